# Optimizing an MI355X kernel written in HIP

```python
import jax, jax.numpy as jnp
from jax import lax
import numpy as np

D_MODEL = 4096
BATCH = 8
SEQ = 2048
DEPTH = 2

HEAD_DIM = 128
N_Q_HEADS = D_MODEL // 256
N_KV_HEADS = N_Q_HEADS // 4
Q_PER_KV = N_Q_HEADS // N_KV_HEADS
WINDOW = 128
BLOCK = 128
ATTN_WIDTH = N_Q_HEADS * HEAD_DIM
KV_WIDTH = N_KV_HEADS * HEAD_DIM
NEG_INF = -1e30
SSM_WIDTH = D_MODEL // 4
SSM_GROUP = 16
SSM_GROUPS = SSM_WIDTH // SSM_GROUP
SSM_STATE = 64
DT_MIN = 1e-3
DT_MAX = 1e-1
IN_COLS = ATTN_WIDTH + 2 * KV_WIDTH + SSM_WIDTH + 2 * D_MODEL
SPLITS = [ATTN_WIDTH, ATTN_WIDTH + KV_WIDTH, ATTN_WIDTH + 2 * KV_WIDTH,
          ATTN_WIDTH + 2 * KV_WIDTH + SSM_WIDTH, ATTN_WIDTH + 2 * KV_WIDTH + SSM_WIDTH + D_MODEL]
PEER_HEADS = 8
PEER_DK = 256
N_KEYS = 128
N_EXPERTS = N_KEYS * N_KEYS
PEER_TOPK = 16
PEER_CHUNK = 128
NORM_EPS = 1e-6

kernel_name = 'hybrid_swa_s5_peer_gated_block'


def rms_norm(x, g):
    xf = x.astype(jnp.float32)
    y = xf * lax.rsqrt(jnp.mean(xf * xf, axis=-1, keepdims=True) + NORM_EPS)
    return (y * g.astype(jnp.float32)).astype(x.dtype)


def alibi_slopes():
    return jnp.asarray(2.0 ** (-8.0 * np.arange(1, N_Q_HEADS + 1) / N_Q_HEADS), dtype=jnp.float32)


def sliding_window_attention(q, k, v, sinks):
    b, s = q.shape[:2]
    nb = s // BLOCK
    qb = q.reshape(b, nb, BLOCK, N_KV_HEADS, Q_PER_KV, HEAD_DIM)
    kb = k.reshape(b, nb, BLOCK, N_KV_HEADS, HEAD_DIM)
    vb = v.reshape(b, nb, BLOCK, N_KV_HEADS, HEAD_DIM)
    pad = jnp.zeros_like(kb[:, :1])
    k_win = jnp.concatenate([jnp.concatenate([pad, kb[:, :-1]], axis=1), kb], axis=2)
    v_win = jnp.concatenate([jnp.concatenate([pad, vb[:, :-1]], axis=1), vb], axis=2)
    logits = jnp.einsum('bnqkgd,bnskd->bnkgqs', qb, k_win,
                        preferred_element_type=jnp.float32) * (HEAD_DIM ** -0.5)
    qi = jnp.arange(BLOCK)[:, None]
    sj = jnp.arange(2 * BLOCK)[None, :]
    dist = qi - sj + BLOCK
    blk = jnp.arange(nb)[:, None, None]
    valid = (dist >= 0) & (dist < WINDOW) & ((blk > 0) | (sj >= BLOCK))
    slopes = alibi_slopes().reshape(N_KV_HEADS, Q_PER_KV)
    bias = -slopes[:, :, None, None] * dist.astype(jnp.float32)
    logits = jnp.where(valid[None, :, None, None], logits + bias[None, None], NEG_INF)
    sink = sinks.astype(jnp.float32).reshape(N_KV_HEADS, Q_PER_KV)[None, None, :, :, None, None]
    sink = jnp.broadcast_to(sink, logits.shape[:-1] + (1,))
    probs = jax.nn.softmax(jnp.concatenate([logits, sink], axis=-1), axis=-1)[..., :-1]
    out = jnp.einsum('bnkgqs,bnskd->bnqkgd', probs.astype(v.dtype), v_win)
    return out.reshape(b, s, ATTN_WIDTH)


def _complex_linear_combine(c1, c2):
    a1r, a1i, b1r, b1i = c1
    a2r, a2i, b2r, b2i = c2
    return (a2r * a1r - a2i * a1i,
            a2r * a1i + a2i * a1r,
            a2r * b1r - a2i * b1i + b2r,
            a2r * b1i + a2i * b1r + b2i)


def s5_mixer(u, a_re, a_im, log_step, b_re, b_im, c_re, c_im, d_skip, w_glu):
    bsz, s, _ = u.shape
    f32 = jnp.float32
    uf = u.astype(f32).reshape(bsz, s, SSM_GROUPS, SSM_GROUP)
    ar = a_re.astype(f32)
    ai = a_im.astype(f32)
    dt = jnp.exp(log_step.astype(f32))[:, None]
    mag = jnp.exp(ar * dt)
    lr = mag * jnp.cos(ai * dt)
    li = mag * jnp.sin(ai * dt)
    den = ar * ar + ai * ai
    nr = lr - 1.0
    zr = (nr * ar + li * ai) / den
    zi = (li * ar - nr * ai) / den
    br = b_re.astype(f32)
    bi = b_im.astype(f32)
    bbar_r = zr[..., None] * br - zi[..., None] * bi
    bbar_i = zr[..., None] * bi + zi[..., None] * br
    bu_r = jnp.einsum('bsgh,gph->bsgp', uf, bbar_r)
    bu_i = jnp.einsum('bsgh,gph->bsgp', uf, bbar_i)
    lam_r = jnp.broadcast_to(lr[None, None], bu_r.shape)
    lam_i = jnp.broadcast_to(li[None, None], bu_i.shape)
    _, _, xr, xi = lax.associative_scan(_complex_linear_combine, (lam_r, lam_i, bu_r, bu_i), axis=1)
    y = (jnp.einsum('bsgp,ghp->bsgh', xr, c_re.astype(f32))
         - jnp.einsum('bsgp,ghp->bsgh', xi, c_im.astype(f32)))
    y = y.reshape(bsz, s, SSM_WIDTH) + d_skip.astype(f32) * u.astype(f32)
    z = jax.nn.gelu(y)
    gl = z @ w_glu.astype(f32)
    out = gl[..., :SSM_WIDTH] * jax.nn.sigmoid(gl[..., SSM_WIDTH:])
    return out.astype(u.dtype)


def peer_ffn(xn, w_q, keys, u_tab, v_tab):
    bsz, s, d = xn.shape
    q = (xn @ w_q).astype(jnp.float32).reshape(bsz, s, PEER_HEADS, 2, PEER_DK // 2)
    sub = jnp.einsum('bshcd,hcnd->bshcn', q, keys.astype(jnp.float32))
    sv, si = lax.top_k(sub, PEER_TOPK)
    cand = (sv[..., 0, :, None] + sv[..., 1, None, :]).reshape(bsz, s, PEER_HEADS, PEER_TOPK * PEER_TOPK)
    cidx = (si[..., 0, :, None] * N_KEYS + si[..., 1, None, :]).reshape(bsz, s, PEER_HEADS, PEER_TOPK * PEER_TOPK)
    top_s, pos = lax.top_k(cand, PEER_TOPK)
    expert = jnp.take_along_axis(cidx, pos, axis=-1)
    gate = jax.nn.softmax(top_s, axis=-1)
    n_chunks = (bsz * s) // PEER_CHUNK
    xs = xn.reshape(n_chunks, PEER_CHUNK, d)
    es = expert.reshape(n_chunks, PEER_CHUNK, PEER_HEADS * PEER_TOPK)
    gs = gate.astype(xn.dtype).reshape(n_chunks, PEER_CHUNK, PEER_HEADS * PEER_TOPK)

    def chunk(args):
        xc, ec, gc = args
        uc = jnp.take(u_tab, ec, axis=0)
        act = jax.nn.gelu(jnp.einsum('ckd,cd->ck', uc, xc)) * gc
        vc = jnp.take(v_tab, ec, axis=0)
        return jnp.einsum('ck,ckd->cd', act, vc)

    out = lax.map(chunk, (xs, es, gs))
    return out.reshape(bsz, s, d)


def setup_inputs(seed: int = 0) -> dict:
    key = jax.random.key(seed)
    ks = jax.random.split(key, 24)
    f32 = jnp.float32

    def nrm(k, shape, scale):
        return jax.random.normal(k, shape, f32) * scale

    L, D, G, P, H = DEPTH, D_MODEL, SSM_GROUPS, SSM_STATE, SSM_GROUP
    return {
        'x': nrm(ks[0], (BATCH, SEQ, D), 1.0),
        'ln_mix': 1.0 + nrm(ks[1], (L, D), 0.02),
        'w_in': nrm(ks[2], (L, D, IN_COLS), D ** -0.5),
        'ssm_a_re': -0.5 * jnp.exp(nrm(ks[3], (L, G, P), 0.02)),
        'ssm_a_im': jnp.pi * jnp.arange(P, dtype=f32)[None, None, :] + nrm(ks[4], (L, G, P), 0.02),
        'ssm_log_step': jax.random.uniform(ks[5], (L, G), f32, float(np.log(DT_MIN)), float(np.log(DT_MAX))),
        'ssm_b_re': nrm(ks[6], (L, G, P, H), (2 * H) ** -0.5),
        'ssm_b_im': nrm(ks[7], (L, G, P, H), (2 * H) ** -0.5),
        'ssm_c_re': nrm(ks[8], (L, G, H, P), (2 * P) ** -0.5),
        'ssm_c_im': nrm(ks[9], (L, G, H, P), (2 * P) ** -0.5),
        'ssm_d': nrm(ks[10], (L, SSM_WIDTH), 1.0),
        'w_glu': nrm(ks[11], (L, SSM_WIDTH, 2 * SSM_WIDTH), SSM_WIDTH ** -0.5),
        'attn_sinks': nrm(ks[12], (L, N_Q_HEADS), 0.5),
        'w_attn_branch': nrm(ks[13], (L, ATTN_WIDTH, D), ATTN_WIDTH ** -0.5),
        'w_ssm_branch': nrm(ks[14], (L, SSM_WIDTH, D), SSM_WIDTH ** -0.5),
        'w_out': nrm(ks[15], (L, D, D), D ** -0.5),
        'ln_ffn': 1.0 + nrm(ks[16], (L, D), 0.02),
        'w_peer_q': nrm(ks[17], (L, D, PEER_HEADS * PEER_DK), D ** -0.5),
        'peer_keys': nrm(ks[18], (L, PEER_HEADS, 2, N_KEYS, PEER_DK // 2), (PEER_DK // 2) ** -0.5),
        'peer_u': nrm(ks[19], (L, N_EXPERTS, D), D ** -0.5),
        'peer_v': nrm(ks[20], (L, N_EXPERTS, D), PEER_HEADS ** -0.5),
        'ln_final': 1.0 + nrm(ks[21], (D,), 0.02),
    }


def reference(x, ln_mix, w_in, ssm_a_re, ssm_a_im, ssm_log_step, ssm_b_re, ssm_b_im,
              ssm_c_re, ssm_c_im, ssm_d, w_glu, attn_sinks, w_attn_branch, w_ssm_branch,
              w_out, ln_ffn, w_peer_q, peer_keys, peer_u, peer_v, ln_final):
    bsz, s, _ = x.shape
    for l in range(DEPTH):
        xn = rms_norm(x, ln_mix[l])
        proj = xn @ w_in[l]
        q, k, v, u, g_attn, g_ssm = jnp.split(proj, SPLITS, axis=-1)
        attn = sliding_window_attention(q.reshape(bsz, s, N_Q_HEADS, HEAD_DIM),
                                        k.reshape(bsz, s, N_KV_HEADS, HEAD_DIM),
                                        v.reshape(bsz, s, N_KV_HEADS, HEAD_DIM),
                                        attn_sinks[l])
        ssm = s5_mixer(u, ssm_a_re[l], ssm_a_im[l], ssm_log_step[l], ssm_b_re[l], ssm_b_im[l],
                       ssm_c_re[l], ssm_c_im[l], ssm_d[l], w_glu[l])
        merged = (jax.nn.sigmoid(g_attn) * (attn @ w_attn_branch[l])
                  + jax.nn.sigmoid(g_ssm) * (ssm @ w_ssm_branch[l]))
        x = x + merged @ w_out[l]
        x = x + peer_ffn(rms_norm(x, ln_ffn[l]), w_peer_q[l], peer_keys[l], peer_u[l], peer_v[l])
    return rms_norm(x, ln_final)
```

```cpp
#include <hip/hip_runtime.h>
#include <cstdio>
#include <cstdint>
namespace pg8 {
#define PG8_LAS __attribute__((address_space(3)))
typedef unsigned short bf16_t;
typedef short bf16x8 __attribute__((ext_vector_type(8)));
typedef float f32x4 __attribute__((ext_vector_type(4)));
typedef unsigned u32x4 __attribute__((ext_vector_type(4)));
constexpr int BM = 256, BK = 64, HALF = 128, HTB = HALF * BK * 2  , STAGE_BYTES = 8 * HTB, NXCD = 8, WGM = 8;

__host__ __device__ __forceinline__ int lds_byte(int r, int c) { const int st = (r >> 4) * 2 + (c >> 5), rr = r & 15, cc = c & 31, ob = rr * 64 + cc * 2; return st * 1024 + (ob ^ (((ob >> 9) & 1) << 5)); }
__host__ __device__ __forceinline__ void stage_rc(int b, int& R, int& C) { const int st = b / 1024, sb = b % 1024, swz = sb ^ (((sb >> 9) & 1) << 5); R = (st >> 1) * 16 + swz / 64; C = (st & 1) * 32 + (swz % 64) / 2; }
__host__ __device__ __forceinline__ int perm32(int rho) { const int n = rho >> 4, i = rho & 15; return 8 * (i >> 2) + 4 * n + (i & 3); }

struct Unit { int pm, pn; };
struct Gemm { const bf16_t* A; const bf16_t* Bt; int M, N, K; };

struct StaticOrder {
    int nM, nN, nwg, G, c;
    __host__ __device__ void init(int M, int N, int G_, int c_) { nM = M / BM; nN = N / BM; nwg = nM * nN; G = G_; c = c_; }
    __host__ __device__ bool next(int i, Unit& u) const {
        const long L = (long)i * G + c; if (L >= nwg) return false;
        int wgid = (int)L; { const int q = nwg / NXCD, r = nwg % NXCD, xcd = wgid % NXCD, off = wgid / NXCD; wgid = (xcd < r ? xcd * (q + 1) : r * (q + 1) + (xcd - r) * q) + off; }
        const int nig = WGM * nN, gid = wgid / nig, fm = gid * WGM, gsz = (nM - fm) < WGM ? (nM - fm) : WGM;
        u.pm = fm + ((wgid % nig) % gsz); u.pn = (wgid % nig) / gsz; return true;
    }
    __device__ __forceinline__ void a_ready(const Unit&) const {}
    __device__ __forceinline__ void done(const Unit&) const {}
};

__device__ __forceinline__ unsigned cvt_pk_bf16(float lo, float hi) { unsigned r; asm volatile("v_cvt_pk_bf16_f32 %0, %1, %2" : "=v"(r) : "v"(lo), "v"(hi)); return r; }
__device__ __forceinline__ float bflo(unsigned w) { return __uint_as_float(w << 16); }
__device__ __forceinline__ float bfhi(unsigned w) { return __uint_as_float(w & 0xffff0000u); }
__device__ __forceinline__ float sigmoidf_fast(float x) { return __builtin_amdgcn_rcpf(1.0f + __expf(-x)); }
__device__ __forceinline__ u32x4 pack8(const f32x4 v0, const f32x4 v1) { u32x4 w; w.x = cvt_pk_bf16(v0[0], v0[1]); w.y = cvt_pk_bf16(v0[2], v0[3]); w.z = cvt_pk_bf16(v1[0], v1[1]); w.w = cvt_pk_bf16(v1[2], v1[3]); return w; }

struct EpiBf16Plain {
    static constexpr bool PERM = true, AFTER_DRAIN = false;
    bf16_t* O; int ldc;
    __device__ __forceinline__ void operator()(const f32x4 (&acc)[2][2][4][2], const Unit& u, int wr, int wc, int fr, int fq) const {
        const int row0 = u.pm * BM + wr * 64 + fr, col0 = u.pn * BM + wc * 32 + 8 * fq;
#pragma unroll
        for (int ai = 0; ai < 2; ++ai)
#pragma unroll
            for (int m = 0; m < 4; ++m) { bf16_t* rowp = O + (size_t)(row0 + ai * HALF + m * 16) * ldc + col0;
#pragma unroll
                for (int bj = 0; bj < 2; ++bj) *(u32x4*)(rowp + bj * HALF) = pack8(acc[ai][bj][m][0], acc[ai][bj][m][1]); }
    }
};
struct EpiIn {
    static constexpr bool PERM = true, AFTER_DRAIN = false;
    bf16_t *Q, *KB, *VT, *U, *GA, *GS;
    __device__ __forceinline__ void operator()(const f32x4 (&acc)[2][2][4][2], const Unit& u, int wr, int wc, int fr, int fq) const {
        const int row0 = u.pm * BM + wr * 64 + fr, colw = wc * 32 + 8 * fq; const int pn = u.pn;
        if (pn >= 10 && pn < 12) {
#pragma unroll
            for (int ai = 0; ai < 2; ++ai)
#pragma unroll
                for (int m = 0; m < 4; ++m) { const int row = row0 + ai * HALF + m * 16; const int b = row >> 11, s = row & 2047;
#pragma unroll
                    for (int bj = 0; bj < 2; ++bj) { const int vcol = (pn - 10) * 256 + bj * HALF + colw;
                        bf16_t* base = VT + ((size_t)((b * 4 + (vcol >> 7)) * 128 + (vcol & 127))) * 2048 + s;
#pragma unroll
                        for (int n = 0; n < 2; ++n)
#pragma unroll
                            for (int i = 0; i < 4; ++i) { const unsigned w = cvt_pk_bf16(acc[ai][bj][m][n][i], 0.f); base[(size_t)(4 * n + i) * 2048] = (bf16_t)(w & 0xffffu); } } }
            return;
        }
        bf16_t* O; int ldc, colt; int mode;
        if (pn < 8) { O = Q; ldc = 2048; colt = pn * 256; mode = 1; }
        else if (pn < 10) { O = KB; ldc = 512; colt = (pn - 8) * 256; mode = 0; }
        else if (pn < 16) { O = U; ldc = 1024; colt = (pn - 12) * 256; mode = 0; }
        else if (pn < 32) { O = GA; ldc = 4096; colt = (pn - 16) * 256; mode = 2; }
        else { O = GS; ldc = 4096; colt = (pn - 32) * 256; mode = 2; }
        const float sc = (mode == 1) ? 0.08838834764831845f : 1.0f;
#pragma unroll
        for (int ai = 0; ai < 2; ++ai)
#pragma unroll
            for (int m = 0; m < 4; ++m) { bf16_t* rowp = O + (size_t)(row0 + ai * HALF + m * 16) * ldc + colt + colw;
#pragma unroll
                for (int bj = 0; bj < 2; ++bj) { f32x4 v0 = acc[ai][bj][m][0], v1 = acc[ai][bj][m][1];
                    if (mode == 2) {
#pragma unroll
                        for (int i = 0; i < 4; ++i) { v0[i] = sigmoidf_fast(v0[i]); v1[i] = sigmoidf_fast(v1[i]); } }
                    else { v0 = v0 * sc; v1 = v1 * sc; }
                    *(u32x4*)(rowp + bj * HALF) = pack8(v0, v1); } }
    }
};
struct EpiGlu {
    static constexpr bool PERM = true, AFTER_DRAIN = false;
    bf16_t* O; int ldc;
    __device__ __forceinline__ void operator()(const f32x4 (&acc)[2][2][4][2], const Unit& u, int wr, int wc, int fr, int fq) const {
        const int row0 = u.pm * BM + wr * 64 + fr, col0 = u.pn * HALF + wc * 32 + 8 * fq;
#pragma unroll
        for (int ai = 0; ai < 2; ++ai)
#pragma unroll
            for (int m = 0; m < 4; ++m) { f32x4 v0 = acc[ai][0][m][0], v1 = acc[ai][0][m][1]; const f32x4 g0 = acc[ai][1][m][0], g1 = acc[ai][1][m][1];
#pragma unroll
                for (int i = 0; i < 4; ++i) { v0[i] *= sigmoidf_fast(g0[i]); v1[i] *= sigmoidf_fast(g1[i]); }
                *(u32x4*)(O + (size_t)(row0 + ai * HALF + m * 16) * ldc + col0) = pack8(v0, v1); }
    }
};
template <bool ADD> struct EpiGate {
    static constexpr bool PERM = true, AFTER_DRAIN = false;
    bf16_t* O; const bf16_t* G; int ldc;
    __device__ __forceinline__ void operator()(const f32x4 (&acc)[2][2][4][2], const Unit& u, int wr, int wc, int fr, int fq) const {
        const int row0 = u.pm * BM + wr * 64 + fr, col0 = u.pn * BM + wc * 32 + 8 * fq;
#pragma unroll
        for (int ai = 0; ai < 2; ++ai)
#pragma unroll
            for (int m = 0; m < 4; ++m) { const size_t off = (size_t)(row0 + ai * HALF + m * 16) * ldc + col0;
#pragma unroll
                for (int bj = 0; bj < 2; ++bj) { const u32x4 g = *(const u32x4*)(G + off + bj * HALF); f32x4 v0 = acc[ai][bj][m][0], v1 = acc[ai][bj][m][1];
                    v0[0] *= bflo(g.x); v0[1] *= bfhi(g.x); v0[2] *= bflo(g.y); v0[3] *= bfhi(g.y); v1[0] *= bflo(g.z); v1[1] *= bfhi(g.z); v1[2] *= bflo(g.w); v1[3] *= bfhi(g.w);
                    if (ADD) { const u32x4 o = *(const u32x4*)(O + off + bj * HALF);
                        v0[0] += bflo(o.x); v0[1] += bfhi(o.x); v0[2] += bflo(o.y); v0[3] += bfhi(o.y); v1[0] += bflo(o.z); v1[1] += bfhi(o.z); v1[2] += bflo(o.w); v1[3] += bfhi(o.w); }
                    *(u32x4*)(O + off + bj * HALF) = pack8(v0, v1); }
                asm volatile("" ::: "memory"); }
    }
};
struct EpiRes {
    static constexpr bool PERM = false, AFTER_DRAIN = false;
    const float* base; float* out; int ldc;
    __device__ __forceinline__ void operator()(const f32x4 (&acc)[2][2][4][2], const Unit& u, int wr, int wc, int fr, int fq) const {
        const int row0 = u.pm * BM + wr * 64 + fr, col0 = u.pn * BM + wc * 32 + 4 * fq;
#pragma unroll
        for (int ai = 0; ai < 2; ++ai)
#pragma unroll
            for (int m = 0; m < 4; ++m) { const size_t off = (size_t)(row0 + ai * HALF + m * 16) * ldc + col0;
#pragma unroll
                for (int bj = 0; bj < 2; ++bj)
#pragma unroll
                    for (int n = 0; n < 2; ++n) { const f32x4 bs = *(const f32x4*)(base + off + bj * HALF + n * 16); *(f32x4*)(out + off + bj * HALF + n * 16) = bs + acc[ai][bj][m][n]; } }
    }
};

template <class Epi, class Sched, bool ALIGN_EPI = false, bool SP2 = false>
__device__ __forceinline__ void gemm_phase(PG8_LAS unsigned char* lds, const Gemm g, const Sched& S, const Epi& E) {
    int tid = threadIdx.x; asm volatile("" : "+v"(tid));
    const int wid = __builtin_amdgcn_readfirstlane(tid >> 6), lane = tid & 63, wr = wid >> 2, wc = wid & 3, fr = lane & 15, fq = lane >> 4;
    const int K = g.K, nt = K / BK;
    unsigned voffA[2], voffB[2];
#pragma unroll
    for (int i = 0; i < 2; ++i) { int R, C; stage_rc(tid * 16 + i * 8192, R, C); const int Rb = Epi::PERM ? ((R & ~31) + perm32(R & 31)) : R;
        voffA[i] = (unsigned)(R * K + C) * 2u; voffB[i] = (unsigned)(Rb * K + C) * 2u; }
    const size_t kstep = (size_t)(BK * 2);
    const size_t hstep = (size_t)HALF * K * 2;
    const size_t tstep = 2 * hstep;
    const unsigned ldsw = (unsigned)wid * 1024u;
    const int aoff = lds_byte(wr * 64 + fr, fq * 8), boff = lds_byte(wc * 32 + fr, fq * 8);
#define PG8_SA(b, h) (((b) * 2 + (h)) * HTB)
#define PG8_SB(b, h) ((4 + (b) * 2 + (h)) * HTB)
#define PG8_STAGE(bufoff, gbase, voff) do { _Pragma("unroll") for (int _i = 0; _i < 2; ++_i) \
        __builtin_amdgcn_global_load_lds((const unsigned*)((const char*)(gbase) + (voff)[_i]), (PG8_LAS unsigned*)(lds + (bufoff) + ldsw + _i * 8192), 16, 0, 0); } while (0)
#define PG8_LDA(dst, b, h) do { _Pragma("unroll") for (int m = 0; m < 4; ++m) _Pragma("unroll") for (int k = 0; k < 2; ++k) dst[m][k] = *(const PG8_LAS bf16x8*)(lds + PG8_SA(b, h) + aoff + m * 2048 + k * 1024); } while (0)
#define PG8_LDB(dst, b, h) do { _Pragma("unroll") for (int n = 0; n < 2; ++n) _Pragma("unroll") for (int k = 0; k < 2; ++k) dst[n][k] = *(const PG8_LAS bf16x8*)(lds + PG8_SB(b, h) + boff + n * 2048 + k * 1024); } while (0)
#define PG8_MMA(ai, bj, At, Bt) do { __builtin_amdgcn_s_setprio(1); _Pragma("unroll") for (int m = 0; m < 4; ++m) _Pragma("unroll") for (int n = 0; n < 2; ++n) _Pragma("unroll") for (int k = 0; k < 2; ++k) \
        acc[ai][bj][m][n] = __builtin_amdgcn_mfma_f32_16x16x32_bf16(Bt[n][k], At[m][k], acc[ai][bj][m][n], 0, 0, 0); __builtin_amdgcn_s_setprio(0); } while (0)
#define PG8_WAIT_V(n) asm volatile("s_waitcnt vmcnt(" #n ")" ::: "memory")
#define PG8_WAIT_L(n) asm volatile("s_waitcnt lgkmcnt(" #n ")" ::: "memory")
#define PG8_BAR __builtin_amdgcn_s_barrier()
#define PG8_SCHED __builtin_amdgcn_sched_barrier(0)
    Unit cur, nxt; int ui = 0;
    if (!S.next(0, cur)) return;
    f32x4 acc[2][2][4][2];
#pragma unroll
    for (int a = 0; a < 2; ++a)
#pragma unroll
        for (int b = 0; b < 2; ++b)
#pragma unroll
            for (int m = 0; m < 4; ++m)
#pragma unroll
                for (int n = 0; n < 2; ++n) acc[a][b][m][n] = (f32x4){0.f, 0.f, 0.f, 0.f};
    bf16x8 At[4][2], B0[2][2], B1[2][2];
    const char* cA = (const char*)g.A + (size_t)cur.pm * tstep; const char* cB = (const char*)g.Bt + (size_t)cur.pn * tstep;
    S.a_ready(cur);
    if constexpr (SP2) {
        PG8_STAGE(PG8_SB(0, 0), cB, voffB); PG8_STAGE(PG8_SB(0, 1), cB + hstep, voffB); PG8_STAGE(PG8_SA(0, 0), cA, voffA); PG8_STAGE(PG8_SA(0, 1), cA + hstep, voffA);
        if (wr == 1) PG8_BAR;
        PG8_WAIT_V(2); PG8_BAR;
        PG8_STAGE(PG8_SB(1, 0), cB + kstep, voffB); PG8_STAGE(PG8_SA(1, 0), cA + kstep, voffA); PG8_STAGE(PG8_SB(1, 1), cB + hstep + kstep, voffB);
        PG8_WAIT_V(6); PG8_BAR;
    } else {
        PG8_STAGE(PG8_SB(0, 0), cB, voffB); PG8_STAGE(PG8_SA(0, 0), cA, voffA); PG8_STAGE(PG8_SB(0, 1), cB + hstep, voffB); PG8_STAGE(PG8_SA(0, 1), cA + hstep, voffA);
        if (wr == 1) PG8_BAR;
        PG8_WAIT_V(4); PG8_BAR;
        PG8_STAGE(PG8_SB(1, 0), cB + kstep, voffB); PG8_STAGE(PG8_SA(1, 0), cA + kstep, voffA); PG8_STAGE(PG8_SB(1, 1), cB + hstep + kstep, voffB);
        PG8_WAIT_V(6); PG8_BAR;
    }
    for (;;) {
        const bool has_next = S.next(ui + 1, nxt);
        const char* nA = has_next ? (const char*)g.A + (size_t)nxt.pm * tstep : cA; const char* nB = has_next ? (const char*)g.Bt + (size_t)nxt.pn * tstep : cB;
        for (int t = 0; t < nt; t += 2) {
            const bool last = (t == nt - 2);
            const char* a1 = cA + (size_t)(t + 1) * kstep;
            const char* a2 = last ? nA : cA + (size_t)(t + 2) * kstep; const char* b2 = last ? nB : cB + (size_t)(t + 2) * kstep;
            const char* a3 = a2 + kstep; const char* b3 = b2 + kstep;
            if (last && has_next) S.a_ready(nxt);
            if constexpr (SP2) {
            PG8_LDB(B0, 0, 0); PG8_LDB(B1, 0, 1); PG8_SCHED; PG8_LDA(At, 0, 0); PG8_STAGE(PG8_SA(1, 1), a1 + hstep, voffA);
            PG8_WAIT_V(8); PG8_WAIT_L(0); PG8_BAR; PG8_MMA(0, 0, At, B0); PG8_MMA(0, 1, At, B1); PG8_BAR; PG8_SCHED;
            PG8_LDA(At, 0, 1); PG8_STAGE(PG8_SB(0, 0), b2, voffB); PG8_STAGE(PG8_SB(0, 1), b2 + hstep, voffB); PG8_STAGE(PG8_SA(0, 0), a2, voffA);
            PG8_WAIT_V(8); PG8_WAIT_L(0); PG8_BAR; PG8_MMA(1, 0, At, B0); PG8_MMA(1, 1, At, B1); PG8_BAR; PG8_SCHED;
            PG8_LDB(B0, 1, 0); PG8_LDB(B1, 1, 1); PG8_SCHED; PG8_LDA(At, 1, 0); PG8_STAGE(PG8_SA(0, 1), a2 + hstep, voffA);
            PG8_WAIT_V(8); PG8_WAIT_L(0); PG8_BAR; PG8_MMA(0, 0, At, B0); PG8_MMA(0, 1, At, B1); PG8_BAR; PG8_SCHED;
            PG8_LDA(At, 1, 1); PG8_STAGE(PG8_SB(1, 0), b3, voffB); PG8_STAGE(PG8_SB(1, 1), b3 + hstep, voffB); PG8_STAGE(PG8_SA(1, 0), a3, voffA);
            PG8_WAIT_V(8); PG8_WAIT_L(0); PG8_BAR; PG8_MMA(1, 0, At, B0); PG8_MMA(1, 1, At, B1); PG8_BAR; PG8_SCHED;
            } else {
            PG8_LDB(B0, 0, 0); PG8_SCHED; PG8_LDA(At, 0, 0); PG8_STAGE(PG8_SA(1, 1), a1 + hstep, voffA);
            PG8_WAIT_L(8); PG8_BAR; PG8_WAIT_L(0); PG8_MMA(0, 0, At, B0); PG8_BAR; PG8_SCHED;
            PG8_LDB(B1, 0, 1); PG8_STAGE(PG8_SB(0, 0), b2, voffB);
            PG8_BAR; PG8_WAIT_L(0); PG8_MMA(0, 1, At, B1); PG8_BAR;
            PG8_LDA(At, 0, 1); PG8_STAGE(PG8_SA(0, 0), a2, voffA);
            PG8_BAR; PG8_WAIT_L(0); PG8_MMA(1, 0, At, B0); PG8_BAR; PG8_SCHED;
            PG8_STAGE(PG8_SB(0, 1), b2 + hstep, voffB);
            PG8_WAIT_V(6); PG8_BAR; PG8_MMA(1, 1, At, B1); PG8_BAR;
            PG8_LDB(B0, 1, 0); PG8_SCHED; PG8_LDA(At, 1, 0); PG8_STAGE(PG8_SA(0, 1), a2 + hstep, voffA);
            PG8_WAIT_L(8); PG8_BAR; PG8_WAIT_L(0); PG8_MMA(0, 0, At, B0); PG8_BAR; PG8_SCHED;
            PG8_LDB(B1, 1, 1); PG8_STAGE(PG8_SB(1, 0), b3, voffB);
            PG8_BAR; PG8_WAIT_L(0); PG8_MMA(0, 1, At, B1); PG8_BAR;
            PG8_LDA(At, 1, 1); PG8_STAGE(PG8_SA(1, 0), a3, voffA);
            PG8_BAR; PG8_WAIT_L(0); PG8_MMA(1, 0, At, B0); PG8_BAR; PG8_SCHED;
            PG8_STAGE(PG8_SB(1, 1), b3 + hstep, voffB);
            PG8_WAIT_V(6); PG8_BAR; PG8_MMA(1, 1, At, B1); PG8_BAR;
            }
        }
        if constexpr (ALIGN_EPI) { if (wr == 0) PG8_BAR; }
        if constexpr (!Epi::AFTER_DRAIN) { E(acc, cur, wr, wc, fr, fq); S.done(cur); }
        if (!has_next) break;
#pragma unroll
        for (int a = 0; a < 2; ++a)
#pragma unroll
            for (int b = 0; b < 2; ++b)
#pragma unroll
                for (int m = 0; m < 4; ++m)
#pragma unroll
                    for (int n = 0; n < 2; ++n) acc[a][b][m][n] = (f32x4){0.f, 0.f, 0.f, 0.f};
        cur = nxt; cA = nA; cB = nB; ++ui;
        if constexpr (ALIGN_EPI) { if (wr == 1) PG8_BAR; }
    }
    PG8_WAIT_V(0);
    if constexpr (!ALIGN_EPI) { if (wr == 0) PG8_BAR; }
    PG8_BAR;
    if constexpr (Epi::AFTER_DRAIN) { E.fused(acc, cur, wr, wc, fr, fq, lds, wid, lane); S.done(cur); }
#undef PG8_SA
#undef PG8_SB
#undef PG8_STAGE
#undef PG8_LDA
#undef PG8_LDB
#undef PG8_MMA
#undef PG8_WAIT_V
#undef PG8_WAIT_L
#undef PG8_BAR
#undef PG8_SCHED
}
}

constexpr int NWAVES = 8;
constexpr int DM = 4096, BATCH = 8, SEQ = 2048, DEPTH = 2, M = BATCH * SEQ;
constexpr int HD = 128, NQH = 16, NKVH = 4, ATTW = 2048, KVW = 512, SSMW = 1024, SSMG = 64, INCOLS = 12288;
constexpr int PH = 8, PDK = 256, NKEYS = 128, NEXP = 16384, PTOPK = 16, PSEL = PH * PTOPK;
constexpr float NORM_EPS = 1e-6f;
#ifndef MK_ONE_LAUNCH
#define MK_ONE_LAUNCH 0
#endif
constexpr int NPH_LAYER = 9, NPHASES = 1 + DEPTH * NPH_LAYER;

constexpr size_t MiB = 1u << 20;
constexpr size_t WS_CTL = 0, CTL_ZERO_BYTES = 1 * MiB;
constexpr size_t LW_WIN = 0, LW_WAB = 96 * MiB, LW_WSB = 112 * MiB, LW_WOUT = 120 * MiB, LW_WGLU = 152 * MiB, LW_WPQ = 156 * MiB, LW_UTAB = 172 * MiB, LW_VTAB = 300 * MiB,
                 LW_KEYS = 428 * MiB, LW_S5K = 429 * MiB, LW_S5ME = 431 * MiB, LW_S5MC = 447 * MiB, LW_S5LAM = 463 * MiB, LW_SIZE = 464 * MiB;
constexpr size_t WS_LW = 1 * MiB;
constexpr size_t WS_ACT = WS_LW + DEPTH * LW_SIZE;
constexpr size_t WS_XN = WS_ACT, WS_Q = WS_XN + 128 * MiB, WS_KB = WS_Q + 64 * MiB, WS_VT = WS_KB + 16 * MiB, WS_U = WS_VT + 16 * MiB, WS_GA = WS_U + 32 * MiB, WS_GS = WS_GA + 128 * MiB,
                 WS_ATT = WS_GS + 128 * MiB, WS_Z = WS_ATT + 64 * MiB, WS_SS = WS_Z + 32 * MiB, WS_MG = WS_SS + 32 * MiB, WS_PQ = WS_MG + 128 * MiB, WS_EID = WS_PQ + 64 * MiB,
                 WS_GATE = WS_EID + 8 * MiB, WS_HN = WS_GATE + 8 * MiB, WS_END = WS_HN + 128 * MiB;
static_assert(WS_END <= 2048 * MiB, "d_ws map exceeds the guaranteed 2 GiB");
constexpr int CW_TMO = 0, CW_CODE = 1, CW_BAR = 4096;

constexpr int SCR_BYTES = 139264;
constexpr int LDSCTL_OFF = SCR_BYTES, MISC_OFF = LDSCTL_OFF + 320, LDS_BYTES = SCR_BYTES + 1024;
static_assert(MISC_OFF + 128 <= LDS_BYTES, "LDS map");
#define GAS __attribute__((address_space(1)))
#define LAS __attribute__((address_space(3)))
typedef unsigned short bf16;
typedef unsigned v4u __attribute__((ext_vector_type(4)));
typedef float f32x4 __attribute__((ext_vector_type(4)));
typedef short bf16x8 __attribute__((ext_vector_type(8)));
typedef GAS unsigned gu32;
typedef GAS unsigned long long gu64;
#define RLX_AGENT __ATOMIC_RELAXED, __HIP_MEMORY_SCOPE_AGENT
#define LDS_WAIT() asm volatile("s_waitcnt lgkmcnt(0)" ::: "memory")
#define VM_WAIT() asm volatile("s_waitcnt vmcnt(0)" ::: "memory")
__device__ __forceinline__ unsigned long long rt() { return __builtin_amdgcn_s_memrealtime(); }
__device__ __forceinline__ unsigned f2bf(float f) { unsigned u = __builtin_bit_cast(unsigned, f); return (u + 0x7fffu + ((u >> 16) & 1u)) >> 16; }
__device__ __forceinline__ unsigned pk2(float lo, float hi) { return f2bf(lo) | (f2bf(hi) << 16); }

#define XB_TMO      128
#define XB_XCNT(j)  (256  + 64 * (j))
#define XB_XSUB(j)  (1280 + 64 * (j))
#define XB_XGEN(j)  (2304 + 64 * (j))
#define XB_TOP      3328
#define XB_TOPGEN   3392
#define XCD_BAR_WORDS 3456
#define XB_SPIN_CAP (1u << 18)

__device__ __forceinline__ unsigned xb_ld(unsigned* p)              { return __hip_atomic_load(p, __ATOMIC_RELAXED, __HIP_MEMORY_SCOPE_AGENT); }
__device__ __forceinline__ unsigned xb_add(unsigned* p, unsigned v) { return __hip_atomic_fetch_add(p, v, __ATOMIC_RELAXED, __HIP_MEMORY_SCOPE_AGENT); }
__device__ __forceinline__ unsigned xb_xcc_id() { return (unsigned)__builtin_amdgcn_s_getreg((3 << 11) | 20) & 0xFu; }
#define XB_SPIN(cond, bar) do { unsigned _sp = 0; while (cond) { __builtin_amdgcn_s_sleep(1); \
    if ((++_sp & 255u) == 0u) { if (xb_ld(&(bar)[XB_TMO])) break; if (_sp > XB_SPIN_CAP) { atomicAdd(&(bar)[XB_TMO], 1u); break; } } } } while (0)

struct XcdBarrier {
    unsigned* bar; unsigned x;
    volatile LAS unsigned* st;
};

__device__ __forceinline__ XcdBarrier xcd_barrier_post(unsigned* bar, volatile LAS unsigned* st) {
    XcdBarrier b; b.bar = bar; b.x = xb_xcc_id(); b.st = st;
    if (threadIdx.x == 0) (void)xb_add(&bar[XB_XCNT(b.x)], 1u);
    return b;
}
__device__ __forceinline__ void xcd_barrier_complete(unsigned* bar, unsigned x, unsigned& nloc, unsigned& nx) {
    const unsigned G = gridDim.x * gridDim.y * gridDim.z;
    unsigned sum, cnt, mine, sp = 0u;
    for (;;) {
        sum = 0u; cnt = 0u; mine = 0u;
#pragma unroll
        for (unsigned j = 0; j < 16; ++j) { const unsigned c = xb_ld(&bar[XB_XCNT(j)]); sum += c; cnt += (c > 0u) ? 1u : 0u; mine = (j == x) ? c : mine; }
        if (sum == G) break;
        __builtin_amdgcn_s_sleep(1);
        if ((++sp & 255u) == 0u) { if (xb_ld(&bar[XB_TMO])) break; if (sp > XB_SPIN_CAP) { atomicAdd(&bar[XB_TMO], 1u); break; } }
    }
    nloc = mine > 0u ? mine : 1u; nx = cnt > 0u ? cnt : 1u;
}

__device__ __forceinline__ void xcd_barrier(const XcdBarrier& b) {
    asm volatile("s_waitcnt vmcnt(0)" ::: "memory");
    __syncthreads();
    if (threadIdx.x == 0) {
        unsigned* bar = b.bar;
        __builtin_amdgcn_s_waitcnt(0);
        unsigned nloc = b.st[0], nx = b.st[1];
        if (nloc == 0u) { xcd_barrier_complete(bar, b.x, nloc, nx); b.st[0] = nloc; b.st[1] = nx; }
        const unsigned old = xb_add(&bar[XB_XSUB(b.x)], 1u);
        const unsigned gen = old / nloc;
        if (old + 1u == (gen + 1u) * nloc) {
            __builtin_amdgcn_fence(__ATOMIC_RELEASE, "agent");
            asm volatile("s_waitcnt vmcnt(0)" ::: "memory");
            const unsigned og = xb_add(&bar[XB_TOP], 1u);
            const unsigned tg = og / nx;
            if (og + 1u == (tg + 1u) * nx) xb_add(&bar[XB_TOPGEN], 1u);
            else XB_SPIN(xb_ld(&bar[XB_TOPGEN]) == tg, bar);
            __builtin_amdgcn_fence(__ATOMIC_ACQUIRE, "agent");
            xb_add(&bar[XB_XGEN(b.x)], 1u);
            asm volatile("s_waitcnt vmcnt(0)" ::: "memory");
        } else {
            XB_SPIN(xb_ld(&bar[XB_XGEN(b.x)]) == gen, bar);
            __builtin_amdgcn_fence(__ATOMIC_ACQUIRE, "agent");
            asm volatile("s_waitcnt vmcnt(0)" ::: "memory");
        }
    }
    __syncthreads();
}

typedef float f32x16 __attribute__((ext_vector_type(16)));
typedef float f32x2 __attribute__((ext_vector_type(2)));
typedef unsigned u32x2 __attribute__((ext_vector_type(2)));
typedef __bf16 bf16v2 __attribute__((ext_vector_type(2)));
typedef int i32x4 __attribute__((ext_vector_type(4)));
typedef int i32x2 __attribute__((ext_vector_type(2)));
__device__ __forceinline__ unsigned cvtpk(float lo, float hi) { unsigned r; asm volatile("v_cvt_pk_bf16_f32 %0, %1, %2" : "=v"(r) : "v"(lo), "v"(hi)); return r; }
__device__ __forceinline__ float bflo(unsigned w) { return __uint_as_float(w << 16); }
__device__ __forceinline__ float bfhi(unsigned w) { return __uint_as_float(w & 0xffff0000u); }
__device__ __forceinline__ float gelu_tanh(float x) { const float t = x + 0.044715f * x * x * x; return x * __builtin_amdgcn_rcpf(1.0f + __expf(-1.5957691216057308f * t)); }
__device__ __forceinline__ float dot2bf(unsigned a, unsigned b, float c) { return __builtin_amdgcn_fdot2_f32_bf16(__builtin_bit_cast(bf16v2, a), __builtin_bit_cast(bf16v2, b), c, false); }
__device__ __forceinline__ float wave_sum(float v) {
#pragma unroll
    for (int o = 1; o < 64; o <<= 1) v += __shfl_xor(v, o);
    return v;
}

struct Frame {
    LAS unsigned char* lds;
    volatile LAS unsigned* MISC;
    gu32* ctl;
    int tid, lane, wave, G;
    unsigned char* ws;
};

__device__ __forceinline__ void p0_transpose_item(const float* W, int K, int N, bf16* WT, bool glu, LAS float* scr, int item, int lane) {
    const int nblk = N / 32, kb = item / nblk, nb = item % nblk, k0 = 64 * kb, n0 = 32 * nb;
#pragma unroll 8
    for (int i = 0; i < 32; ++i) { const int kk = 2 * i + (lane >> 5); scr[kk * 33 + (lane & 31)] = W[(size_t)(k0 + kk) * N + n0 + (lane & 31)]; }
    LDS_WAIT(); asm volatile("" ::: "memory");
    const int c = lane & 7;
#pragma unroll
    for (int j = 0; j < 4; ++j) { const int n = (lane >> 3) + 8 * j; const LAS float* s = scr + (8 * c) * 33 + n;
        v4u o; o.x = cvtpk(s[0 * 33], s[1 * 33]); o.y = cvtpk(s[2 * 33], s[3 * 33]); o.z = cvtpk(s[4 * 33], s[5 * 33]); o.w = cvtpk(s[6 * 33], s[7 * 33]);
        int nrow = n0 + n; if (glu) { const int half = nrow >> 10, rem = nrow & 1023; nrow = (rem >> 7) * 256 + half * 128 + (rem & 127); }
        *(GAS v4u*)(WT + (size_t)nrow * K + k0 + 8 * c) = o; }
    LDS_WAIT(); asm volatile("" ::: "memory");
}
__device__ __forceinline__ void rms_row_to_bf16(const float* xrow, const float* g, bf16* orow, int lane) {
    const GAS f32x4* xr = (const GAS f32x4*)xrow + lane;
    f32x4 v[16]; float s = 0.f;
#pragma unroll
    for (int j = 0; j < 16; ++j) { v[j] = xr[64 * j]; s += (v[j].x * v[j].x + v[j].y * v[j].y) + (v[j].z * v[j].z + v[j].w * v[j].w); }
    const float rstd = 1.0f / sqrtf(wave_sum(s) * (1.f / DM) + NORM_EPS);
    const GAS f32x4* gr = (const GAS f32x4*)g + lane;
    GAS u32x2* o8 = (GAS u32x2*)orow + lane;
#pragma unroll
    for (int j = 0; j < 16; ++j) { const f32x4 gg = gr[64 * j]; u32x2 w; w.x = cvtpk(v[j].x * rstd * gg.x, v[j].y * rstd * gg.y); w.y = cvtpk(v[j].z * rstd * gg.z, v[j].w * rstd * gg.w); o8[64 * j] = w; }
}
__device__ __forceinline__ void s5_precompute(Frame& F, const float* a_re, const float* a_im, const float* log_step, const float* b_re, const float* b_im, const float* c_re, const float* c_im,
                                              int g, bf16* KT, bf16* MEf, bf16* MCf, float* LAM) {
    LAS float* LPr = (LAS float*)F.lds; LAS float* LPi = LPr + 65 * 64; LAS float* Bbr = LPi + 65 * 64; LAS float* Bbi = Bbr + 1024; LAS float* Cr = Bbi + 1024; LAS float* Ci = Cr + 1024;
    const int tid = F.tid;
    if (tid < 64) { const int p = tid; const float ar = a_re[g * 64 + p], ai = a_im[g * 64 + p], dt = expf(log_step[g]);
        for (int t = 0; t <= 64; ++t) { const float mag = expf(ar * dt * (float)t); float sn, cs; sincosf(ai * dt * (float)t, &sn, &cs); LPr[t * 64 + p] = mag * cs; LPi[t * 64 + p] = mag * sn; }
        const float lr = LPr[64 + p], li = LPi[64 + p], den = ar * ar + ai * ai, nr = lr - 1.0f;
        const float zr = (nr * ar + li * ai) / den, zi = (li * ar - nr * ai) / den;
        for (int h = 0; h < 16; ++h) { const float br = b_re[(g * 64 + p) * 16 + h], bi = b_im[(g * 64 + p) * 16 + h]; Bbr[p * 16 + h] = zr * br - zi * bi; Bbi[p * 16 + h] = zr * bi + zi * br; }
        LAM[(g * 64 + p) * 2] = LPr[64 * 64 + p]; LAM[(g * 64 + p) * 2 + 1] = LPi[64 * 64 + p]; }
    for (int i = tid; i < 1024; i += 512) { Cr[i] = c_re[g * 1024 + i]; Ci[i] = c_im[g * 1024 + i]; }
    __syncthreads();
    for (int o = tid; o < 64 * 256; o += 512) { const int tau = o >> 8, h = (o >> 4) & 15, h2 = o & 15; float s = 0.f;
        for (int p = 0; p < 64; ++p) { const float cr = Cr[h * 64 + p], ci = Ci[h * 64 + p], lr = LPr[tau * 64 + p], li = LPi[tau * 64 + p]; const float wr = cr * lr - ci * li, wi = cr * li + ci * lr; s += wr * Bbr[p * 16 + h2] - wi * Bbi[p * 16 + h2]; }
        KT[(size_t)g * 16384 + o] = (bf16)(cvtpk(s, 0.f) & 0xffffu); }
    for (int e = tid; e < 131072; e += 512) { const int j = e & 7, ln = (e >> 3) & 63, s = (e >> 9) & 63, mt = e >> 15; const int r = mt * 32 + (ln & 31), h = 8 * (ln >> 5) + j, p = r & 63;
        const float lr = LPr[(63 - s) * 64 + p], li = LPi[(63 - s) * 64 + p], br = Bbr[p * 16 + h], bi = Bbi[p * 16 + h]; const float v = (r < 64) ? (lr * br - li * bi) : (lr * bi + li * br);
        MEf[(size_t)g * 131072 + e] = (bf16)(cvtpk(v, 0.f) & 0xffffu); }
    for (int e = tid; e < 131072; e += 512) { const int j = e & 7, ln = (e >> 3) & 63, kr = (e >> 9) & 7, mt = e >> 12; const int rr = ln & 31, t = 2 * mt + (rr >> 4), h = rr & 15, r = kr * 16 + 8 * (ln >> 5) + j, p = r & 63;
        const float cr = Cr[h * 64 + p], ci = Ci[h * 64 + p], lr = LPr[(t + 1) * 64 + p], li = LPi[(t + 1) * 64 + p]; const float v = (r < 64) ? (cr * lr - ci * li) : -(cr * li + ci * lr);
        MCf[(size_t)g * 131072 + e] = (bf16)(cvtpk(v, 0.f) & 0xffffu); }
    __syncthreads();
}

constexpr int ATT_KS_STRIDE = 272, ATT_VS_STRIDE = 528, ATT_VS_OFF = 256 * ATT_KS_STRIDE;
static_assert(ATT_VS_OFF + 128 * ATT_VS_STRIDE <= SCR_BYTES, "attention LDS");
__device__ __forceinline__ void attn_unit(Frame& F, int b, int nb, int kvh, const bf16* Q, const bf16* KB, const bf16* VT, bf16* ATT, const float* sinks) {
    int tid = F.tid; asm volatile("" : "+v"(tid)); const int lane = tid & 63, w = __builtin_amdgcn_readfirstlane(tid >> 6), r = lane & 31, hh = lane >> 5;
    LAS unsigned char* Ks = F.lds; LAS unsigned char* Vs = F.lds + ATT_VS_OFF;
    const int t0 = b * SEQ + nb * 128;
#pragma unroll
    for (int i = 0; i < 8; ++i) { const int idx = tid + 512 * i, j = idx >> 4, ch = idx & 15; int tk = t0 - 128 + j; if (nb == 0 && j < 128) tk = t0 + j;
        const v4u v = *(const GAS v4u*)(KB + (size_t)tk * KVW + kvh * 128 + ch * 8); *(LAS v4u*)(Ks + j * ATT_KS_STRIDE + ch * 16) = v; }
#pragma unroll
    for (int i = 0; i < 8; ++i) { const int idx = tid + 512 * i, d = idx >> 5, ch = idx & 31; int j0 = ch * 8; int srcj = nb * 128 - 128 + j0; if (nb == 0 && j0 < 128) srcj = j0;
        const v4u v = *(const GAS v4u*)(VT + ((size_t)((b * 4 + kvh) * 128 + d)) * SEQ + srcj); *(LAS v4u*)(Vs + d * ATT_VS_STRIDE + ch * 16) = v; }
    __syncthreads();
    const int hq = kvh * 4 + (w >> 1), hw = w & 1;
    const float slope = exp2f(-0.5f * (float)(hq + 1)), sink = sinks[hq];
#pragma unroll 1
    for (int qt = 0; qt < 2; ++qt) {
        const int qrow = hw * 64 + qt * 32 + r; const size_t tq = (size_t)(t0 + qrow);
        bf16x8 qf[8];
#pragma unroll
        for (int ks = 0; ks < 8; ++ks) qf[ks] = *(const GAS bf16x8*)(Q + tq * ATTW + hq * 128 + ks * 16 + 8 * hh);
        f32x16 S[6];
#pragma unroll
        for (int k6 = 0; k6 < 6; ++k6) { S[k6] = (f32x16){0.f};
            const int kt = 2 * hw + k6;
#pragma unroll
            for (int ks = 0; ks < 8; ++ks) { const bf16x8 a = *(const LAS bf16x8*)(Ks + (kt * 32 + r) * ATT_KS_STRIDE + ks * 32 + hh * 16); S[k6] = __builtin_amdgcn_mfma_f32_32x32x16_bf16(a, qf[ks], S[k6], 0, 0, 0); }
            asm volatile("" ::: "memory"); }
        float mx = sink;
#pragma unroll
        for (int k6 = 0; k6 < 6; ++k6)
#pragma unroll
            for (int rg = 0; rg < 16; ++rg) { const int j = (2 * hw + k6) * 32 + (rg & 3) + 8 * (rg >> 2) + 4 * hh; const int dist = qrow - j + 128;
                const bool valid = (dist >= 0) && (dist < 128) && (nb > 0 || j >= 128);
                const float lg = valid ? (S[k6][rg] - slope * (float)dist) : -1e30f; S[k6][rg] = lg; mx = fmaxf(mx, lg); }
        mx = fmaxf(mx, __shfl_xor(mx, 32));
        float sum = 0.f;
#pragma unroll
        for (int k6 = 0; k6 < 6; ++k6)
#pragma unroll
            for (int rg = 0; rg < 16; ++rg) { const float p = __expf(S[k6][rg] - mx); S[k6][rg] = p; sum += p; }
        sum += __shfl_xor(sum, 32); sum += __expf(sink - mx);
        const float inv = 1.0f / sum;
        f32x16 O[4];
#pragma unroll
        for (int dt = 0; dt < 4; ++dt) O[dt] = (f32x16){0.f};
#pragma unroll
        for (int k6 = 0; k6 < 6; ++k6)
#pragma unroll
            for (int s2 = 0; s2 < 2; ++s2) { v4u pw; pw.x = cvtpk(S[k6][8 * s2 + 0], S[k6][8 * s2 + 1]); pw.y = cvtpk(S[k6][8 * s2 + 2], S[k6][8 * s2 + 3]); pw.z = cvtpk(S[k6][8 * s2 + 4], S[k6][8 * s2 + 5]); pw.w = cvtpk(S[k6][8 * s2 + 6], S[k6][8 * s2 + 7]);
                const bf16x8 pb = __builtin_bit_cast(bf16x8, pw); const int key0 = (2 * hw + k6) * 32 + 16 * s2 + 4 * hh;
#pragma unroll
                for (int dt = 0; dt < 4; ++dt) { const LAS unsigned char* vp = Vs + (dt * 32 + r) * ATT_VS_STRIDE + key0 * 2; const u32x2 a0 = *(const LAS u32x2*)vp, a1 = *(const LAS u32x2*)(vp + 16);
                    v4u aw; aw.x = a0.x; aw.y = a0.y; aw.z = a1.x; aw.w = a1.y; O[dt] = __builtin_amdgcn_mfma_f32_32x32x16_bf16(__builtin_bit_cast(bf16x8, aw), pb, O[dt], 0, 0, 0); }
                asm volatile("" ::: "memory"); }
        bf16* orow = ATT + tq * ATTW + hq * 128;
#pragma unroll
        for (int dt = 0; dt < 4; ++dt)
#pragma unroll
            for (int g4 = 0; g4 < 4; ++g4) { u32x2 o; o.x = cvtpk(O[dt][4 * g4 + 0] * inv, O[dt][4 * g4 + 1] * inv); o.y = cvtpk(O[dt][4 * g4 + 2] * inv, O[dt][4 * g4 + 3] * inv);
                *(GAS u32x2*)(orow + dt * 32 + 8 * g4 + 4 * hh) = o; }
    }
    __syncthreads();
}

constexpr int S5_US_STRIDE = 2064, S5_ES_OFF = 32 * S5_US_STRIDE, S5_XS_OFF = S5_ES_OFF + 2 * 128 * 33 * 4, S5_XS_STRIDE = 272;
static_assert(S5_XS_OFF + 32 * S5_XS_STRIDE <= SCR_BYTES && 2 * 128 * 33 * 4 >= 32768, "S5 LDS");
__device__ __forceinline__ void s5_unit(Frame& F, int b, int g, const bf16* U, const bf16* KT, const bf16* MEf, const bf16* MCf, const float* LAM, const float* dskip, bf16* Z) {
    int tid = F.tid; asm volatile("" : "+v"(tid)); const int lane = tid & 63, w = __builtin_amdgcn_readfirstlane(tid >> 6), r = lane & 31, hh = lane >> 5;
    LAS unsigned char* Us = F.lds; LAS float* Es = (LAS float*)(F.lds + S5_ES_OFF); LAS unsigned char* Kt = F.lds + S5_ES_OFF; LAS unsigned char* Xs = F.lds + S5_XS_OFF;
#pragma unroll
    for (int i = 0; i < 8; ++i) { const int idx = tid + 512 * i, t = idx >> 1, half = idx & 1;
        const v4u v = *(const GAS v4u*)(U + ((size_t)(b * SEQ + t)) * SSMW + g * 16 + half * 8); *(LAS v4u*)(Us + (t >> 6) * S5_US_STRIDE + (t & 63) * 32 + half * 16) = v; }
    __syncthreads();
    {
        const int mtile = w & 3, sh = w >> 2; f32x16 acc = (f32x16){0.f};
        const bf16* mep = MEf + ((size_t)(g * 4 + mtile) * 64 + sh * 32) * 512 + lane * 8;
#pragma unroll 8
        for (int s2 = 0; s2 < 32; ++s2) { const bf16x8 a = *(const GAS bf16x8*)(mep + (size_t)s2 * 512);
            const bf16x8 bb = *(const LAS bf16x8*)(Us + r * S5_US_STRIDE + (sh * 32 + s2) * 32 + hh * 16); acc = __builtin_amdgcn_mfma_f32_32x32x16_bf16(a, bb, acc, 0, 0, 0); }
#pragma unroll
        for (int rg = 0; rg < 16; ++rg) { const int row = mtile * 32 + (rg & 3) + 8 * (rg >> 2) + 4 * hh; Es[(sh * 128 + row) * 33 + r] = acc[rg]; }
    }
    __syncthreads();
    if (tid < 64) {
        const int p = tid; const float lr = LAM[(g * 64 + p) * 2], li = LAM[(g * 64 + p) * 2 + 1]; float xr = 0.f, xi = 0.f;
        for (int c = 0; c < 32; ++c) {
            *(LAS bf16*)(Xs + c * S5_XS_STRIDE + p * 2) = (bf16)(cvtpk(xr, 0.f) & 0xffffu); *(LAS bf16*)(Xs + c * S5_XS_STRIDE + (64 + p) * 2) = (bf16)(cvtpk(xi, 0.f) & 0xffffu);
            const float er = Es[p * 33 + c] + Es[(128 + p) * 33 + c], ei = Es[(64 + p) * 33 + c] + Es[(128 + 64 + p) * 33 + c];
            const float nr = lr * xr - li * xi + er, ni = lr * xi + li * xr + ei; xr = nr; xi = ni; }
    }
    __syncthreads();
#pragma unroll
    for (int i = 0; i < 4; ++i) { const int idx = tid + 512 * i; *(LAS v4u*)(Kt + idx * 16) = *(const GAS v4u*)(KT + (size_t)g * 16384 + idx * 8); }
    __syncthreads();
#pragma unroll 1
    for (int q = 0; q < 4; ++q) {
        const int mt = (q == 0) ? w : (q == 1) ? 15 - w : (q == 2) ? 16 + w : 31 - w;
        const int tl = 2 * mt + (r >> 4), h = r & 15; f32x16 acc = (f32x16){0.f};
        for (int s = 0; s <= 2 * mt + 1; ++s) { const int tau = tl - s; const int tc = tau < 0 ? 0 : tau;
            bf16x8 a = *(const LAS bf16x8*)(Kt + tc * 512 + h * 32 + hh * 16); if (tau < 0) a = (bf16x8){0, 0, 0, 0, 0, 0, 0, 0};
            const bf16x8 bb = *(const LAS bf16x8*)(Us + r * S5_US_STRIDE + s * 32 + hh * 16); acc = __builtin_amdgcn_mfma_f32_32x32x16_bf16(a, bb, acc, 0, 0, 0); }
        const bf16* mcp = MCf + ((size_t)(g * 32 + mt) * 8) * 512 + lane * 8;
#pragma unroll
        for (int kr = 0; kr < 8; ++kr) { const bf16x8 a = *(const GAS bf16x8*)(mcp + (size_t)kr * 512);
            const bf16x8 bb = *(const LAS bf16x8*)(Xs + r * S5_XS_STRIDE + kr * 32 + hh * 16); acc = __builtin_amdgcn_mfma_f32_32x32x16_bf16(a, bb, acc, 0, 0, 0); }
#pragma unroll
        for (int g4 = 0; g4 < 4; ++g4) { const int ts = 2 * mt + (g4 >> 1), h0 = 8 * (g4 & 1) + 4 * hh;
            const u32x2 uu = *(const LAS u32x2*)(Us + r * S5_US_STRIDE + ts * 32 + h0 * 2); const f32x4 dd = *(const GAS f32x4*)(dskip + g * 16 + h0);
            const float y0 = acc[4 * g4 + 0] + dd.x * bflo(uu.x), y1 = acc[4 * g4 + 1] + dd.y * bfhi(uu.x), y2 = acc[4 * g4 + 2] + dd.z * bflo(uu.y), y3 = acc[4 * g4 + 3] + dd.w * bfhi(uu.y);
            u32x2 o; o.x = cvtpk(gelu_tanh(y0), gelu_tanh(y1)); o.y = cvtpk(gelu_tanh(y2), gelu_tanh(y3));
            *(GAS u32x2*)(Z + ((size_t)(b * SEQ + r * 64 + ts)) * SSMW + g * 16 + h0) = o; }
    }
    __syncthreads();
}

constexpr float NEGBIG = -3.0e38f;
__device__ __forceinline__ float max64(const float (&v)[64]) {
    float m[32];
#pragma unroll
    for (int i = 0; i < 32; ++i) m[i] = fmaxf(v[2 * i], v[2 * i + 1]);
#pragma unroll
    for (int st = 16; st >= 1; st >>= 1)
#pragma unroll
        for (int i = 0; i < st; ++i) m[i] = fmaxf(m[i], m[i + st]);
    return m[0];
}
__device__ __forceinline__ void topk_task(int task, int lane, const bf16* PQ, const bf16* KEYS, int* EID, float* GATE) {
    asm volatile("" : "+v"(lane));
    const int tt = task >> 3, h = task & 7, r = lane & 31, hh = lane >> 5; const size_t token = (size_t)tt * 32 + r;
    float sv[2][16];
#pragma unroll
    for (int c = 0; c < 2; ++c) {
        bf16x8 qf[8];
#pragma unroll
        for (int ks = 0; ks < 8; ++ks) qf[ks] = *(const GAS bf16x8*)(PQ + token * (PH * PDK) + h * PDK + c * 128 + ks * 16 + 8 * hh);
        float v[64];
#pragma unroll
        for (int mt = 0; mt < 4; ++mt) { f32x16 acc = (f32x16){0.f};
#pragma unroll
            for (int ks = 0; ks < 8; ++ks) { const bf16x8 a = *(const GAS bf16x8*)(KEYS + ((size_t)((h * 2 + c) * 128 + mt * 32 + r)) * 128 + ks * 16 + 8 * hh); acc = __builtin_amdgcn_mfma_f32_32x32x16_bf16(a, qf[ks], acc, 0, 0, 0); }
#pragma unroll
            for (int rg = 0; rg < 16; ++rg) { const unsigned n = (unsigned)(mt * 32 + (rg & 3) + 8 * (rg >> 2) + 4 * hh); v[mt * 16 + rg] = __uint_as_float((__float_as_uint(acc[rg]) & ~127u) | n); }
            asm volatile("" ::: "memory"); }
#pragma unroll
        for (int k = 0; k < 16; ++k) { float m = max64(v); m = fmaxf(m, __shfl_xor(m, 32)); sv[c][k] = m;
#pragma unroll
            for (int i = 0; i < 64; ++i) v[i] = (v[i] == m) ? NEGBIG : v[i]; }
    }
    float cand[50]; int ceid[50];
    { int q = 0;
#pragma unroll
      for (int i = 0; i < 16; ++i)
#pragma unroll
        for (int j = 0; j < 16; ++j) if ((i + 1) * (j + 1) <= 16) {
            const unsigned bi = __float_as_uint(sv[0][i]), bj = __float_as_uint(sv[1][j]);
            const float s = __uint_as_float(bi & ~127u) + __uint_as_float(bj & ~127u);
            cand[q] = __uint_as_float((__float_as_uint(s) & ~63u) | (unsigned)q); ceid[q] = (int)((bi & 127u) * 128u + (bj & 127u)); ++q; } }
    float ws[16]; int we[16];
#pragma unroll
    for (int k = 0; k < 16; ++k) { float m = cand[0];
#pragma unroll
        for (int q = 1; q < 50; ++q) m = fmaxf(m, cand[q]);
        int e = 0;
#pragma unroll
        for (int q = 0; q < 50; ++q) { const bool is = (cand[q] == m); e = is ? ceid[q] : e; cand[q] = is ? NEGBIG : cand[q]; }
        ws[k] = __uint_as_float(__float_as_uint(m) & ~63u); we[k] = e; }
    const float s0 = ws[0];
    float ex[16]; float sum = 0.f;
#pragma unroll
    for (int k = 0; k < 16; ++k) { ex[k] = __expf(ws[k] - s0); sum += ex[k]; }
    const float inv = 1.0f / sum;
    int eo[8]; float go[8];
#pragma unroll
    for (int k = 0; k < 8; ++k) { eo[k] = hh ? we[k + 8] : we[k]; go[k] = (hh ? ex[k + 8] : ex[k]) * inv; }
    int* ep = EID + token * PSEL + h * 16 + hh * 8; float* gp = GATE + token * PSEL + h * 16 + hh * 8;
    *(GAS i32x4*)ep = (i32x4){eo[0], eo[1], eo[2], eo[3]}; *(GAS i32x4*)(ep + 4) = (i32x4){eo[4], eo[5], eo[6], eo[7]};
    *(GAS f32x4*)gp = (f32x4){go[0], go[1], go[2], go[3]}; *(GAS f32x4*)(gp + 4) = (f32x4){go[4], go[5], go[6], go[7]};
}

#define ROWLOAD(dst, tab, e) do { const GAS v4u* _p = (const GAS v4u*)((tab) + (size_t)(e) * DM) + lane; _Pragma("unroll") for (int _i = 0; _i < 8; ++_i) dst[_i] = _p[64 * _i]; } while (0)
__device__ __forceinline__ float dotrow(const v4u (&a)[8], const v4u (&x)[8]) {
    float s0 = 0.f, s1 = 0.f, s2 = 0.f, s3 = 0.f;
#pragma unroll
    for (int i = 0; i < 8; ++i) { s0 = dot2bf(a[i].x, x[i].x, s0); s1 = dot2bf(a[i].y, x[i].y, s1); s2 = dot2bf(a[i].z, x[i].z, s2); s3 = dot2bf(a[i].w, x[i].w, s3); }
    return (s0 + s1) + (s2 + s3);
}
#define HALFLOAD(dst, tab, e, hf) do { const GAS v4u* _p = (const GAS v4u*)((tab) + (size_t)(e) * DM) + lane + 256 * (hf); _Pragma("unroll") for (int _i = 0; _i < 4; ++_i) dst[_i] = _p[64 * _i]; } while (0)
template <int HF> __device__ __forceinline__ void vhalf(float (&acc)[64], const v4u (&r0)[4], const v4u (&r1)[4], unsigned apk) {
#pragma unroll
    for (int i = 0; i < 4; ++i) {
        const unsigned x[4] = {r0[i].x, r0[i].y, r0[i].z, r0[i].w}, y[4] = {r1[i].x, r1[i].y, r1[i].z, r1[i].w};
#pragma unroll
        for (int q = 0; q < 4; ++q) { const unsigned lo = __builtin_amdgcn_perm(y[q], x[q], 0x05040100u), hi = __builtin_amdgcn_perm(y[q], x[q], 0x07060302u);
            acc[(4 * HF + i) * 8 + 2 * q] = dot2bf(lo, apk, acc[(4 * HF + i) * 8 + 2 * q]); acc[(4 * HF + i) * 8 + 2 * q + 1] = dot2bf(hi, apk, acc[(4 * HF + i) * 8 + 2 * q + 1]); } }
}
template <bool LAST>
__device__ __forceinline__ void gather_token(size_t token, int lane, const bf16* HN, const int* EID, const float* GATE, const bf16* UT, const bf16* VTB, float* X, const float* gnext, bf16* XNout) {
    asm volatile("" : "+v"(lane));
    const int hh = lane >> 5, b4 = (lane >> 4) & 1, b3 = (lane >> 3) & 1, b2 = (lane >> 2) & 1;
    v4u hn[8];
    { const GAS v4u* p = (const GAS v4u*)(HN + token * DM) + lane;
#pragma unroll
      for (int i = 0; i < 8; ++i) hn[i] = p[64 * i]; }
    const i32x2 ee = *(const GAS i32x2*)(EID + token * PSEL + 2 * lane); const f32x2 gg = *(const GAS f32x2*)(GATE + token * PSEL + 2 * lane);
    const int e0 = ee.x, e1 = ee.y;
    float sc0 = 0.f, sc1 = 0.f;
#pragma unroll 1
    for (int kb = 0; kb < 8; ++kb) {
        float part[16]; v4u A[8], B[8];
        { const int ea = __builtin_amdgcn_readlane(e0, kb * 8); ROWLOAD(A, UT, ea); }
#pragma unroll
        for (int kk = 0; kk < 16; kk += 2) {
            { const int eb = __builtin_amdgcn_readlane(e1, kb * 8 + (kk >> 1)); ROWLOAD(B, UT, eb); }
            part[kk] = dotrow(A, hn);
            if (kk + 2 < 16) { const int ea = __builtin_amdgcn_readlane(e0, kb * 8 + (kk >> 1) + 1); ROWLOAD(A, UT, ea); }
            part[kk + 1] = dotrow(B, hn);
        }
        float p8[8], p4[4], p2[2];
#pragma unroll
        for (int i = 0; i < 8; ++i) { const float send = hh ? part[i] : part[i + 8], keep = hh ? part[i + 8] : part[i]; p8[i] = keep + __shfl_xor(send, 32); }
#pragma unroll
        for (int i = 0; i < 4; ++i) { const float send = b4 ? p8[i] : p8[i + 4], keep = b4 ? p8[i + 4] : p8[i]; p4[i] = keep + __shfl_xor(send, 16); }
#pragma unroll
        for (int i = 0; i < 2; ++i) { const float send = b3 ? p4[i] : p4[i + 2], keep = b3 ? p4[i + 2] : p4[i]; p2[i] = keep + __shfl_xor(send, 8); }
        float p1; { const float send = b2 ? p2[0] : p2[1], keep = b2 ? p2[1] : p2[0]; p1 = keep + __shfl_xor(send, 4); }
        p1 += __shfl_xor(p1, 2); p1 += __shfl_xor(p1, 1);
        const float v0 = __shfl(p1, 8 * (lane & 7)), v1 = __shfl(p1, 8 * (lane & 7) + 4);
        if ((lane >> 3) == kb) { sc0 = v0; sc1 = v1; }
    }
    const unsigned apk_l = cvtpk(gelu_tanh(sc0) * gg.x, gelu_tanh(sc1) * gg.y);
    float acc[64];
#pragma unroll
    for (int i = 0; i < 64; ++i) acc[i] = 0.f;
    {
        v4u A0[4], A1[4], B0[4], B1[4];
        { const int ea = __builtin_amdgcn_readlane(e0, 0), eb = __builtin_amdgcn_readlane(e1, 0); HALFLOAD(A0, VTB, ea, 0); HALFLOAD(A1, VTB, eb, 0); }
#pragma unroll 1
        for (int kp = 0; kp < 64; ++kp) {
            const unsigned apk = (unsigned)__builtin_amdgcn_readlane((int)apk_l, kp);
            { const int ea = __builtin_amdgcn_readlane(e0, kp), eb = __builtin_amdgcn_readlane(e1, kp); HALFLOAD(B0, VTB, ea, 1); HALFLOAD(B1, VTB, eb, 1); }
            vhalf<0>(acc, A0, A1, apk);
            if (kp + 1 < 64) { const int ea = __builtin_amdgcn_readlane(e0, kp + 1), eb = __builtin_amdgcn_readlane(e1, kp + 1); HALFLOAD(A0, VTB, ea, 0); HALFLOAD(A1, VTB, eb, 0); }
            vhalf<1>(acc, B0, B1, apk);
        }
    }
    float* xrow = X + token * DM + lane * 8; float ss = 0.f;
#pragma unroll
    for (int i = 0; i < 8; ++i) { const f32x4 xa = *(const GAS f32x4*)(xrow + i * 512), xb = *(const GAS f32x4*)(xrow + i * 512 + 4);
        acc[i * 8 + 0] += xa.x; acc[i * 8 + 1] += xa.y; acc[i * 8 + 2] += xa.z; acc[i * 8 + 3] += xa.w; acc[i * 8 + 4] += xb.x; acc[i * 8 + 5] += xb.y; acc[i * 8 + 6] += xb.z; acc[i * 8 + 7] += xb.w;
#pragma unroll
        for (int e = 0; e < 8; ++e) ss += acc[i * 8 + e] * acc[i * 8 + e];
        if (!LAST) { *(GAS f32x4*)(xrow + i * 512) = (f32x4){acc[i * 8 + 0], acc[i * 8 + 1], acc[i * 8 + 2], acc[i * 8 + 3]}; *(GAS f32x4*)(xrow + i * 512 + 4) = (f32x4){acc[i * 8 + 4], acc[i * 8 + 5], acc[i * 8 + 6], acc[i * 8 + 7]}; } }
    const float rstd = 1.0f / sqrtf(wave_sum(ss) * (1.f / DM) + NORM_EPS);
#pragma unroll
    for (int i = 0; i < 8; ++i) { const f32x4 ga = *(const GAS f32x4*)(gnext + i * 512 + lane * 8), gb = *(const GAS f32x4*)(gnext + i * 512 + lane * 8 + 4);
        const float y0 = acc[i * 8 + 0] * rstd * ga.x, y1 = acc[i * 8 + 1] * rstd * ga.y, y2 = acc[i * 8 + 2] * rstd * ga.z, y3 = acc[i * 8 + 3] * rstd * ga.w;
        const float y4 = acc[i * 8 + 4] * rstd * gb.x, y5 = acc[i * 8 + 5] * rstd * gb.y, y6 = acc[i * 8 + 6] * rstd * gb.z, y7 = acc[i * 8 + 7] * rstd * gb.w;
        if (LAST) { *(GAS f32x4*)(xrow + i * 512) = (f32x4){y0, y1, y2, y3}; *(GAS f32x4*)(xrow + i * 512 + 4) = (f32x4){y4, y5, y6, y7}; }
        else { v4u o; o.x = cvtpk(y0, y1); o.y = cvtpk(y2, y3); o.z = cvtpk(y4, y5); o.w = cvtpk(y6, y7); *(GAS v4u*)(XNout + token * DM + i * 512 + lane * 8) = o; } }
}

struct Args { const float* in[22]; float* out; unsigned char* ws; int ph_lo, ph_hi; };
__global__ void __launch_bounds__(NWAVES * 64, 2) hybrid_fwd(Args args) {
    extern __shared__ __attribute__((aligned(16))) unsigned char lds[];
    Frame F;
    F.lds = (LAS unsigned char*)lds; F.MISC = (volatile LAS unsigned*)(F.lds + MISC_OFF);
    F.tid = threadIdx.x; F.lane = F.tid & 63; F.wave = __builtin_amdgcn_readfirstlane(F.tid >> 6); F.G = gridDim.x; F.ws = args.ws;
    F.ctl = (gu32*)(args.ws + WS_CTL);
    for (int u = F.tid; u < (LDS_BYTES - LDSCTL_OFF) / 4; u += NWAVES * 64) ((LAS unsigned*)(F.lds + LDSCTL_OFF))[u] = 0u;
    __syncthreads();
    const int lo = args.ph_lo, hi = args.ph_hi;
    const bool use_bar = (hi - lo) > 1;
    XcdBarrier bar; bar.bar = (unsigned*)(F.ctl + CW_BAR); bar.x = 0; bar.st = nullptr;
    if (use_bar) bar = xcd_barrier_post((unsigned*)(F.ctl + CW_BAR), F.MISC + 8);
#ifndef PHSUB
#define PHSUB 3
#endif
#ifndef PHMASK
#define PHMASK 0x3ff
#endif
#define IN(k) (lo <= (k) && (k) < hi)
#define SEAM(k) do { if (IN(k) && IN((k) + 1)) xcd_barrier(bar); } while (0)
    unsigned char* ws = args.ws;
    const float* x_in = args.in[0];
    float* X = args.out;
    bf16* XN = (bf16*)(ws + WS_XN); bf16* Qb = (bf16*)(ws + WS_Q); bf16* KBb = (bf16*)(ws + WS_KB); bf16* VTb = (bf16*)(ws + WS_VT); bf16* Ub = (bf16*)(ws + WS_U);
    bf16* GA = (bf16*)(ws + WS_GA); bf16* GS = (bf16*)(ws + WS_GS); bf16* ATT = (bf16*)(ws + WS_ATT); bf16* Zb = (bf16*)(ws + WS_Z); bf16* SSb = (bf16*)(ws + WS_SS);
    bf16* MG = (bf16*)(ws + WS_MG); bf16* PQ = (bf16*)(ws + WS_PQ); bf16* HN = (bf16*)(ws + WS_HN); int* EID = (int*)(ws + WS_EID); float* GATE = (float*)(ws + WS_GATE);
    const int gw = blockIdx.x * NWAVES + F.wave, NGW = F.G * NWAVES;

    if (((PHMASK >> 0) & 1) && IN(0)) {
        LAS float* scr = (LAS float*)(F.lds + F.wave * 16384);
        for (int l = 0; l < DEPTH; ++l) {
            unsigned char* lw = ws + WS_LW + (size_t)l * LW_SIZE;
            constexpr int I_IN = (DM / 64) * (INCOLS / 32), I_AB = (ATTW / 64) * (DM / 32), I_SB = (SSMW / 64) * (DM / 32), I_OUT = (DM / 64) * (DM / 32), I_GLU = (SSMW / 64) * (2 * SSMW / 32), I_PQ = (DM / 64) * (PH * PDK / 32);
            constexpr int NIT = I_IN + I_AB + I_SB + I_OUT + I_GLU + I_PQ;
            for (int it = gw; it < NIT; it += NGW) {
                int r = it;
                if (r < I_IN) { p0_transpose_item(args.in[2] + (size_t)l * DM * INCOLS, DM, INCOLS, (bf16*)(lw + LW_WIN), false, scr, r, F.lane); continue; } r -= I_IN;
                if (r < I_AB) { p0_transpose_item(args.in[13] + (size_t)l * ATTW * DM, ATTW, DM, (bf16*)(lw + LW_WAB), false, scr, r, F.lane); continue; } r -= I_AB;
                if (r < I_SB) { p0_transpose_item(args.in[14] + (size_t)l * SSMW * DM, SSMW, DM, (bf16*)(lw + LW_WSB), false, scr, r, F.lane); continue; } r -= I_SB;
                if (r < I_OUT) { p0_transpose_item(args.in[15] + (size_t)l * DM * DM, DM, DM, (bf16*)(lw + LW_WOUT), false, scr, r, F.lane); continue; } r -= I_OUT;
                if (r < I_GLU) { p0_transpose_item(args.in[11] + (size_t)l * SSMW * 2 * SSMW, SSMW, 2 * SSMW, (bf16*)(lw + LW_WGLU), true, scr, r, F.lane); continue; } r -= I_GLU;
                p0_transpose_item(args.in[17] + (size_t)l * DM * PH * PDK, DM, PH * PDK, (bf16*)(lw + LW_WPQ), false, scr, r, F.lane);
            }
            constexpr size_t NT = (size_t)NEXP * DM / 512, NK = (size_t)PH * 2 * NKEYS * 128 / 512;
            for (size_t st = gw; st < 2 * NT + NK; st += NGW) {
                const float* src; bf16* dst; size_t s2 = st;
                if (s2 < NT) { src = args.in[19] + (size_t)l * NEXP * DM; dst = (bf16*)(lw + LW_UTAB); }
                else if (s2 < 2 * NT) { s2 -= NT; src = args.in[20] + (size_t)l * NEXP * DM; dst = (bf16*)(lw + LW_VTAB); }
                else { s2 -= 2 * NT; src = args.in[18] + (size_t)l * PH * 2 * NKEYS * 128; dst = (bf16*)(lw + LW_KEYS); }
                const size_t e = s2 * 512 + F.lane * 8; const f32x4 a = *(const GAS f32x4*)(src + e), b = *(const GAS f32x4*)(src + e + 4);
                v4u o; o.x = cvtpk(a.x, a.y); o.y = cvtpk(a.z, a.w); o.z = cvtpk(b.x, b.y); o.w = cvtpk(b.z, b.w); *(GAS v4u*)(dst + e) = o;
            }
        }
        for (int m = gw; m < M; m += NGW) rms_row_to_bf16(x_in + (size_t)m * DM, args.in[1], XN + (size_t)m * DM, F.lane);
        __syncthreads();
        for (int it = blockIdx.x; it < DEPTH * SSMG; it += F.G) { const int l = it / SSMG, g = it % SSMG; unsigned char* lw = ws + WS_LW + (size_t)l * LW_SIZE;
            s5_precompute(F, args.in[3] + l * SSMG * 64, args.in[4] + l * SSMG * 64, args.in[5] + l * SSMG, args.in[6] + (size_t)l * SSMG * 1024, args.in[7] + (size_t)l * SSMG * 1024,
                          args.in[8] + (size_t)l * SSMG * 1024, args.in[9] + (size_t)l * SSMG * 1024, g, (bf16*)(lw + LW_S5K), (bf16*)(lw + LW_S5ME), (bf16*)(lw + LW_S5MC), (float*)(lw + LW_S5LAM)); }
    }
    SEAM(0);

#pragma unroll 1
    for (int l = 0; l < DEPTH; ++l) {
        const int pb = 1 + l * NPH_LAYER;
        unsigned char* lw = ws + WS_LW + (size_t)l * LW_SIZE;
        if (((PHMASK >> 1) & 1) && IN(pb + 0)) {
            pg8::Gemm g{XN, (const bf16*)(lw + LW_WIN), M, INCOLS, DM}; pg8::StaticOrder S; S.init(M, INCOLS, F.G, (int)blockIdx.x);
            pg8::EpiIn E{Qb, KBb, VTb, Ub, GA, GS};
            pg8::gemm_phase<pg8::EpiIn, pg8::StaticOrder, true, true>(F.lds, g, S, E);
        }
        SEAM(pb + 0);
        if (((PHMASK >> 2) & 1) && IN(pb + 1)) {
            for (int u = blockIdx.x; u < 1024; u += F.G) {
                if (u < 512) { if (PHSUB & 1) attn_unit(F, u >> 6, (u >> 2) & 15, u & 3, Qb, KBb, VTb, ATT, args.in[12] + l * NQH); }
                else if (PHSUB & 2) { const int v = u - 512; s5_unit(F, v >> 6, v & 63, Ub, (const bf16*)(lw + LW_S5K), (const bf16*)(lw + LW_S5ME), (const bf16*)(lw + LW_S5MC), (const float*)(lw + LW_S5LAM), args.in[10] + l * SSMW, Zb); }
            }
        }
        SEAM(pb + 1);
        if (((PHMASK >> 3) & 1) && IN(pb + 2)) {
            pg8::Gemm g{Zb, (const bf16*)(lw + LW_WGLU), M, 2 * SSMW, SSMW}; pg8::StaticOrder S; S.init(M, 2 * SSMW, F.G, (int)blockIdx.x);
            pg8::EpiGlu E{SSb, SSMW};
            pg8::gemm_phase<pg8::EpiGlu, pg8::StaticOrder, true, true>(F.lds, g, S, E);
        }
        SEAM(pb + 2);
        if (((PHMASK >> 4) & 1) && IN(pb + 3)) {
            { pg8::Gemm g{ATT, (const bf16*)(lw + LW_WAB), M, DM, ATTW}; pg8::StaticOrder S; S.init(M, DM, F.G, (int)blockIdx.x); pg8::EpiGate<false> E{MG, GA, DM};
              pg8::gemm_phase<pg8::EpiGate<false>, pg8::StaticOrder, true, true>(F.lds, g, S, E); }
            { pg8::Gemm g{SSb, (const bf16*)(lw + LW_WSB), M, DM, SSMW}; pg8::StaticOrder S; S.init(M, DM, F.G, (int)blockIdx.x); pg8::EpiGate<true> E{MG, GS, DM};
              pg8::gemm_phase<pg8::EpiGate<true>, pg8::StaticOrder, true, true>(F.lds, g, S, E); }
        }
        SEAM(pb + 3);
        if (((PHMASK >> 5) & 1) && IN(pb + 4)) {
            pg8::Gemm g{MG, (const bf16*)(lw + LW_WOUT), M, DM, DM}; pg8::StaticOrder S; S.init(M, DM, F.G, (int)blockIdx.x);
            pg8::EpiRes E{l == 0 ? x_in : (const float*)X, X, DM};
            pg8::gemm_phase<pg8::EpiRes, pg8::StaticOrder, true, true>(F.lds, g, S, E);
        }
        SEAM(pb + 4);
        if (((PHMASK >> 6) & 1) && IN(pb + 5)) { for (int m = gw; m < M; m += NGW) rms_row_to_bf16(X + (size_t)m * DM, args.in[16] + l * DM, HN + (size_t)m * DM, F.lane); }
        SEAM(pb + 5);
        if (((PHMASK >> 7) & 1) && IN(pb + 6)) {
            pg8::Gemm g{HN, (const bf16*)(lw + LW_WPQ), M, PH * PDK, DM}; pg8::StaticOrder S; S.init(M, PH * PDK, F.G, (int)blockIdx.x);
            pg8::EpiBf16Plain E{PQ, PH * PDK};
            pg8::gemm_phase<pg8::EpiBf16Plain, pg8::StaticOrder, true, true>(F.lds, g, S, E);
        }
        SEAM(pb + 6);
        if (((PHMASK >> 8) & 1) && IN(pb + 7)) { for (int task = gw; task < (M / 32) * PH; task += NGW) topk_task(task, F.lane, PQ, (const bf16*)(lw + LW_KEYS), EID, GATE); }
        SEAM(pb + 7);
        if (((PHMASK >> 9) & 1) && IN(pb + 8)) {
            if (l + 1 < DEPTH) { for (int m = gw; m < M; m += NGW) gather_token<false>((size_t)m, F.lane, HN, EID, GATE, (const bf16*)(lw + LW_UTAB), (const bf16*)(lw + LW_VTAB), X, args.in[1] + (l + 1) * DM, XN); }
            else { for (int m = gw; m < M; m += NGW) gather_token<true>((size_t)m, F.lane, HN, EID, GATE, (const bf16*)(lw + LW_UTAB), (const bf16*)(lw + LW_VTAB), X, args.in[21], XN); }
        }
        SEAM(pb + 8);
    }
#undef IN
#undef SEAM
}

extern "C" void kernel_launch(void* const* d_in, const int* in_sizes, int n_in, void* d_out, int out_size, void* d_ws, size_t ws_size, hipStream_t stream) {
    static int grid = 0;
    if (grid == 0) {
        if (n_in != 22 || out_size != M * DM || ws_size < WS_END) { fprintf(stderr, "kernel_launch: unexpected shapes (n_in %d out %d ws %zu)\n", n_in, out_size, ws_size); grid = -1; return; }
        int dev = 0, cus = 0, per_cu = 0;
        if (hipGetDevice(&dev) != hipSuccess || hipDeviceGetAttribute(&cus, hipDeviceAttributeMultiprocessorCount, dev) != hipSuccess) { grid = -1; return; }
        if (hipFuncSetAttribute((const void*)hybrid_fwd, hipFuncAttributeMaxDynamicSharedMemorySize, LDS_BYTES) != hipSuccess) { fprintf(stderr, "kernel_launch: hipFuncSetAttribute failed\n"); grid = -1; return; }
        if (hipOccupancyMaxActiveBlocksPerMultiprocessor(&per_cu, (const void*)hybrid_fwd, NWAVES * 64, LDS_BYTES) != hipSuccess || per_cu < 1) fprintf(stderr, "kernel_launch: occupancy query says %d\n", per_cu);
        (void)hipGetLastError();
        grid = cus;
    }
    if (grid < 0) return;
    if (hipMemsetAsync((char*)d_ws + WS_CTL, 0, CTL_ZERO_BYTES, stream) != hipSuccess) return;
    Args a{};
    for (int i = 0; i < 22; ++i) a.in[i] = (const float*)d_in[i];
    a.out = (float*)d_out; a.ws = (unsigned char*)d_ws;
#if MK_ONE_LAUNCH
    a.ph_lo = 0; a.ph_hi = NPHASES;
    hipLaunchKernelGGL(hybrid_fwd, dim3(grid), dim3(NWAVES * 64), LDS_BYTES, stream, a);
#else
    for (int p = 0; p < NPHASES; ++p) { a.ph_lo = p; a.ph_hi = p + 1; hipLaunchKernelGGL(hybrid_fwd, dim3(grid), dim3(NWAVES * 64), LDS_BYTES, stream, a); }
#endif
}
```

```cpp
#include <hip/hip_runtime.h>
#include <cstdio>
#include <cstdint>
namespace pg8 {
#define PG8_LAS __attribute__((address_space(3)))
typedef unsigned short bf16_t;
typedef short bf16x8 __attribute__((ext_vector_type(8)));
typedef float f32x4 __attribute__((ext_vector_type(4)));
typedef unsigned u32x4 __attribute__((ext_vector_type(4)));
typedef int i32x4 __attribute__((ext_vector_type(4)));
constexpr int BM = 256, BK = 64, HALF = 128, HTB = HALF * BK * 2  , STAGE_BYTES = 8 * HTB, NXCD = 8, WGM = 4;

__host__ __device__ __forceinline__ int lds_byte(int r, int c) { const int st = (r >> 4) * 2 + (c >> 5), rr = r & 15, cc = c & 31, ob = rr * 64 + cc * 2; return st * 1024 + (ob ^ (((ob >> 9) & 1) << 5)); }
__host__ __device__ __forceinline__ void stage_rc(int b, int& R, int& C) { const int st = b / 1024, sb = b % 1024, swz = sb ^ (((sb >> 9) & 1) << 5); R = (st >> 1) * 16 + swz / 64; C = (st & 1) * 32 + (swz % 64) / 2; }
__host__ __device__ __forceinline__ int perm32(int rho) { const int n = rho >> 4, i = rho & 15; return 8 * (i >> 2) + 4 * n + (i & 3); }

struct Unit { int pm, pn; };
struct Gemm { const bf16_t* A; const bf16_t* Bt; int M, N, K; };

struct StaticOrder {
    int nM, nN, nwg, G, c;
    __host__ __device__ void init(int M, int N, int G_, int c_) { nM = M / BM; nN = N / BM; nwg = nM * nN; G = G_; c = c_; }
    __host__ __device__ bool next(int i, Unit& u) const {
        const long L = (long)i * G + c; if (L >= nwg) return false;
        int wgid = (int)L; { const int q = nwg / NXCD, r = nwg % NXCD, xcd = wgid % NXCD, off = wgid / NXCD; wgid = (xcd < r ? xcd * (q + 1) : r * (q + 1) + (xcd - r) * q) + off; }
        const int nig = WGM * nN, gid = wgid / nig, fm = gid * WGM, gsz = (nM - fm) < WGM ? (nM - fm) : WGM;
        u.pm = fm + ((wgid % nig) % gsz); u.pn = (wgid % nig) / gsz; return true;
    }
    __device__ __forceinline__ void a_ready(const Unit&) const {}
    __device__ __forceinline__ void done(const Unit&) const {}
};
struct LocalOrder {
    int nN, nloc, rank, xi, nx, nbo;
    __host__ __device__ void init(int N, int nloc_, int rank_, int xi_, int nx_) { nN = N / BM; nloc = nloc_; rank = rank_; xi = xi_; nx = nx_; nbo = (8 - xi + nx - 1) / nx; }
    __host__ __device__ bool next(int i, Unit& u) const {
        const int per = 8 * nN, j = i * nloc + rank; if (j >= nbo * per) return false;
        const int bi = j / per, jj = j % per, b = xi + bi * nx;
        const int nig = WGM * nN, gid = jj / nig, fm = gid * WGM;
        u.pm = 8 * b + fm + (jj % nig) % WGM; u.pn = (jj % nig) / WGM; return true;
    }
    __device__ __forceinline__ void a_ready(const Unit&) const {}
    __device__ __forceinline__ void done(const Unit&) const {}
};
struct LocalWindow : LocalOrder {
    int lo, hi;
    __host__ __device__ bool next(int i, Unit& u) const { return (i + lo < hi) && LocalOrder::next(i + lo, u); }
};

__device__ __forceinline__ unsigned cvt_pk_bf16(float lo, float hi) { unsigned r; asm volatile("v_cvt_pk_bf16_f32 %0, %1, %2" : "=v"(r) : "v"(lo), "v"(hi)); return r; }
__device__ __forceinline__ float bflo(unsigned w) { return __uint_as_float(w << 16); }
__device__ __forceinline__ float bfhi(unsigned w) { return __uint_as_float(w & 0xffff0000u); }
__device__ __forceinline__ float sigmoidf_fast(float x) { return __builtin_amdgcn_rcpf(1.0f + __expf(-x)); }
__device__ __forceinline__ u32x4 pack8(const f32x4 v0, const f32x4 v1) { u32x4 w; w.x = cvt_pk_bf16(v0[0], v0[1]); w.y = cvt_pk_bf16(v0[2], v0[3]); w.z = cvt_pk_bf16(v1[0], v1[1]); w.w = cvt_pk_bf16(v1[2], v1[3]); return w; }

struct EpiBf16Plain {
    static constexpr bool PERM = true, AFTER_DRAIN = false, I8 = false; typedef f32x4 acc_t;
    bf16_t* O; int ldc;
    __device__ __forceinline__ void operator()(const f32x4 (&acc)[2][2][4][2], const Unit& u, int wr, int wc, int fr, int fq) const {
        const int row0 = u.pm * BM + wr * 64 + fr, col0 = u.pn * BM + wc * 32 + 8 * fq;
#pragma unroll
        for (int ai = 0; ai < 2; ++ai)
#pragma unroll
            for (int m = 0; m < 4; ++m) { bf16_t* rowp = O + (size_t)(row0 + ai * HALF + m * 16) * ldc + col0;
#pragma unroll
                for (int bj = 0; bj < 2; ++bj) *(u32x4*)(rowp + bj * HALF) = pack8(acc[ai][bj][m][0], acc[ai][bj][m][1]); }
    }
};
struct EpiBf16Plain8 {
    static constexpr bool PERM = true, AFTER_DRAIN = false, I8 = true; typedef i32x4 acc_t;
    bf16_t* O; int ldc; const float *xs, *wsc;
    __device__ __forceinline__ void operator()(const i32x4 (&acc)[2][2][4][2], const Unit& u, int wr, int wc, int fr, int fq) const {
        const int row0 = u.pm * BM + wr * 64 + fr, col0 = u.pn * BM + wc * 32 + 8 * fq;
#pragma unroll
        for (int ai = 0; ai < 2; ++ai)
#pragma unroll
            for (int m = 0; m < 4; ++m) { bf16_t* rowp = O + (size_t)(row0 + ai * HALF + m * 16) * ldc + col0; const float rs = xs[row0 + ai * HALF + m * 16];
#pragma unroll
                for (int bj = 0; bj < 2; ++bj) { const f32x4 c0 = *(const f32x4*)(wsc + col0 + bj * HALF), c1 = *(const f32x4*)(wsc + col0 + bj * HALF + 4); f32x4 v0, v1;
#pragma unroll
                    for (int i = 0; i < 4; ++i) { v0[i] = (float)acc[ai][bj][m][0][i] * (rs * c0[i]); v1[i] = (float)acc[ai][bj][m][1][i] * (rs * c1[i]); }
                    *(u32x4*)(rowp + bj * HALF) = pack8(v0, v1); } }
    }
};
struct EpiIn {
    static constexpr bool PERM = true, AFTER_DRAIN = false, I8 = false; typedef f32x4 acc_t;
    bf16_t *Q, *KB, *VT, *U, *GA, *GS;
    __device__ __forceinline__ void operator()(const f32x4 (&acc)[2][2][4][2], const Unit& u, int wr, int wc, int fr, int fq) const {
        const int row0 = u.pm * BM + wr * 64 + fr, colw = wc * 32 + 8 * fq; const int pn = u.pn;
        if (pn >= 10 && pn < 12) {
#pragma unroll
            for (int ai = 0; ai < 2; ++ai)
#pragma unroll
                for (int m = 0; m < 4; ++m) { const int row = row0 + ai * HALF + m * 16; const int b = row >> 11, s = row & 2047;
#pragma unroll
                    for (int bj = 0; bj < 2; ++bj) { const int vcol = (pn - 10) * 256 + bj * HALF + colw;
                        bf16_t* base = VT + ((size_t)((b * 4 + (vcol >> 7)) * 128 + (vcol & 127))) * 2048 + s;
#pragma unroll
                        for (int n = 0; n < 2; ++n)
#pragma unroll
                            for (int i = 0; i < 4; ++i) { const unsigned w = cvt_pk_bf16(acc[ai][bj][m][n][i], 0.f); base[(size_t)(4 * n + i) * 2048] = (bf16_t)(w & 0xffffu); } } }
            return;
        }
        bf16_t* O; int ldc, colt; int mode;
        if (pn < 8) { O = Q; ldc = 2048; colt = pn * 256; mode = 1; }
        else if (pn < 10) { O = KB; ldc = 512; colt = (pn - 8) * 256; mode = 0; }
        else if (pn < 16) { O = U; ldc = 1024; colt = (pn - 12) * 256; mode = 0; }
        else if (pn < 32) { O = GA; ldc = 4096; colt = (pn - 16) * 256; mode = 2; }
        else { O = GS; ldc = 4096; colt = (pn - 32) * 256; mode = 2; }
        const float sc = (mode == 1) ? 0.08838834764831845f : 1.0f;
#pragma unroll
        for (int ai = 0; ai < 2; ++ai)
#pragma unroll
            for (int m = 0; m < 4; ++m) { bf16_t* rowp = O + (size_t)(row0 + ai * HALF + m * 16) * ldc + colt + colw;
#pragma unroll
                for (int bj = 0; bj < 2; ++bj) { f32x4 v0 = acc[ai][bj][m][0], v1 = acc[ai][bj][m][1];
                    if (mode == 2) {
#pragma unroll
                        for (int i = 0; i < 4; ++i) { v0[i] = sigmoidf_fast(v0[i]); v1[i] = sigmoidf_fast(v1[i]); } }
                    else { v0 = v0 * sc; v1 = v1 * sc; }
                    *(u32x4*)(rowp + bj * HALF) = pack8(v0, v1); } }
    }
};
struct EpiIn8 {
    static constexpr bool PERM = true, AFTER_DRAIN = false, I8 = true; typedef i32x4 acc_t;
    bf16_t *Q, *KB, *VT, *U, *GA, *GS; const float *xs, *wsc;
    __device__ __forceinline__ void operator()(const i32x4 (&acc)[2][2][4][2], const Unit& u, int wr, int wc, int fr, int fq) const {
        const int row0 = u.pm * BM + wr * 64 + fr, colw = wc * 32 + 8 * fq; const int pn = u.pn;
        if (pn >= 10 && pn < 12) {
#pragma unroll
            for (int ai = 0; ai < 2; ++ai)
#pragma unroll
                for (int m = 0; m < 4; ++m) { const int row = row0 + ai * HALF + m * 16; const int b = row >> 11, s = row & 2047;
#pragma unroll
                    for (int bj = 0; bj < 2; ++bj) { const int vcol = (pn - 10) * 256 + bj * HALF + colw;
                        const float rs = xs[row]; const f32x4 c0 = *(const f32x4*)(wsc + pn * 256 + bj * HALF + colw), c1 = *(const f32x4*)(wsc + pn * 256 + bj * HALF + colw + 4);
                        bf16_t* base = VT + ((size_t)((b * 4 + (vcol >> 7)) * 128 + (vcol & 127))) * 2048 + s;
#pragma unroll
                        for (int n = 0; n < 2; ++n)
#pragma unroll
                            for (int i = 0; i < 4; ++i) { const unsigned w = cvt_pk_bf16((float)acc[ai][bj][m][n][i] * rs * (n ? c1[i] : c0[i]), 0.f); base[(size_t)(4 * n + i) * 2048] = (bf16_t)(w & 0xffffu); } } }
            return;
        }
        bf16_t* O; int ldc, colt; int mode;
        if (pn < 8) { O = Q; ldc = 2048; colt = pn * 256; mode = 1; }
        else if (pn < 10) { O = KB; ldc = 512; colt = (pn - 8) * 256; mode = 0; }
        else if (pn < 16) { O = U; ldc = 1024; colt = (pn - 12) * 256; mode = 0; }
        else if (pn < 32) { O = GA; ldc = 4096; colt = (pn - 16) * 256; mode = 2; }
        else { O = GS; ldc = 4096; colt = (pn - 32) * 256; mode = 2; }
        const float sc = (mode == 1) ? 0.08838834764831845f : 1.0f;
#pragma unroll
        for (int ai = 0; ai < 2; ++ai)
#pragma unroll
            for (int m = 0; m < 4; ++m) { bf16_t* rowp = O + (size_t)(row0 + ai * HALF + m * 16) * ldc + colt + colw; const float rs = xs[row0 + ai * HALF + m * 16];
#pragma unroll
                for (int bj = 0; bj < 2; ++bj) { const f32x4 c0 = *(const f32x4*)(wsc + pn * 256 + bj * HALF + colw), c1 = *(const f32x4*)(wsc + pn * 256 + bj * HALF + colw + 4);
                    f32x4 v0, v1;
#pragma unroll
                    for (int i = 0; i < 4; ++i) { v0[i] = (float)acc[ai][bj][m][0][i] * (rs * c0[i]); v1[i] = (float)acc[ai][bj][m][1][i] * (rs * c1[i]); }
                    if (mode == 2) {
                        unsigned w0 = 0, w1 = 0;
#pragma unroll
                        for (int i = 0; i < 4; ++i) { w0 |= (unsigned)(int)rintf(255.0f * sigmoidf_fast(v0[i])) << (8 * i); w1 |= (unsigned)(int)rintf(255.0f * sigmoidf_fast(v1[i])) << (8 * i); }
                        typedef unsigned u32x2_t __attribute__((ext_vector_type(2))); u32x2_t w; w.x = w0; w.y = w1;
                        *(u32x2_t*)((unsigned char*)O + (size_t)(row0 + ai * HALF + m * 16) * ldc + colt + colw + bj * HALF) = w; }
                    else { v0 = v0 * sc; v1 = v1 * sc; *(u32x4*)(rowp + bj * HALF) = pack8(v0, v1); } } }
    }
};
struct EpiGlu {
    static constexpr bool PERM = true, AFTER_DRAIN = false, I8 = false; typedef f32x4 acc_t;
    bf16_t* O; int ldc;
    __device__ __forceinline__ void operator()(const f32x4 (&acc)[2][2][4][2], const Unit& u, int wr, int wc, int fr, int fq) const {
        const int row0 = u.pm * BM + wr * 64 + fr, col0 = u.pn * HALF + wc * 32 + 8 * fq;
#pragma unroll
        for (int ai = 0; ai < 2; ++ai)
#pragma unroll
            for (int m = 0; m < 4; ++m) { f32x4 v0 = acc[ai][0][m][0], v1 = acc[ai][0][m][1]; const f32x4 g0 = acc[ai][1][m][0], g1 = acc[ai][1][m][1];
#pragma unroll
                for (int i = 0; i < 4; ++i) { v0[i] *= sigmoidf_fast(g0[i]); v1[i] *= sigmoidf_fast(g1[i]); }
                *(u32x4*)(O + (size_t)(row0 + ai * HALF + m * 16) * ldc + col0) = pack8(v0, v1); }
    }
};
template <bool ADD> struct EpiGate {
    static constexpr bool PERM = true, AFTER_DRAIN = false, I8 = false; typedef f32x4 acc_t;
    bf16_t* O; const bf16_t* G; int ldc;
    __device__ __forceinline__ void operator()(const f32x4 (&acc)[2][2][4][2], const Unit& u, int wr, int wc, int fr, int fq) const {
        const int row0 = u.pm * BM + wr * 64 + fr, col0 = u.pn * BM + wc * 32 + 8 * fq;
#pragma unroll
        for (int ai = 0; ai < 2; ++ai)
#pragma unroll
            for (int m = 0; m < 4; ++m) { const size_t off = (size_t)(row0 + ai * HALF + m * 16) * ldc + col0;
#pragma unroll
                for (int bj = 0; bj < 2; ++bj) { const u32x4 g = *(const u32x4*)(G + off + bj * HALF); f32x4 v0 = acc[ai][bj][m][0], v1 = acc[ai][bj][m][1];
                    v0[0] *= bflo(g.x); v0[1] *= bfhi(g.x); v0[2] *= bflo(g.y); v0[3] *= bfhi(g.y); v1[0] *= bflo(g.z); v1[1] *= bfhi(g.z); v1[2] *= bflo(g.w); v1[3] *= bfhi(g.w);
                    if (ADD) { const u32x4 o = *(const u32x4*)(O + off + bj * HALF);
                        v0[0] += bflo(o.x); v0[1] += bfhi(o.x); v0[2] += bflo(o.y); v0[3] += bfhi(o.y); v1[0] += bflo(o.z); v1[1] += bfhi(o.z); v1[2] += bflo(o.w); v1[3] += bfhi(o.w); }
                    *(u32x4*)(O + off + bj * HALF) = pack8(v0, v1); }
                asm volatile("" ::: "memory"); }
    }
};
template <bool ADD> struct EpiGate8 {
    static constexpr bool PERM = true, AFTER_DRAIN = false, I8 = true; typedef i32x4 acc_t;
    bf16_t* O; const bf16_t* G; int ldc; const float *xs, *wsc;
    __device__ __forceinline__ void operator()(const i32x4 (&acc)[2][2][4][2], const Unit& u, int wr, int wc, int fr, int fq) const {
        const int row0 = u.pm * BM + wr * 64 + fr, col0 = u.pn * BM + wc * 32 + 8 * fq;
        f32x4 cs[2][2];
#pragma unroll
        for (int bj = 0; bj < 2; ++bj) { cs[bj][0] = *(const f32x4*)(wsc + col0 + bj * HALF); cs[bj][1] = *(const f32x4*)(wsc + col0 + bj * HALF + 4); }
        typedef unsigned u32x2_t __attribute__((ext_vector_type(2))); const unsigned char* G8 = (const unsigned char*)G;
        u32x2_t gcur[2], gnxt[2]; u32x4 ocur[2], onxt[2]; float rcur, rnxt;
        { const size_t off = (size_t)row0 * ldc + col0; gcur[0] = *(const u32x2_t*)(G8 + off); gcur[1] = *(const u32x2_t*)(G8 + off + HALF); if (ADD) { ocur[0] = *(const u32x4*)(O + off); ocur[1] = *(const u32x4*)(O + off + HALF); } rcur = xs[row0]; }
#pragma unroll
        for (int it = 0; it < 8; ++it) { const int ai = it >> 2, m = it & 3; const size_t off = (size_t)(row0 + ai * HALF + m * 16) * ldc + col0;
            if (it + 1 < 8) { const int ai2 = (it + 1) >> 2, m2 = (it + 1) & 3; const int r2 = row0 + ai2 * HALF + m2 * 16; const size_t off2 = (size_t)r2 * ldc + col0;
                gnxt[0] = *(const u32x2_t*)(G8 + off2); gnxt[1] = *(const u32x2_t*)(G8 + off2 + HALF); if (ADD) { onxt[0] = *(const u32x4*)(O + off2); onxt[1] = *(const u32x4*)(O + off2 + HALF); } rnxt = xs[r2]; }
            asm volatile("" ::: "memory");
#pragma unroll
            for (int bj = 0; bj < 2; ++bj) { const u32x2_t g = gcur[bj]; f32x4 v0, v1; constexpr float k255 = 1.0f / 255.0f;
#pragma unroll
                for (int i = 0; i < 4; ++i) { v0[i] = (float)acc[ai][bj][m][0][i] * (rcur * cs[bj][0][i]); v1[i] = (float)acc[ai][bj][m][1][i] * (rcur * cs[bj][1][i]); }
#pragma unroll
                for (int i = 0; i < 4; ++i) { v0[i] *= (float)((g.x >> (8 * i)) & 0xffu) * k255; v1[i] *= (float)((g.y >> (8 * i)) & 0xffu) * k255; }
                if (ADD) { const u32x4 o = ocur[bj];
                    v0[0] += bflo(o.x); v0[1] += bfhi(o.x); v0[2] += bflo(o.y); v0[3] += bfhi(o.y); v1[0] += bflo(o.z); v1[1] += bfhi(o.z); v1[2] += bflo(o.w); v1[3] += bfhi(o.w); }
                *(u32x4*)(O + off + bj * HALF) = pack8(v0, v1); }
            asm volatile("" ::: "memory");
            if (it + 1 < 8) { gcur[0] = gnxt[0]; gcur[1] = gnxt[1]; if (ADD) { ocur[0] = onxt[0]; ocur[1] = onxt[1]; } rcur = rnxt; }
        }
    }
};
struct EpiRes8 {
    static constexpr bool PERM = true, AFTER_DRAIN = false, I8 = true; typedef i32x4 acc_t;
    const float* base32; const bf16_t* base16; bf16_t* out; int ldc; const float *xs, *wsc;
    __device__ __forceinline__ void operator()(const i32x4 (&acc)[2][2][4][2], const Unit& u, int wr, int wc, int fr, int fq) const {
        const int row0 = u.pm * BM + wr * 64 + fr, col0 = u.pn * BM + wc * 32 + 8 * fq;
        f32x4 cs[2][2];
#pragma unroll
        for (int bj = 0; bj < 2; ++bj) { cs[bj][0] = *(const f32x4*)(wsc + col0 + bj * HALF); cs[bj][1] = *(const f32x4*)(wsc + col0 + bj * HALF + 4); }
#pragma unroll
        for (int ai = 0; ai < 2; ++ai)
#pragma unroll
            for (int m = 0; m < 4; ++m) { const size_t off = (size_t)(row0 + ai * HALF + m * 16) * ldc + col0; const float rs = xs[row0 + ai * HALF + m * 16];
#pragma unroll
                for (int bj = 0; bj < 2; ++bj) { f32x4 b0, b1;
                    if (base32) { b0 = *(const f32x4*)(base32 + off + bj * HALF); b1 = *(const f32x4*)(base32 + off + bj * HALF + 4); }
                    else { const u32x4 t = *(const u32x4*)(base16 + off + bj * HALF); b0 = (f32x4){bflo(t.x), bfhi(t.x), bflo(t.y), bfhi(t.y)}; b1 = (f32x4){bflo(t.z), bfhi(t.z), bflo(t.w), bfhi(t.w)}; }
                    f32x4 v0, v1;
#pragma unroll
                    for (int i = 0; i < 4; ++i) { v0[i] = b0[i] + (float)acc[ai][bj][m][0][i] * (rs * cs[bj][0][i]); v1[i] = b1[i] + (float)acc[ai][bj][m][1][i] * (rs * cs[bj][1][i]); }
                    *(u32x4*)(out + off + bj * HALF) = pack8(v0, v1); } }
    }
};
struct EpiRes {
    static constexpr bool PERM = false, AFTER_DRAIN = false, I8 = false; typedef f32x4 acc_t;
    const float* base; float* out; int ldc;
    __device__ __forceinline__ void operator()(const f32x4 (&acc)[2][2][4][2], const Unit& u, int wr, int wc, int fr, int fq) const {
        const int row0 = u.pm * BM + wr * 64 + fr, col0 = u.pn * BM + wc * 32 + 4 * fq;
#pragma unroll
        for (int ai = 0; ai < 2; ++ai)
#pragma unroll
            for (int m = 0; m < 4; ++m) { const size_t off = (size_t)(row0 + ai * HALF + m * 16) * ldc + col0;
#pragma unroll
                for (int bj = 0; bj < 2; ++bj)
#pragma unroll
                    for (int n = 0; n < 2; ++n) { const f32x4 bs = *(const f32x4*)(base + off + bj * HALF + n * 16); *(f32x4*)(out + off + bj * HALF + n * 16) = bs + acc[ai][bj][m][n]; } }
    }
};

__device__ __forceinline__ f32x4 mma16(const bf16x8& b, const bf16x8& a, const f32x4& c) { return __builtin_amdgcn_mfma_f32_16x16x32_bf16(b, a, c, 0, 0, 0); }
__device__ __forceinline__ i32x4 mma16(const bf16x8& b, const bf16x8& a, const i32x4& c) { return __builtin_amdgcn_mfma_i32_16x16x64_i8(__builtin_bit_cast(i32x4, b), __builtin_bit_cast(i32x4, a), c, 0, 0, 0); }
template <class Epi, class Sched, bool ALIGN_EPI = false, bool SP2 = false>
__device__ __forceinline__ void gemm_phase(PG8_LAS unsigned char* lds, const Gemm g, const Sched& S, const Epi& E) {
    int tid = threadIdx.x; asm volatile("" : "+v"(tid));
    const int wid = __builtin_amdgcn_readfirstlane(tid >> 6), lane = tid & 63, wr = wid >> 2, wc = wid & 3, fr = lane & 15, fq = lane >> 4;
    const int K = g.K, nt = K / BK;
    unsigned voffA[2], voffB[2];
#pragma unroll
    for (int i = 0; i < 2; ++i) { int R, C; stage_rc(tid * 16 + i * 8192, R, C); const int Rb = Epi::PERM ? ((R & ~31) + perm32(R & 31)) : R;
        voffA[i] = (unsigned)(R * K + C) * 2u; voffB[i] = (unsigned)(Rb * K + C) * 2u; }
    const size_t kstep = (size_t)(BK * 2);
    const size_t hstep = (size_t)HALF * K * 2;
    const size_t tstep = 2 * hstep;
    const unsigned ldsw = (unsigned)wid * 1024u;
    const int aoff = lds_byte(wr * 64 + fr, fq * 8), boff = lds_byte(wc * 32 + fr, fq * 8);
#define PG8_SA(b, h) (((b) * 2 + (h)) * HTB)
#define PG8_SB(b, h) ((4 + (b) * 2 + (h)) * HTB)
#define PG8_STAGE(bufoff, gbase, voff) do { _Pragma("unroll") for (int _i = 0; _i < 2; ++_i) \
        __builtin_amdgcn_global_load_lds((const unsigned*)((const char*)(gbase) + (voff)[_i]), (PG8_LAS unsigned*)(lds + (bufoff) + ldsw + _i * 8192), 16, 0, 0); } while (0)
#define PG8_LDA(dst, b, h) do { _Pragma("unroll") for (int m = 0; m < 4; ++m) _Pragma("unroll") for (int k = 0; k < 2; ++k) dst[m][k] = *(const PG8_LAS bf16x8*)(lds + PG8_SA(b, h) + aoff + m * 2048 + k * 1024); } while (0)
#define PG8_LDB(dst, b, h) do { _Pragma("unroll") for (int n = 0; n < 2; ++n) _Pragma("unroll") for (int k = 0; k < 2; ++k) dst[n][k] = *(const PG8_LAS bf16x8*)(lds + PG8_SB(b, h) + boff + n * 2048 + k * 1024); } while (0)
#define PG8_MMA(ai, bj, At, Bt) do { __builtin_amdgcn_s_setprio(1); _Pragma("unroll") for (int m = 0; m < 4; ++m) _Pragma("unroll") for (int n = 0; n < 2; ++n) _Pragma("unroll") for (int k = 0; k < 2; ++k) \
        acc[ai][bj][m][n] = mma16(Bt[n][k], At[m][k], acc[ai][bj][m][n]); __builtin_amdgcn_s_setprio(0); } while (0)
#define PG8_WAIT_V(n) asm volatile("s_waitcnt vmcnt(" #n ")" ::: "memory")
#define PG8_WAIT_L(n) asm volatile("s_waitcnt lgkmcnt(" #n ")" ::: "memory")
#define PG8_BAR __builtin_amdgcn_s_barrier()
#define PG8_SCHED __builtin_amdgcn_sched_barrier(0)
    Unit cur, nxt; int ui = 0;
    if (!S.next(0, cur)) return;
    typedef typename Epi::acc_t acc_t; acc_t acc[2][2][4][2];
#pragma unroll
    for (int a = 0; a < 2; ++a)
#pragma unroll
        for (int b = 0; b < 2; ++b)
#pragma unroll
            for (int m = 0; m < 4; ++m)
#pragma unroll
                for (int n = 0; n < 2; ++n) acc[a][b][m][n] = acc_t{};
    bf16x8 At[4][2], B0[2][2], B1[2][2];
    const char* cA = (const char*)g.A + (size_t)cur.pm * tstep; const char* cB = (const char*)g.Bt + (size_t)cur.pn * tstep;
    S.a_ready(cur);
    if constexpr (SP2) {
        PG8_STAGE(PG8_SB(0, 0), cB, voffB); PG8_STAGE(PG8_SB(0, 1), cB + hstep, voffB); PG8_STAGE(PG8_SA(0, 0), cA, voffA); PG8_STAGE(PG8_SA(0, 1), cA + hstep, voffA);
        if (wr == 1) PG8_BAR;
        PG8_WAIT_V(2); PG8_BAR;
        PG8_STAGE(PG8_SB(1, 0), cB + kstep, voffB); PG8_STAGE(PG8_SA(1, 0), cA + kstep, voffA); PG8_STAGE(PG8_SB(1, 1), cB + hstep + kstep, voffB);
        PG8_WAIT_V(6); PG8_BAR;
    } else {
        PG8_STAGE(PG8_SB(0, 0), cB, voffB); PG8_STAGE(PG8_SA(0, 0), cA, voffA); PG8_STAGE(PG8_SB(0, 1), cB + hstep, voffB); PG8_STAGE(PG8_SA(0, 1), cA + hstep, voffA);
        if (wr == 1) PG8_BAR;
        PG8_WAIT_V(4); PG8_BAR;
        PG8_STAGE(PG8_SB(1, 0), cB + kstep, voffB); PG8_STAGE(PG8_SA(1, 0), cA + kstep, voffA); PG8_STAGE(PG8_SB(1, 1), cB + hstep + kstep, voffB);
        PG8_WAIT_V(6); PG8_BAR;
    }
    for (;;) {
        const bool has_next = S.next(ui + 1, nxt);
        const char* nA = has_next ? (const char*)g.A + (size_t)nxt.pm * tstep : cA; const char* nB = has_next ? (const char*)g.Bt + (size_t)nxt.pn * tstep : cB;
        for (int t = 0; t < nt; t += 2) {
            const bool last = (t == nt - 2);
            const char* a1 = cA + (size_t)(t + 1) * kstep;
            const char* a2 = last ? nA : cA + (size_t)(t + 2) * kstep; const char* b2 = last ? nB : cB + (size_t)(t + 2) * kstep;
            const char* a3 = a2 + kstep; const char* b3 = b2 + kstep;
            if (last && has_next) S.a_ready(nxt);
            if constexpr (SP2) {
            PG8_LDB(B0, 0, 0); PG8_LDB(B1, 0, 1); PG8_SCHED; PG8_LDA(At, 0, 0); PG8_STAGE(PG8_SA(1, 1), a1 + hstep, voffA);
            PG8_WAIT_V(8); PG8_WAIT_L(0); PG8_BAR; PG8_MMA(0, 0, At, B0); PG8_MMA(0, 1, At, B1); PG8_BAR; PG8_SCHED;
            PG8_LDA(At, 0, 1); PG8_STAGE(PG8_SB(0, 0), b2, voffB); PG8_STAGE(PG8_SB(0, 1), b2 + hstep, voffB); PG8_STAGE(PG8_SA(0, 0), a2, voffA);
            PG8_WAIT_V(8); PG8_WAIT_L(0); PG8_BAR; PG8_MMA(1, 0, At, B0); PG8_MMA(1, 1, At, B1); PG8_BAR; PG8_SCHED;
            PG8_LDB(B0, 1, 0); PG8_LDB(B1, 1, 1); PG8_SCHED; PG8_LDA(At, 1, 0); PG8_STAGE(PG8_SA(0, 1), a2 + hstep, voffA);
            PG8_WAIT_V(8); PG8_WAIT_L(0); PG8_BAR; PG8_MMA(0, 0, At, B0); PG8_MMA(0, 1, At, B1); PG8_BAR; PG8_SCHED;
            PG8_LDA(At, 1, 1); PG8_STAGE(PG8_SB(1, 0), b3, voffB); PG8_STAGE(PG8_SB(1, 1), b3 + hstep, voffB); PG8_STAGE(PG8_SA(1, 0), a3, voffA);
            PG8_WAIT_V(8); PG8_WAIT_L(0); PG8_BAR; PG8_MMA(1, 0, At, B0); PG8_MMA(1, 1, At, B1); PG8_BAR; PG8_SCHED;
            } else {
            PG8_LDB(B0, 0, 0); PG8_SCHED; PG8_LDA(At, 0, 0); PG8_STAGE(PG8_SA(1, 1), a1 + hstep, voffA);
            PG8_WAIT_L(8); PG8_BAR; PG8_WAIT_L(0); PG8_MMA(0, 0, At, B0); PG8_BAR; PG8_SCHED;
            PG8_LDB(B1, 0, 1); PG8_STAGE(PG8_SB(0, 0), b2, voffB);
            PG8_BAR; PG8_WAIT_L(0); PG8_MMA(0, 1, At, B1); PG8_BAR;
            PG8_LDA(At, 0, 1); PG8_STAGE(PG8_SA(0, 0), a2, voffA);
            PG8_BAR; PG8_WAIT_L(0); PG8_MMA(1, 0, At, B0); PG8_BAR; PG8_SCHED;
            PG8_STAGE(PG8_SB(0, 1), b2 + hstep, voffB);
            PG8_WAIT_V(6); PG8_BAR; PG8_MMA(1, 1, At, B1); PG8_BAR;
            PG8_LDB(B0, 1, 0); PG8_SCHED; PG8_LDA(At, 1, 0); PG8_STAGE(PG8_SA(0, 1), a2 + hstep, voffA);
            PG8_WAIT_L(8); PG8_BAR; PG8_WAIT_L(0); PG8_MMA(0, 0, At, B0); PG8_BAR; PG8_SCHED;
            PG8_LDB(B1, 1, 1); PG8_STAGE(PG8_SB(1, 0), b3, voffB);
            PG8_BAR; PG8_WAIT_L(0); PG8_MMA(0, 1, At, B1); PG8_BAR;
            PG8_LDA(At, 1, 1); PG8_STAGE(PG8_SA(1, 0), a3, voffA);
            PG8_BAR; PG8_WAIT_L(0); PG8_MMA(1, 0, At, B0); PG8_BAR; PG8_SCHED;
            PG8_STAGE(PG8_SB(1, 1), b3 + hstep, voffB);
            PG8_WAIT_V(6); PG8_BAR; PG8_MMA(1, 1, At, B1); PG8_BAR;
            }
        }
        if constexpr (ALIGN_EPI) { if (wr == 0) PG8_BAR; }
        if constexpr (!Epi::AFTER_DRAIN) { E(acc, cur, wr, wc, fr, fq); S.done(cur); }
        if (!has_next) break;
#pragma unroll
        for (int a = 0; a < 2; ++a)
#pragma unroll
            for (int b = 0; b < 2; ++b)
#pragma unroll
                for (int m = 0; m < 4; ++m)
#pragma unroll
                    for (int n = 0; n < 2; ++n) acc[a][b][m][n] = acc_t{};
        cur = nxt; cA = nA; cB = nB; ++ui;
        if constexpr (ALIGN_EPI) { if (wr == 1) PG8_BAR; }
    }
    PG8_WAIT_V(0);
    if constexpr (!ALIGN_EPI) { if (wr == 0) PG8_BAR; }
    PG8_BAR;
    if constexpr (Epi::AFTER_DRAIN) { E.fused(acc, cur, wr, wc, fr, fq, lds, wid, lane); S.done(cur); }
#undef PG8_SA
#undef PG8_SB
#undef PG8_STAGE
#undef PG8_LDA
#undef PG8_LDB
#undef PG8_MMA
#undef PG8_WAIT_V
#undef PG8_WAIT_L
#undef PG8_BAR
#undef PG8_SCHED
}
}

constexpr int NWAVES = 8;
constexpr int DM = 4096, BATCH = 8, SEQ = 2048, DEPTH = 2, M = BATCH * SEQ;
constexpr int HD = 128, NQH = 16, NKVH = 4, ATTW = 2048, KVW = 512, SSMW = 1024, SSMG = 64, INCOLS = 12288;
constexpr int PH = 8, PDK = 256, NKEYS = 128, NEXP = 16384, PTOPK = 16, PSEL = PH * PTOPK;
constexpr float NORM_EPS = 1e-6f;
#ifndef MK_ONE_LAUNCH
#define MK_ONE_LAUNCH 1
#endif
constexpr int NPH_LAYER = 13, NPH_PRO = 2, NPHASES = NPH_PRO + DEPTH * NPH_LAYER;

constexpr size_t MiB = 1u << 20;
constexpr size_t WS_CTL = 0, CTL_ZERO_BYTES = 1 * MiB;
constexpr size_t LW_WIN = 0, LW_WAB = 96 * MiB, LW_WSB = 112 * MiB, LW_WOUT = 120 * MiB, LW_WGLU = 152 * MiB, LW_WPQ = 156 * MiB, LW_UTAB = 172 * MiB, LW_VTAB = 300 * MiB,
                 LW_KEYS = 428 * MiB, LW_S5K = 429 * MiB, LW_S5ME = 431 * MiB, LW_S5MC = 447 * MiB, LW_S5LAM = 463 * MiB, LW_SIZE = 464 * MiB;
constexpr size_t LW_WINS = LW_WIN + 48 * MiB, LW_WABS = LW_WAB + 8 * MiB, LW_WSBS = LW_WSB + 4 * MiB, LW_WOUTS = LW_WOUT + 16 * MiB, LW_WPQS = LW_WPQ + 8 * MiB;
constexpr size_t LW_SU = LW_UTAB + 64 * MiB, LW_SV = LW_VTAB + 64 * MiB, LW_VT4 = LW_VTAB + 72 * MiB, LW_S4 = LW_VTAB + 112 * MiB;
constexpr size_t WS_LW = 1 * MiB;
constexpr size_t WS_ACT = WS_LW + DEPTH * LW_SIZE;
constexpr size_t WS_XN = WS_ACT, WS_Q = WS_XN + 128 * MiB, WS_KB = WS_Q + 64 * MiB, WS_VT = WS_KB + 16 * MiB, WS_U = WS_VT + 16 * MiB, WS_GA = WS_U + 32 * MiB, WS_GS = WS_GA + 128 * MiB,
                 WS_ATT = WS_GS + 128 * MiB, WS_Z = WS_ATT + 64 * MiB, WS_SS = WS_Z + 32 * MiB, WS_MG = WS_SS + 32 * MiB, WS_PQ = WS_MG + 128 * MiB, WS_EID = WS_PQ + 64 * MiB,
                 WS_GATE = WS_EID + 8 * MiB, WS_HN = WS_GATE + 8 * MiB, WS_HN8 = WS_HN + 128 * MiB, WS_HS = WS_HN8 + 64 * MiB, WS_PAIRS = WS_HS + 1 * MiB, WS_SC = WS_PAIRS + 8 * MiB, WS_END = WS_SC + 8 * MiB;
static_assert(WS_END <= 2048 * MiB, "d_ws map exceeds the guaranteed 2 GiB");
constexpr int CW_TMO = 0, CW_CODE = 1, CW_BAR = 4096, CW_XRANK = 8192, CW_LBAR = 90112  , CW_CONV = 94208  , CW_COLMAX = 16384;
constexpr int CW_COLMAX2 = CW_COLMAX + DEPTH * INCOLS, CW_COLMAX3 = CW_COLMAX2 + DEPTH * 3 * DM;
static_assert((CW_COLMAX3 + DEPTH * 2048) * 4 <= (int)CTL_ZERO_BYTES, "CTL words inside the memset region");

constexpr int SCR_BYTES = 139264;
constexpr int LDSCTL_OFF = SCR_BYTES, MISC_OFF = LDSCTL_OFF + 320, LDS_BYTES = SCR_BYTES + 1024;
static_assert(MISC_OFF + 128 <= LDS_BYTES, "LDS map");
#define GAS __attribute__((address_space(1)))
#define LAS __attribute__((address_space(3)))
typedef unsigned short bf16;
typedef unsigned v4u __attribute__((ext_vector_type(4)));
typedef float f32x4 __attribute__((ext_vector_type(4)));
typedef short bf16x8 __attribute__((ext_vector_type(8)));
typedef GAS unsigned gu32;
typedef GAS unsigned long long gu64;
#define RLX_AGENT __ATOMIC_RELAXED, __HIP_MEMORY_SCOPE_AGENT
#define LDS_WAIT() asm volatile("s_waitcnt lgkmcnt(0)" ::: "memory")
#define VM_WAIT() asm volatile("s_waitcnt vmcnt(0)" ::: "memory")
__device__ __forceinline__ unsigned long long rt() { return __builtin_amdgcn_s_memrealtime(); }
__device__ __forceinline__ unsigned f2bf(float f) { unsigned u = __builtin_bit_cast(unsigned, f); return (u + 0x7fffu + ((u >> 16) & 1u)) >> 16; }
__device__ __forceinline__ unsigned pk2(float lo, float hi) { return f2bf(lo) | (f2bf(hi) << 16); }

#define XB_TMO      128
#define XB_XCNT(j)  (256  + 64 * (j))
#define XB_XSUB(j)  (1280 + 64 * (j))
#define XB_XGEN(j)  (2304 + 64 * (j))
#define XB_TOP      3328
#define XB_TOPGEN   3392
#define XCD_BAR_WORDS 3456
#define XB_SPIN_CAP (1u << 18)

__device__ __forceinline__ unsigned xb_ld(unsigned* p)              { return __hip_atomic_load(p, __ATOMIC_RELAXED, __HIP_MEMORY_SCOPE_AGENT); }
__device__ __forceinline__ unsigned xb_add(unsigned* p, unsigned v) { return __hip_atomic_fetch_add(p, v, __ATOMIC_RELAXED, __HIP_MEMORY_SCOPE_AGENT); }
__device__ __forceinline__ unsigned xb_xcc_id() { return (unsigned)__builtin_amdgcn_s_getreg((3 << 11) | 20) & 0xFu; }
#define XB_SPIN(cond, bar) do { unsigned _sp = 0; while (cond) { __builtin_amdgcn_s_sleep(1); \
    if ((++_sp & 255u) == 0u) { if (xb_ld(&(bar)[XB_TMO])) break; if (_sp > XB_SPIN_CAP) { atomicAdd(&(bar)[XB_TMO], 1u); break; } } } } while (0)

struct XcdBarrier {
    unsigned* bar; unsigned x;
    volatile LAS unsigned* st;
};

__device__ __forceinline__ XcdBarrier xcd_barrier_post(unsigned* bar, volatile LAS unsigned* st) {
    XcdBarrier b; b.bar = bar; b.x = xb_xcc_id(); b.st = st;
    if (threadIdx.x == 0) (void)xb_add(&bar[XB_XCNT(b.x)], 1u);
    return b;
}
__device__ __forceinline__ void xcd_barrier_complete(unsigned* bar, unsigned x, unsigned& nloc, unsigned& nx) {
    const unsigned G = gridDim.x * gridDim.y * gridDim.z;
    unsigned sum, cnt, mine, sp = 0u;
    for (;;) {
        sum = 0u; cnt = 0u; mine = 0u;
#pragma unroll
        for (unsigned j = 0; j < 16; ++j) { const unsigned c = xb_ld(&bar[XB_XCNT(j)]); sum += c; cnt += (c > 0u) ? 1u : 0u; mine = (j == x) ? c : mine; }
        if (sum == G) break;
        __builtin_amdgcn_s_sleep(1);
        if ((++sp & 255u) == 0u) { if (xb_ld(&bar[XB_TMO])) break; if (sp > XB_SPIN_CAP) { atomicAdd(&bar[XB_TMO], 1u); break; } }
    }
    nloc = mine > 0u ? mine : 1u; nx = cnt > 0u ? cnt : 1u;
}

__device__ __forceinline__ void xcd_barrier(const XcdBarrier& b) {
    asm volatile("s_waitcnt vmcnt(0)" ::: "memory");
    __syncthreads();
    if (threadIdx.x == 0) {
        unsigned* bar = b.bar; unsigned bx = b.x; asm volatile("" : "+s"(bx));
        __builtin_amdgcn_s_waitcnt(0);
        unsigned nloc = b.st[0], nx = b.st[1];
        if (nloc == 0u) { xcd_barrier_complete(bar, bx, nloc, nx); b.st[0] = nloc; b.st[1] = nx; }
        const unsigned old = xb_add(&bar[XB_XSUB(bx)], 1u);
        const unsigned gen = old / nloc;
        if (old + 1u == (gen + 1u) * nloc) {
            __builtin_amdgcn_fence(__ATOMIC_RELEASE, "agent");
            asm volatile("s_waitcnt vmcnt(0)" ::: "memory");
            const unsigned og = xb_add(&bar[XB_TOP], 1u);
            const unsigned tg = og / nx;
            if (og + 1u == (tg + 1u) * nx) xb_add(&bar[XB_TOPGEN], 1u);
            else XB_SPIN(xb_ld(&bar[XB_TOPGEN]) == tg, bar);
            __builtin_amdgcn_fence(__ATOMIC_ACQUIRE, "agent");
            xb_add(&bar[XB_XGEN(bx)], 1u);
            asm volatile("s_waitcnt vmcnt(0)" ::: "memory");
        } else {
            XB_SPIN(xb_ld(&bar[XB_XGEN(bx)]) == gen, bar);
            __builtin_amdgcn_fence(__ATOMIC_ACQUIRE, "agent");
            asm volatile("s_waitcnt vmcnt(0)" ::: "memory");
        }
    }
    __syncthreads();
}

typedef float f32x16 __attribute__((ext_vector_type(16)));
typedef float f32x2 __attribute__((ext_vector_type(2)));
typedef unsigned u32x2 __attribute__((ext_vector_type(2)));
typedef __bf16 bf16v2 __attribute__((ext_vector_type(2)));
typedef int i32x4 __attribute__((ext_vector_type(4)));
typedef int i32x2 __attribute__((ext_vector_type(2)));
__device__ __forceinline__ unsigned cvtpk(float lo, float hi) { unsigned r; asm volatile("v_cvt_pk_bf16_f32 %0, %1, %2" : "=v"(r) : "v"(lo), "v"(hi)); return r; }
__device__ __forceinline__ float bflo(unsigned w) { return __uint_as_float(w << 16); }
__device__ __forceinline__ float bfhi(unsigned w) { return __uint_as_float(w & 0xffff0000u); }
__device__ __forceinline__ float gelu_tanh(float x) { const float t = x + 0.044715f * x * x * x; return x * __builtin_amdgcn_rcpf(1.0f + __expf(-1.5957691216057308f * t)); }
__device__ __forceinline__ float dot2bf(unsigned a, unsigned b, float c) { return __builtin_amdgcn_fdot2_f32_bf16(__builtin_bit_cast(bf16v2, a), __builtin_bit_cast(bf16v2, b), c, false); }
__device__ __forceinline__ float wave_sum(float v) {
#pragma unroll
    for (int o = 1; o < 64; o <<= 1) v += __shfl_xor(v, o);
    return v;
}

struct Frame {
    LAS unsigned char* lds;
    volatile LAS unsigned* MISC;
    gu32* ctl;
    int tid, lane, wave, G;
    unsigned xcc, xrank, xi, nx, nloc;
    unsigned char* ws;
};

__device__ __forceinline__ void p0_transpose_item(const float* W, int K, int N, bf16* WT, bool glu, LAS float* scr, int item, int lane) {
    const int nblk = N / 32, kb = item / nblk, nb = item % nblk, k0 = 64 * kb, n0 = 32 * nb;
#pragma unroll 8
    for (int i = 0; i < 32; ++i) { const int kk = 2 * i + (lane >> 5); scr[kk * 33 + (lane & 31)] = W[(size_t)(k0 + kk) * N + n0 + (lane & 31)]; }
    LDS_WAIT(); asm volatile("" ::: "memory");
    const int c = lane & 7;
#pragma unroll
    for (int j = 0; j < 4; ++j) { const int n = (lane >> 3) + 8 * j; const LAS float* s = scr + (8 * c) * 33 + n;
        v4u o; o.x = cvtpk(s[0 * 33], s[1 * 33]); o.y = cvtpk(s[2 * 33], s[3 * 33]); o.z = cvtpk(s[4 * 33], s[5 * 33]); o.w = cvtpk(s[6 * 33], s[7 * 33]);
        int nrow = n0 + n; if (glu) { const int half = nrow >> 10, rem = nrow & 1023; nrow = (rem >> 7) * 256 + half * 128 + (rem & 127); }
        *(GAS v4u*)(WT + (size_t)nrow * K + k0 + 8 * c) = o; }
    LDS_WAIT(); asm volatile("" ::: "memory");
}
__device__ __forceinline__ void rms_row_to_bf16(const float* xrow, const float* g, bf16* orow, int lane) {
    const GAS f32x4* xr = (const GAS f32x4*)xrow + lane;
    f32x4 v[16]; float s = 0.f;
#pragma unroll
    for (int j = 0; j < 16; ++j) { v[j] = xr[64 * j]; s += (v[j].x * v[j].x + v[j].y * v[j].y) + (v[j].z * v[j].z + v[j].w * v[j].w); }
    const float rstd = 1.0f / sqrtf(wave_sum(s) * (1.f / DM) + NORM_EPS);
    const GAS f32x4* gr = (const GAS f32x4*)g + lane;
    GAS u32x2* o8 = (GAS u32x2*)orow + lane;
#pragma unroll
    for (int j = 0; j < 16; ++j) { const f32x4 gg = gr[64 * j]; u32x2 w; w.x = cvtpk(v[j].x * rstd * gg.x, v[j].y * rstd * gg.y); w.y = cvtpk(v[j].z * rstd * gg.z, v[j].w * rstd * gg.w); o8[64 * j] = w; }
}
__device__ __forceinline__ void s5_precompute(Frame& F, const float* a_re, const float* a_im, const float* log_step, const float* b_re, const float* b_im, const float* c_re, const float* c_im,
                                              int g, int half, bf16* KT, bf16* MEf, bf16* MCf, float* LAM) {
    LAS float* LPr = (LAS float*)F.lds; LAS float* LPi = LPr + 65 * 64; LAS float* Bbr = LPi + 65 * 64; LAS float* Bbi = Bbr + 1024; LAS float* Cr = Bbi + 1024; LAS float* Ci = Cr + 1024;
    const int tid = F.tid;
    { const float dt = expf(log_step[g]);
      for (int idx = tid; idx < 65 * 64; idx += 512) { const int t = idx >> 6, p = idx & 63; const float ar = a_re[g * 64 + p], ai = a_im[g * 64 + p];
          const float mag = expf(ar * dt * (float)t); float sn, cs; sincosf(ai * dt * (float)t, &sn, &cs); LPr[idx] = mag * cs; LPi[idx] = mag * sn; } }
    for (int i = tid; i < 1024; i += 512) { Cr[i] = c_re[g * 1024 + i]; Ci[i] = c_im[g * 1024 + i]; }
    __syncthreads();
    for (int i = tid; i < 1024; i += 512) { const int p = i >> 4, h = i & 15; const float ar = a_re[g * 64 + p], ai = a_im[g * 64 + p];
        const float lr = LPr[64 + p], li = LPi[64 + p], den = ar * ar + ai * ai, nr = lr - 1.0f;
        const float zr = (nr * ar + li * ai) / den, zi = (li * ar - nr * ai) / den;
        const float br = b_re[(g * 64 + p) * 16 + h], bi = b_im[(g * 64 + p) * 16 + h]; Bbr[i] = zr * br - zi * bi; Bbi[i] = zr * bi + zi * br; }
    if (half == 0 && tid < 64) { LAM[(g * 64 + tid) * 2] = LPr[64 * 64 + tid]; LAM[(g * 64 + tid) * 2 + 1] = LPi[64 * 64 + tid]; }
    __syncthreads();
    for (int o = half * 8192 + tid; o < half * 8192 + 8192; o += 512) { const int tau = o >> 8, h = (o >> 4) & 15, h2 = o & 15; float s = 0.f;
        for (int p = 0; p < 64; ++p) { const float cr = Cr[h * 64 + p], ci = Ci[h * 64 + p], lr = LPr[tau * 64 + p], li = LPi[tau * 64 + p]; const float wr = cr * lr - ci * li, wi = cr * li + ci * lr; s += wr * Bbr[p * 16 + h2] - wi * Bbi[p * 16 + h2]; }
        KT[(size_t)g * 16384 + o] = (bf16)(cvtpk(s, 0.f) & 0xffffu); }
    if (half == 0) for (int e = tid; e < 131072; e += 512) { const int j = e & 7, ln = (e >> 3) & 63, s = (e >> 9) & 63, mt = e >> 15; const int r = mt * 32 + (ln & 31), h = 8 * (ln >> 5) + j, p = r & 63;
        const float lr = LPr[(63 - s) * 64 + p], li = LPi[(63 - s) * 64 + p], br = Bbr[p * 16 + h], bi = Bbi[p * 16 + h]; const float v = (r < 64) ? (lr * br - li * bi) : (lr * bi + li * br);
        MEf[(size_t)g * 131072 + e] = (bf16)(cvtpk(v, 0.f) & 0xffffu); }
    if (half == 1) for (int e = tid; e < 131072; e += 512) { const int j = e & 7, ln = (e >> 3) & 63, kr = (e >> 9) & 7, mt = e >> 12; const int rr = ln & 31, t = 2 * mt + (rr >> 4), h = rr & 15, r = kr * 16 + 8 * (ln >> 5) + j, p = r & 63;
        const float cr = Cr[h * 64 + p], ci = Ci[h * 64 + p], lr = LPr[(t + 1) * 64 + p], li = LPi[(t + 1) * 64 + p]; const float v = (r < 64) ? (cr * lr - ci * li) : -(cr * li + ci * lr);
        MCf[(size_t)g * 131072 + e] = (bf16)(cvtpk(v, 0.f) & 0xffffu); }
    __syncthreads();
}

constexpr int ATT_KS_STRIDE = 272, ATT_VS_STRIDE = 528, ATT_VS_OFF = 256 * ATT_KS_STRIDE;
static_assert(ATT_VS_OFF + 128 * ATT_VS_STRIDE <= SCR_BYTES, "attention LDS");
__device__ __forceinline__ void attn_unit(Frame& F, int b, int nb, int kvh, const bf16* Q, const bf16* KB, const bf16* VT, bf16* ATT, const float* sinks) {
    int tid = F.tid; asm volatile("" : "+v"(tid)); const int lane = tid & 63, w = __builtin_amdgcn_readfirstlane(tid >> 6), r = lane & 31, hh = lane >> 5;
    LAS unsigned char* Ks = F.lds; LAS unsigned char* Vs = F.lds + ATT_VS_OFF;
    const int t0 = b * SEQ + nb * 128;
#pragma unroll
    for (int i = 0; i < 8; ++i) { const int idx = tid + 512 * i, j = idx >> 4, ch = idx & 15; int tk = t0 - 128 + j; if (nb == 0 && j < 128) tk = t0 + j;
        const v4u v = *(const GAS v4u*)(KB + (size_t)tk * KVW + kvh * 128 + ch * 8); *(LAS v4u*)(Ks + j * ATT_KS_STRIDE + ch * 16) = v; }
#pragma unroll
    for (int i = 0; i < 8; ++i) { const int idx = tid + 512 * i, d = idx >> 5, ch = idx & 31; int j0 = ch * 8; int srcj = nb * 128 - 128 + j0; if (nb == 0 && j0 < 128) srcj = j0;
        const v4u v = *(const GAS v4u*)(VT + ((size_t)((b * 4 + kvh) * 128 + d)) * SEQ + srcj); *(LAS v4u*)(Vs + d * ATT_VS_STRIDE + ch * 16) = v; }
    __syncthreads();
    const int hq = kvh * 4 + (w >> 1), hw = w & 1;
    const float slope = exp2f(-0.5f * (float)(hq + 1)), sink = sinks[hq];
#pragma unroll 1
    for (int qt = 0; qt < 2; ++qt) {
        const int qrow = hw * 64 + qt * 32 + r; const size_t tq = (size_t)(t0 + qrow);
        bf16x8 qf[8];
#pragma unroll
        for (int ks = 0; ks < 8; ++ks) qf[ks] = *(const GAS bf16x8*)(Q + tq * ATTW + hq * 128 + ks * 16 + 8 * hh);
        f32x16 S[6];
#pragma unroll
        for (int k6 = 0; k6 < 6; ++k6) { S[k6] = (f32x16){0.f};
            const int kt = 2 * hw + k6;
#pragma unroll
            for (int ks = 0; ks < 8; ++ks) { const bf16x8 a = *(const LAS bf16x8*)(Ks + (kt * 32 + r) * ATT_KS_STRIDE + ks * 32 + hh * 16); S[k6] = __builtin_amdgcn_mfma_f32_32x32x16_bf16(a, qf[ks], S[k6], 0, 0, 0); }
            asm volatile("" ::: "memory"); }
        float mx = sink;
#pragma unroll
        for (int k6 = 0; k6 < 6; ++k6)
#pragma unroll
            for (int rg = 0; rg < 16; ++rg) { const int j = (2 * hw + k6) * 32 + (rg & 3) + 8 * (rg >> 2) + 4 * hh; const int dist = qrow - j + 128;
                const bool valid = (dist >= 0) && (dist < 128) && (nb > 0 || j >= 128);
                const float lg = valid ? (S[k6][rg] - slope * (float)dist) : -1e30f; S[k6][rg] = lg; mx = fmaxf(mx, lg); }
        mx = fmaxf(mx, __shfl_xor(mx, 32));
        float sum = 0.f;
#pragma unroll
        for (int k6 = 0; k6 < 6; ++k6)
#pragma unroll
            for (int rg = 0; rg < 16; ++rg) { const float p = __expf(S[k6][rg] - mx); S[k6][rg] = p; sum += p; }
        sum += __shfl_xor(sum, 32); sum += __expf(sink - mx);
        const float inv = 1.0f / sum;
        f32x16 O[4];
#pragma unroll
        for (int dt = 0; dt < 4; ++dt) O[dt] = (f32x16){0.f};
#pragma unroll
        for (int k6 = 0; k6 < 6; ++k6)
#pragma unroll
            for (int s2 = 0; s2 < 2; ++s2) { v4u pw; pw.x = cvtpk(S[k6][8 * s2 + 0], S[k6][8 * s2 + 1]); pw.y = cvtpk(S[k6][8 * s2 + 2], S[k6][8 * s2 + 3]); pw.z = cvtpk(S[k6][8 * s2 + 4], S[k6][8 * s2 + 5]); pw.w = cvtpk(S[k6][8 * s2 + 6], S[k6][8 * s2 + 7]);
                const bf16x8 pb = __builtin_bit_cast(bf16x8, pw); const int key0 = (2 * hw + k6) * 32 + 16 * s2 + 4 * hh;
#pragma unroll
                for (int dt = 0; dt < 4; ++dt) { const LAS unsigned char* vp = Vs + (dt * 32 + r) * ATT_VS_STRIDE + key0 * 2; const u32x2 a0 = *(const LAS u32x2*)vp, a1 = *(const LAS u32x2*)(vp + 16);
                    v4u aw; aw.x = a0.x; aw.y = a0.y; aw.z = a1.x; aw.w = a1.y; O[dt] = __builtin_amdgcn_mfma_f32_32x32x16_bf16(__builtin_bit_cast(bf16x8, aw), pb, O[dt], 0, 0, 0); }
                asm volatile("" ::: "memory"); }
        bf16* orow = ATT + tq * ATTW + hq * 128;
#pragma unroll
        for (int dt = 0; dt < 4; ++dt)
#pragma unroll
            for (int g4 = 0; g4 < 4; ++g4) { u32x2 o; o.x = cvtpk(O[dt][4 * g4 + 0] * inv, O[dt][4 * g4 + 1] * inv); o.y = cvtpk(O[dt][4 * g4 + 2] * inv, O[dt][4 * g4 + 3] * inv);
                *(GAS u32x2*)(orow + dt * 32 + 8 * g4 + 4 * hh) = o; }
    }
    __syncthreads();
}

constexpr int S5_US_STRIDE = 2064, S5_ES_OFF = 32 * S5_US_STRIDE, S5_XS_OFF = S5_ES_OFF + 2 * 128 * 33 * 4, S5_XS_STRIDE = 272;
static_assert(S5_XS_OFF + 32 * S5_XS_STRIDE <= SCR_BYTES && 2 * 128 * 33 * 4 >= 32768, "S5 LDS");
__device__ __forceinline__ void s5_unit(Frame& F, int b, int g, const bf16* U, const bf16* KT, const bf16* MEf, const bf16* MCf, const float* LAM, const float* dskip, bf16* Z) {
    int tid = F.tid; asm volatile("" : "+v"(tid)); const int lane = tid & 63, w = __builtin_amdgcn_readfirstlane(tid >> 6), r = lane & 31, hh = lane >> 5;
    LAS unsigned char* Us = F.lds; LAS float* Es = (LAS float*)(F.lds + S5_ES_OFF); LAS unsigned char* Kt = F.lds + S5_ES_OFF; LAS unsigned char* Xs = F.lds + S5_XS_OFF;
#pragma unroll
    for (int i = 0; i < 8; ++i) { const int idx = tid + 512 * i, t = idx >> 1, half = idx & 1;
        const v4u v = *(const GAS v4u*)(U + ((size_t)(b * SEQ + t)) * SSMW + g * 16 + half * 8); *(LAS v4u*)(Us + (t >> 6) * S5_US_STRIDE + (t & 63) * 32 + half * 16) = v; }
    __syncthreads();
    {
        const int mtile = w & 3, sh = w >> 2; f32x16 acc = (f32x16){0.f};
        const bf16* mep = MEf + ((size_t)(g * 4 + mtile) * 64 + sh * 32) * 512 + lane * 8;
#pragma unroll 8
        for (int s2 = 0; s2 < 32; ++s2) { const bf16x8 a = *(const GAS bf16x8*)(mep + (size_t)s2 * 512);
            const bf16x8 bb = *(const LAS bf16x8*)(Us + r * S5_US_STRIDE + (sh * 32 + s2) * 32 + hh * 16); acc = __builtin_amdgcn_mfma_f32_32x32x16_bf16(a, bb, acc, 0, 0, 0); }
#pragma unroll
        for (int rg = 0; rg < 16; ++rg) { const int row = mtile * 32 + (rg & 3) + 8 * (rg >> 2) + 4 * hh; Es[(sh * 128 + row) * 33 + r] = acc[rg]; }
    }
    __syncthreads();
    if (tid < 64) {
        const int p = tid; const float lr = LAM[(g * 64 + p) * 2], li = LAM[(g * 64 + p) * 2 + 1]; float xr = 0.f, xi = 0.f;
        for (int c = 0; c < 32; ++c) {
            *(LAS bf16*)(Xs + c * S5_XS_STRIDE + p * 2) = (bf16)(cvtpk(xr, 0.f) & 0xffffu); *(LAS bf16*)(Xs + c * S5_XS_STRIDE + (64 + p) * 2) = (bf16)(cvtpk(xi, 0.f) & 0xffffu);
            const float er = Es[p * 33 + c] + Es[(128 + p) * 33 + c], ei = Es[(64 + p) * 33 + c] + Es[(128 + 64 + p) * 33 + c];
            const float nr = lr * xr - li * xi + er, ni = lr * xi + li * xr + ei; xr = nr; xi = ni; }
    }
    __syncthreads();
#pragma unroll
    for (int i = 0; i < 4; ++i) { const int idx = tid + 512 * i; *(LAS v4u*)(Kt + idx * 16) = *(const GAS v4u*)(KT + (size_t)g * 16384 + idx * 8); }
    __syncthreads();
#pragma unroll 1
    for (int q = 0; q < 4; ++q) {
        const int mt = (q == 0) ? w : (q == 1) ? 15 - w : (q == 2) ? 16 + w : 31 - w;
        const int tl = 2 * mt + (r >> 4), h = r & 15; f32x16 acc = (f32x16){0.f};
        for (int s = 0; s <= 2 * mt + 1; ++s) { const int tau = tl - s; const int tc = tau < 0 ? 0 : tau;
            bf16x8 a = *(const LAS bf16x8*)(Kt + tc * 512 + h * 32 + hh * 16); if (tau < 0) a = (bf16x8){0, 0, 0, 0, 0, 0, 0, 0};
            const bf16x8 bb = *(const LAS bf16x8*)(Us + r * S5_US_STRIDE + s * 32 + hh * 16); acc = __builtin_amdgcn_mfma_f32_32x32x16_bf16(a, bb, acc, 0, 0, 0); }
        const bf16* mcp = MCf + ((size_t)(g * 32 + mt) * 8) * 512 + lane * 8;
#pragma unroll
        for (int kr = 0; kr < 8; ++kr) { const bf16x8 a = *(const GAS bf16x8*)(mcp + (size_t)kr * 512);
            const bf16x8 bb = *(const LAS bf16x8*)(Xs + r * S5_XS_STRIDE + kr * 32 + hh * 16); acc = __builtin_amdgcn_mfma_f32_32x32x16_bf16(a, bb, acc, 0, 0, 0); }
#pragma unroll
        for (int g4 = 0; g4 < 4; ++g4) { const int ts = 2 * mt + (g4 >> 1), h0 = 8 * (g4 & 1) + 4 * hh;
            const u32x2 uu = *(const LAS u32x2*)(Us + r * S5_US_STRIDE + ts * 32 + h0 * 2); const f32x4 dd = *(const GAS f32x4*)(dskip + g * 16 + h0);
            const float y0 = acc[4 * g4 + 0] + dd.x * bflo(uu.x), y1 = acc[4 * g4 + 1] + dd.y * bfhi(uu.x), y2 = acc[4 * g4 + 2] + dd.z * bflo(uu.y), y3 = acc[4 * g4 + 3] + dd.w * bfhi(uu.y);
            u32x2 o; o.x = cvtpk(gelu_tanh(y0), gelu_tanh(y1)); o.y = cvtpk(gelu_tanh(y2), gelu_tanh(y3));
            *(GAS u32x2*)(Z + ((size_t)(b * SEQ + r * 64 + ts)) * SSMW + g * 16 + h0) = o; }
    }
    __syncthreads();
}

constexpr float NEGBIG = -3.0e38f;
template <int N> __device__ __forceinline__ void bitonic_sort_desc(float (&a)[N]) {
#pragma unroll
    for (int k = 2; k <= N; k <<= 1)
#pragma unroll
        for (int j = k >> 1; j > 0; j >>= 1)
#pragma unroll
            for (int i = 0; i < N; ++i) { const int l = i ^ j; if (l > i) { const bool up = ((i & k) == 0); const float hi = fmaxf(a[i], a[l]), lo = fminf(a[i], a[l]); a[i] = up ? hi : lo; a[l] = up ? lo : hi; } }
}
template <int N> __device__ __forceinline__ void bitonic_merge_desc(float (&a)[N]) {
#pragma unroll
    for (int j = N >> 1; j > 0; j >>= 1)
#pragma unroll
        for (int i = 0; i < N; ++i) { const int l = i ^ j; if (l > i) { const float hi = fmaxf(a[i], a[l]), lo = fminf(a[i], a[l]); a[i] = hi; a[l] = lo; } }
}
__device__ __forceinline__ void top16_merge(float (&a)[16], const float (&b)[16]) {
#pragma unroll
    for (int i = 0; i < 16; ++i) a[i] = fmaxf(a[i], b[15 - i]);
    bitonic_merge_desc<16>(a);
}
__device__ __forceinline__ void topk_task(int task, int lane, const bf16* PQ, const bf16* KEYS, int* EID, float* GATE, LAS unsigned char* wl) {
    asm volatile("" : "+v"(lane));
    const int tt = task >> 3, h = task & 7, r = lane & 31, hh = lane >> 5; const size_t token = (size_t)tt * 32 + r;
    float sv[2][16];
#pragma unroll
    for (int c = 0; c < 2; ++c) {
        bf16x8 qf[8];
#pragma unroll
        for (int ks = 0; ks < 8; ++ks) qf[ks] = *(const GAS bf16x8*)(PQ + token * (PH * PDK) + h * PDK + c * 128 + ks * 16 + 8 * hh);
        float g[4][16];
#pragma unroll
        for (int mt = 0; mt < 4; ++mt) { f32x16 acc = (f32x16){0.f};
#pragma unroll
            for (int ks = 0; ks < 8; ++ks) { const bf16x8 a = *(const GAS bf16x8*)(KEYS + ((size_t)((h * 2 + c) * 128 + mt * 32 + r)) * 128 + ks * 16 + 8 * hh); acc = __builtin_amdgcn_mfma_f32_32x32x16_bf16(a, qf[ks], acc, 0, 0, 0); }
#pragma unroll
            for (int rg = 0; rg < 16; ++rg) { const unsigned n = (unsigned)(mt * 32 + (rg & 3) + 8 * (rg >> 2) + 4 * hh); g[mt][rg] = __uint_as_float((__float_as_uint(acc[rg]) & ~127u) | n); }
            bitonic_sort_desc<16>(g[mt]); }
        top16_merge(g[0], g[1]); top16_merge(g[2], g[3]); top16_merge(g[0], g[2]);
        float u[16];
#pragma unroll
        for (int i = 0; i < 16; ++i) u[i] = fmaxf(g[0][i], __shfl_xor(g[0][15 - i], 32));
        bitonic_merge_desc<16>(u);
#pragma unroll
        for (int i = 0; i < 16; ++i) sv[c][i] = u[i];
    }
    { unsigned w[8];
#pragma unroll
      for (int d = 0; d < 8; ++d) { const int c = d >> 2, i0 = (d & 3) * 4; w[d] = (__float_as_uint(sv[c][i0]) & 127u) | ((__float_as_uint(sv[c][i0 + 1]) & 127u) << 8) | ((__float_as_uint(sv[c][i0 + 2]) & 127u) << 16) | ((__float_as_uint(sv[c][i0 + 3]) & 127u) << 24); }
      LAS unsigned* tp = (LAS unsigned*)(wl + lane * 36);
#pragma unroll
      for (int d = 0; d < 8; ++d) tp[d] = w[d]; }
    float cd[4][16];
    { int q = 0;
#pragma unroll
      for (int i = 0; i < 16; ++i)
#pragma unroll
        for (int j = 0; j < 16; ++j) if ((i + 1) * (j + 1) <= 16) {
            const float s = __uint_as_float(__float_as_uint(sv[0][i]) & ~127u) + __uint_as_float(__float_as_uint(sv[1][j]) & ~127u);
            cd[q >> 4][q & 15] = __uint_as_float((__float_as_uint(s) & ~255u) | (unsigned)((i << 4) | j)); ++q; }
#pragma unroll
      for (int p = 50; p < 64; ++p) cd[p >> 4][p & 15] = NEGBIG; }
#pragma unroll
    for (int t = 0; t < 4; ++t) bitonic_sort_desc<16>(cd[t]);
    top16_merge(cd[0], cd[1]); top16_merge(cd[2], cd[3]); top16_merge(cd[0], cd[2]);
    const float s0 = __uint_as_float(__float_as_uint(cd[0][0]) & ~255u);
    float ex[16]; int we[16]; float sum = 0.f;
    const LAS unsigned char* tb = wl + lane * 36;
#pragma unroll
    for (int k = 0; k < 16; ++k) { const unsigned bits = __float_as_uint(cd[0][k]); ex[k] = __expf(__uint_as_float(bits & ~255u) - s0); sum += ex[k];
        we[k] = (int)tb[(bits >> 4) & 15u] * 128 + (int)tb[16 + (bits & 15u)]; }
    const float inv = 1.0f / sum;
    int eo[8]; float go[8];
#pragma unroll
    for (int k = 0; k < 8; ++k) { eo[k] = hh ? we[k + 8] : we[k]; go[k] = (hh ? ex[k + 8] : ex[k]) * inv; }
    int* ep = EID + token * PSEL + h * 16 + hh * 8; float* gp = GATE + token * PSEL + h * 16 + hh * 8;
    *(GAS i32x4*)ep = (i32x4){eo[0], eo[1], eo[2], eo[3]}; *(GAS i32x4*)(ep + 4) = (i32x4){eo[4], eo[5], eo[6], eo[7]};
    *(GAS f32x4*)gp = (f32x4){go[0], go[1], go[2], go[3]}; *(GAS f32x4*)(gp + 4) = (f32x4){go[4], go[5], go[6], go[7]};
}

typedef signed char i8;
#define ROWLOAD8(dst, tab, e) do { const GAS v4u* _p = (const GAS v4u*)((tab) + (size_t)(e) * DM) + lane; _Pragma("unroll") for (int _i = 0; _i < 4; ++_i) dst[_i] = _p[64 * _i]; } while (0)
#define HALFLOAD8(dst, tab, e, hf) do { const GAS v4u* _p = (const GAS v4u*)((tab) + (size_t)(e) * DM) + lane + 128 * (hf); dst[0] = _p[0]; dst[1] = _p[64]; } while (0)
__device__ __forceinline__ int dotrow8(const v4u (&a)[4], const v4u (&x)[4]) {
    int s0 = 0, s1 = 0, s2 = 0, s3 = 0;
#pragma unroll
    for (int i = 0; i < 4; ++i) { s0 = __builtin_amdgcn_sdot4((int)a[i].x, (int)x[i].x, s0, false); s1 = __builtin_amdgcn_sdot4((int)a[i].y, (int)x[i].y, s1, false);
                                  s2 = __builtin_amdgcn_sdot4((int)a[i].z, (int)x[i].z, s2, false); s3 = __builtin_amdgcn_sdot4((int)a[i].w, (int)x[i].w, s3, false); }
    return (s0 + s1) + (s2 + s3);
}
template <int HF> __device__ __forceinline__ void vquad(int (&acc)[64], const v4u (&r0)[2], const v4u (&r1)[2], const v4u (&r2)[2], const v4u (&r3)[2], int a4) {
#pragma unroll
    for (int i = 0; i < 2; ++i) {
        const unsigned x0[4] = {r0[i].x, r0[i].y, r0[i].z, r0[i].w}, x1[4] = {r1[i].x, r1[i].y, r1[i].z, r1[i].w}, x2[4] = {r2[i].x, r2[i].y, r2[i].z, r2[i].w}, x3[4] = {r3[i].x, r3[i].y, r3[i].z, r3[i].w};
#pragma unroll
        for (int w = 0; w < 4; ++w) {
            const unsigned t0 = __builtin_amdgcn_perm(x1[w], x0[w], 0x05010400u), t1 = __builtin_amdgcn_perm(x1[w], x0[w], 0x07030602u);
            const unsigned u0 = __builtin_amdgcn_perm(x3[w], x2[w], 0x05010400u), u1 = __builtin_amdgcn_perm(x3[w], x2[w], 0x07030602u);
            const unsigned y0 = __builtin_amdgcn_perm(u0, t0, 0x05040100u), y1 = __builtin_amdgcn_perm(u0, t0, 0x07060302u), y2 = __builtin_amdgcn_perm(u1, t1, 0x05040100u), y3 = __builtin_amdgcn_perm(u1, t1, 0x07060302u);
            const int b = (2 * HF + i) * 16 + w * 4;
            acc[b + 0] = __builtin_amdgcn_sdot4((int)y0, a4, acc[b + 0], false); acc[b + 1] = __builtin_amdgcn_sdot4((int)y1, a4, acc[b + 1], false);
            acc[b + 2] = __builtin_amdgcn_sdot4((int)y2, a4, acc[b + 2], false); acc[b + 3] = __builtin_amdgcn_sdot4((int)y3, a4, acc[b + 3], false); } }
}
__device__ __forceinline__ unsigned pack_lo8(unsigned a, unsigned b, unsigned c, unsigned d) {
    return __builtin_amdgcn_perm(__builtin_amdgcn_perm(d, c, 0x0c0c0400u), __builtin_amdgcn_perm(b, a, 0x0c0c0400u), 0x05040100u);
}
__device__ __forceinline__ unsigned q8x4(float a, float b, float c, float d, float inv) {
    return pack_lo8(__float_as_uint(fmaf(a, inv, 12582912.0f)), __float_as_uint(fmaf(b, inv, 12582912.0f)), __float_as_uint(fmaf(c, inv, 12582912.0f)), __float_as_uint(fmaf(d, inv, 12582912.0f)));
}
__device__ __forceinline__ float wave_max(float v) {
#pragma unroll
    for (int o = 1; o < 64; o <<= 1) v = fmaxf(v, __shfl_xor(v, o));
    return v;
}
__device__ __forceinline__ void wave_sort128(unsigned& k0, unsigned& k1, int lane) {
#pragma unroll
    for (int k = 2; k <= 128; k <<= 1)
#pragma unroll
        for (int j = k >> 1; j > 0; j >>= 1) {
            const bool asc = ((2 * lane) & k) == 0;
            if (j == 1) { const unsigned lo = k0 < k1 ? k0 : k1, hi = k0 < k1 ? k1 : k0; k0 = asc ? lo : hi; k1 = asc ? hi : lo; }
            else { const int m = j >> 1; const bool takemin = (((lane & m) == 0) == asc);
                const unsigned o0 = (unsigned)__shfl_xor((int)k0, m), o1 = (unsigned)__shfl_xor((int)k1, m);
                k0 = takemin ? (k0 < o0 ? k0 : o0) : (k0 < o0 ? o0 : k0); k1 = takemin ? (k1 < o1 ? k1 : o1) : (k1 < o1 ? o1 : k1); }
        }
}
__device__ __forceinline__ void vquad4(int (&acc)[64], const v4u (&r0)[2], const v4u (&r1)[2], const v4u (&r2)[2], const v4u (&r3)[2], int a4) {
#pragma unroll
    for (int j = 0; j < 2; ++j) {
        const unsigned d0[4] = {r0[j].x, r0[j].y, r0[j].z, r0[j].w}, d1[4] = {r1[j].x, r1[j].y, r1[j].z, r1[j].w}, d2[4] = {r2[j].x, r2[j].y, r2[j].z, r2[j].w}, d3[4] = {r3[j].x, r3[j].y, r3[j].z, r3[j].w};
#pragma unroll
        for (int c = 0; c < 4; ++c) { const int i = 2 * j + (c >> 1), p = c & 1;
            const unsigned x0 = d0[c], x1 = d1[c], x2 = d2[c], x3 = d3[c];
            const unsigned t0 = __builtin_amdgcn_perm(x1, x0, 0x05010400u), t1 = __builtin_amdgcn_perm(x1, x0, 0x07030602u);
            const unsigned u0 = __builtin_amdgcn_perm(x3, x2, 0x05010400u), u1 = __builtin_amdgcn_perm(x3, x2, 0x07030602u);
            const unsigned y[4] = {__builtin_amdgcn_perm(u0, t0, 0x05040100u), __builtin_amdgcn_perm(u0, t0, 0x07060302u), __builtin_amdgcn_perm(u1, t1, 0x05040100u), __builtin_amdgcn_perm(u1, t1, 0x07060302u)};
            const int bl = i * 16 + p * 4, bh = bl + 8;
#pragma unroll
            for (int e = 0; e < 4; ++e) { acc[bl + e] = __builtin_amdgcn_sdot4((int)(y[e] & 0x0f0f0f0fu), a4, acc[bl + e], false); acc[bh + e] = __builtin_amdgcn_sdot4((int)y[e], a4, acc[bh + e], false); } } }
}
__device__ __forceinline__ void vquad4_fix(int (&acc)[64]) {
#pragma unroll
    for (int i = 0; i < 4; ++i)
#pragma unroll
        for (int k = 0; k < 8; ++k) acc[i * 16 + 8 + k] = (acc[i * 16 + 8 + k] - acc[i * 16 + k]) >> 4;
}
#define ROWLOAD4(dst, tab, e) do { const GAS v4u* _p = (const GAS v4u*)((tab) + (size_t)(e) * (DM / 2)) + lane; dst[0] = _p[0]; dst[1] = _p[64]; } while (0)
constexpr float INT4_CLIP = 2.7f;
constexpr int N8ROWS = 0;
template <bool LAST>
__device__ __forceinline__ void gather_token(size_t token, int lane, const int* SC, const float* HS, const int* EID, const float* GATE, const float* SU, const i8* VTB, const float* SV, const i8* VT4, const float* S4,
                                             const bf16* X, bf16* Xo, float* Fo, const float* gnext, i8* XNout, float* XSout) {
    asm volatile("" : "+v"(lane));
    const i32x2 ee = *(const GAS i32x2*)(EID + token * PSEL + 2 * lane); const f32x2 gg = *(const GAS f32x2*)(GATE + token * PSEL + 2 * lane); const i32x2 scv = *(const GAS i32x2*)(SC + token * PSEL + 2 * lane);
    const f32x4 scl0 = *((const GAS f32x4*)SU + ee.x), scl1 = *((const GAS f32x4*)SU + ee.y);
    const float hs = HS[token], su0 = scl0.x, su1 = scl1.x, s80 = scl0.y, s81 = scl1.y, s40 = scl0.z, s41 = scl1.z;
    const float g0 = gelu_tanh((float)scv.x * su0 * hs) * gg.x, g1 = gelu_tanh((float)scv.y * su1 * hs) * gg.y;
    const float m0 = fabsf(g0 * s80), m1 = fabsf(g1 * s81);
    unsigned t0 = __float_as_uint(m0), t1 = __float_as_uint(m1); wave_sort128(t0, t1, lane);
    const float thr = N8ROWS > 0 ? __uint_as_float((unsigned)__builtin_amdgcn_readlane((int)t0, N8ROWS > 0 ? (128 - N8ROWS) / 2 : 0)) : 3.0e38f;
    const unsigned c0 = (m0 < thr) ? 1u : 0u, c1 = (m1 < thr) ? 1u : 0u;
    const float a0 = g0 * (c0 ? s40 : s80), a1 = g1 * (c1 ? s41 : s81);
    const float amax = wave_max(fmaxf(fabsf(a0), fabsf(a1))); const float sa = amax * (1.0f / 127.0f), ainv = amax > 0.f ? 127.0f / amax : 0.f;
    const int q0 = (int)rintf(a0 * ainv), q1 = (int)rintf(a1 * ainv);
    unsigned k0 = (c0 << 23) | ((unsigned)ee.x << 8) | (unsigned)(q0 & 0xff), k1 = (c1 << 23) | ((unsigned)ee.y << 8) | (unsigned)(q1 & 0xff);
    wave_sort128(k0, k1, lane);
    const int e0 = (int)((k0 >> 8) & 0x3fffu), e1 = (int)((k1 >> 8) & 0x3fffu); const bool i40 = (k0 >> 23) & 1u, i41 = (k1 >> 23) & 1u;
    const int n0 = __builtin_popcountll(__ballot(!i40)) + __builtin_popcountll(__ballot(!i41));
    const int pair8 = (int)((i40 ? 0u : (k0 & 0xffu)) | ((i41 ? 0u : (k1 & 0xffu)) << 8));
    const int pair4 = (int)((i40 ? (k0 & 0xffu) : 0u) | ((i41 ? (k1 & 0xffu) : 0u) << 8));
    int corr = (i40 ? (int)(signed char)(k0 & 0xffu) : 0) + (i41 ? (int)(signed char)(k1 & 0xffu) : 0);
#pragma unroll
    for (int o = 1; o < 64; o <<= 1) corr += __shfl_xor(corr, o);
    corr *= 8;
    int acc[64];
#pragma unroll
    for (int i = 0; i < 64; ++i) acc[i] = 0;
    const int nq8 = (n0 + 3) >> 2, q4s = n0 >> 2;
    if (q4s < 32) {
        v4u P0[2], P1[2], P2[2], P3[2], R0[2], R1[2], R2[2], R3[2];
#define QLOAD4(S0, S1, S2, S3, q_) do { const int ea = __builtin_amdgcn_readlane(e0, 2 * (q_)), eb = __builtin_amdgcn_readlane(e1, 2 * (q_)), ec = __builtin_amdgcn_readlane(e0, 2 * (q_) + 1), ed = __builtin_amdgcn_readlane(e1, 2 * (q_) + 1); \
            ROWLOAD4(S0, VT4, ea); ROWLOAD4(S1, VT4, eb); ROWLOAD4(S2, VT4, ec); ROWLOAD4(S3, VT4, ed); } while (0)
#define A4OF(q_) (__builtin_amdgcn_readlane(pair4, 2 * (q_)) | (__builtin_amdgcn_readlane(pair4, 2 * (q_) + 1) << 16))
        QLOAD4(P0, P1, P2, P3, q4s);
#pragma unroll 1
        for (int q = q4s; q < 32; q += 2) {
            if (q + 1 < 32) QLOAD4(R0, R1, R2, R3, q + 1);
            vquad4(acc, P0, P1, P2, P3, A4OF(q));
            if (q + 2 < 32) QLOAD4(P0, P1, P2, P3, q + 2);
            if (q + 1 < 32) vquad4(acc, R0, R1, R2, R3, A4OF(q + 1));
        }
#undef QLOAD4
#undef A4OF
        vquad4_fix(acc);
    }
    if (nq8 > 0) {
        v4u A0[2], A1[2], A2[2], A3[2], B0[2], B1[2], B2[2], B3[2];
        { const int ea = __builtin_amdgcn_readlane(e0, 0), eb = __builtin_amdgcn_readlane(e1, 0), ec = __builtin_amdgcn_readlane(e0, 1), ed = __builtin_amdgcn_readlane(e1, 1);
          HALFLOAD8(A0, VTB, ea, 0); HALFLOAD8(A1, VTB, eb, 0); HALFLOAD8(A2, VTB, ec, 0); HALFLOAD8(A3, VTB, ed, 0); }
#pragma unroll 1
        for (int q = 0; q < nq8; ++q) {
            const int a4 = __builtin_amdgcn_readlane(pair8, 2 * q) | (__builtin_amdgcn_readlane(pair8, 2 * q + 1) << 16);
            { const int ea = __builtin_amdgcn_readlane(e0, 2 * q), eb = __builtin_amdgcn_readlane(e1, 2 * q), ec = __builtin_amdgcn_readlane(e0, 2 * q + 1), ed = __builtin_amdgcn_readlane(e1, 2 * q + 1);
              HALFLOAD8(B0, VTB, ea, 1); HALFLOAD8(B1, VTB, eb, 1); HALFLOAD8(B2, VTB, ec, 1); HALFLOAD8(B3, VTB, ed, 1); }
            vquad<0>(acc, A0, A1, A2, A3, a4);
            if (q + 1 < nq8) { const int ea = __builtin_amdgcn_readlane(e0, 2 * q + 2), eb = __builtin_amdgcn_readlane(e1, 2 * q + 2), ec = __builtin_amdgcn_readlane(e0, 2 * q + 3), ed = __builtin_amdgcn_readlane(e1, 2 * q + 3);
              HALFLOAD8(A0, VTB, ea, 0); HALFLOAD8(A1, VTB, eb, 0); HALFLOAD8(A2, VTB, ec, 0); HALFLOAD8(A3, VTB, ed, 0); }
            vquad<1>(acc, B0, B1, B2, B3, a4);
        }
    }
#pragma unroll
    for (int i = 0; i < 64; ++i) if ((i & 8) == 0) acc[i] -= corr;
    const bf16* xrow = X + token * DM + lane * 16; bf16* orow = Xo + token * DM + lane * 16; float* frow = Fo + token * DM + lane * 16; float ss = 0.f; float xv[64];
#pragma unroll
    for (int i = 0; i < 4; ++i) { const v4u t0 = *(const GAS v4u*)(xrow + i * 1024), t1 = *(const GAS v4u*)(xrow + i * 1024 + 8); const int b = i * 16;
        const float xin[16] = {bflo(t0.x), bfhi(t0.x), bflo(t0.y), bfhi(t0.y), bflo(t0.z), bfhi(t0.z), bflo(t0.w), bfhi(t0.w), bflo(t1.x), bfhi(t1.x), bflo(t1.y), bfhi(t1.y), bflo(t1.z), bfhi(t1.z), bflo(t1.w), bfhi(t1.w)};
#pragma unroll
        for (int e = 0; e < 16; ++e) { xv[b + e] = xin[e] + sa * (float)acc[b + e]; ss += xv[b + e] * xv[b + e]; }
        if (!LAST) { v4u o0, o1; o0.x = cvtpk(xv[b + 0], xv[b + 1]); o0.y = cvtpk(xv[b + 2], xv[b + 3]); o0.z = cvtpk(xv[b + 4], xv[b + 5]); o0.w = cvtpk(xv[b + 6], xv[b + 7]); o1.x = cvtpk(xv[b + 8], xv[b + 9]); o1.y = cvtpk(xv[b + 10], xv[b + 11]); o1.z = cvtpk(xv[b + 12], xv[b + 13]); o1.w = cvtpk(xv[b + 14], xv[b + 15]);
            *(GAS v4u*)(orow + i * 1024) = o0; *(GAS v4u*)(orow + i * 1024 + 8) = o1; } }
    const float rstd = 1.0f / sqrtf(wave_sum(ss) * (1.f / DM) + NORM_EPS); float mx = 0.f;
#pragma unroll
    for (int i = 0; i < 4; ++i)
#pragma unroll
        for (int w = 0; w < 4; ++w) { const f32x4 ga = *(const GAS f32x4*)(gnext + i * 1024 + lane * 16 + w * 4); const int b = i * 16 + w * 4;
            xv[b + 0] *= rstd * ga.x; xv[b + 1] *= rstd * ga.y; xv[b + 2] *= rstd * ga.z; xv[b + 3] *= rstd * ga.w;
            if (LAST) *(GAS f32x4*)(frow + i * 1024 + w * 4) = (f32x4){xv[b + 0], xv[b + 1], xv[b + 2], xv[b + 3]};
            else mx = fmaxf(fmaxf(mx, fmaxf(fabsf(xv[b + 0]), fabsf(xv[b + 1]))), fmaxf(fabsf(xv[b + 2]), fabsf(xv[b + 3]))); }
    if (!LAST) {
        mx = wave_max(mx); const float inv = mx > 0.f ? 127.0f / mx : 0.f;
#pragma unroll
        for (int i = 0; i < 4; ++i) { unsigned o[4];
#pragma unroll
            for (int w = 0; w < 4; ++w) { const int b = i * 16 + w * 4; o[w] = q8x4(xv[b + 0], xv[b + 1], xv[b + 2], xv[b + 3], inv); }
            v4u ov; ov.x = o[0]; ov.y = o[1]; ov.z = o[2]; ov.w = o[3]; *(GAS v4u*)(XNout + token * DM + i * 1024 + lane * 16) = ov; }
        if (lane == 0) XSout[token] = mx * (1.0f / 127.0f);
    }
}
__device__ __forceinline__ unsigned nib4(const f32x4 t, float inv4) {
#define NIB1(x_) __float_as_uint(fminf(fmaxf(fmaf((x_), inv4, 12582920.0f), 12582913.0f), 12582927.0f))
    return pack_lo8(NIB1(t.x), NIB1(t.y), NIB1(t.z), NIB1(t.w));
#undef NIB1
}
__device__ __forceinline__ void quant_row_load(f32x4 (&v)[16], const float* src, int lane) {
#pragma unroll
    for (int c = 0; c < 16; ++c) v[c] = *(const GAS f32x4*)(src + c * 256 + lane * 4);
}
__device__ __forceinline__ void quant_row_store(const f32x4 (&v)[16], i8* dst, float* scale_out, i8* dst4, float* scale4_out, int lane) {
    float mx = 0.f;
#pragma unroll
    for (int c = 0; c < 16; ++c) { const f32x4 t = v[c]; mx = fmaxf(fmaxf(mx, fmaxf(fabsf(t.x), fabsf(t.y))), fmaxf(fabsf(t.z), fabsf(t.w))); }
    mx = wave_max(mx); const float inv = mx > 0.f ? 127.0f / mx : 0.f;
#pragma unroll
    for (int c = 0; c < 16; ++c) { const f32x4 t = v[c];
        if (dst) *(GAS unsigned*)(dst + c * 256 + lane * 4) = q8x4(t.x, t.y, t.z, t.w, inv); }
    if (lane == 0) *scale_out = mx * (1.0f / 127.0f);
    if (dst4) { float ss = 0.f;
#pragma unroll
        for (int c = 0; c < 16; ++c) { const f32x4 t = v[c]; ss += (t.x * t.x + t.y * t.y) + (t.z * t.z + t.w * t.w); }
        const float clip = fminf(mx, INT4_CLIP * sqrtf(wave_sum(ss) * (1.0f / DM))), inv4 = clip > 0.f ? 7.0f / clip : 0.f; const bool lowp = (lane & 3) < 2;
#pragma unroll
        for (int k = 0; k < 8; ++k) { const int ca = (k & 3) + (k >> 2) * 8, cb = ca + 4;
            const unsigned fix = lowp ? 0u : 0x08080808u, qa = nib4(v[ca], inv4) ^ fix, qb = nib4(v[cb], inv4) ^ fix;
            const unsigned r = (unsigned)__builtin_amdgcn_mov_dpp((int)(lowp ? qb : qa), 0x4E, 0xF, 0xF, true);
            *(GAS unsigned*)(dst4 + (size_t)((k >> 2) * 64 + (k & 3) * 16 + (lane >> 2)) * 16 + (lane & 3) * 4) = lowp ? (qa | (r << 4)) : (r | (qb << 4)); }
        if (lane == 0) *scale4_out = clip * (1.0f / 7.0f); }
}
__device__ __forceinline__ void quant_row8(const float* src, i8* dst, float* scale_out, i8* dst4, float* scale4_out, int lane) {
    f32x4 v[16]; quant_row_load(v, src, lane); quant_row_store(v, dst, scale_out, dst4, scale4_out, lane);
}
__device__ __forceinline__ void convert_tables(const float* srcu, const float* srcv, unsigned char* lw, int cw, int ncw, int lane) {
#define CT_LOAD(R, rw_) do { const int t_ = (rw_) >= NEXP, e_ = (rw_) - t_ * NEXP; quant_row_load(R, (t_ ? srcv : srcu) + (size_t)e_ * DM, lane); } while (0)
#define CT_STORE(R, rw_) do { const int t_ = (rw_) >= NEXP, e_ = (rw_) - t_ * NEXP; \
        quant_row_store(R, (t_ && N8ROWS == 0) ? (i8*)nullptr : (i8*)(lw + (t_ ? LW_VTAB : LW_UTAB)) + (size_t)e_ * DM, (float*)(lw + LW_SU) + 4 * e_ + t_, t_ ? (i8*)(lw + LW_VT4) + (size_t)e_ * (DM / 2) : (i8*)nullptr, (float*)(lw + LW_SU) + 4 * e_ + 2, lane); } while (0)
    f32x4 A[16], B[16];
    if (cw < 2 * NEXP) CT_LOAD(A, cw);
#pragma unroll 1
    for (int rw = cw; rw < 2 * NEXP; rw += 2 * ncw) {
        const int r1 = rw + ncw, r2 = rw + 2 * ncw;
        if (r1 < 2 * NEXP) CT_LOAD(B, r1);
        CT_STORE(A, rw);
        if (r2 < 2 * NEXP) CT_LOAD(A, r2);
        if (r1 < 2 * NEXP) CT_STORE(B, r1);
    }
#undef CT_LOAD
#undef CT_STORE
}
__device__ __forceinline__ void rms_row_to_bf16_i8(const float* xrow, const float* g, bf16* orow, i8* o8row, float* scale_out, int lane) {
    const GAS f32x4* xr = (const GAS f32x4*)xrow + lane;
    f32x4 v[16]; float s = 0.f;
#pragma unroll
    for (int j = 0; j < 16; ++j) { v[j] = xr[64 * j]; s += (v[j].x * v[j].x + v[j].y * v[j].y) + (v[j].z * v[j].z + v[j].w * v[j].w); }
    const float rstd = 1.0f / sqrtf(wave_sum(s) * (1.f / DM) + NORM_EPS);
    const GAS f32x4* gr = (const GAS f32x4*)g + lane;
    GAS u32x2* o8 = (GAS u32x2*)orow + lane; float mx = 0.f;
#pragma unroll
    for (int j = 0; j < 16; ++j) { const f32x4 gg = gr[64 * j]; v[j].x *= rstd * gg.x; v[j].y *= rstd * gg.y; v[j].z *= rstd * gg.z; v[j].w *= rstd * gg.w;
        u32x2 w; w.x = cvtpk(v[j].x, v[j].y); w.y = cvtpk(v[j].z, v[j].w); o8[64 * j] = w; mx = fmaxf(fmaxf(mx, fmaxf(fabsf(v[j].x), fabsf(v[j].y))), fmaxf(fabsf(v[j].z), fabsf(v[j].w))); }
    mx = wave_max(mx); const float inv = mx > 0.f ? 127.0f / mx : 0.f;
    GAS unsigned* q8 = (GAS unsigned*)o8row + lane;
#pragma unroll
    for (int j = 0; j < 16; ++j) q8[64 * j] = q8x4(v[j].x, v[j].y, v[j].z, v[j].w, inv);
    if (lane == 0) *scale_out = mx * (1.0f / 127.0f);
}

__device__ __forceinline__ void rms_row_to_i8(const float* xrow, const float* g, i8* o8row, float* scale_out, int lane) {
    const GAS f32x4* xr = (const GAS f32x4*)xrow + lane;
    f32x4 v[16]; float s = 0.f;
#pragma unroll
    for (int j = 0; j < 16; ++j) { v[j] = xr[64 * j]; s += (v[j].x * v[j].x + v[j].y * v[j].y) + (v[j].z * v[j].z + v[j].w * v[j].w); }
    const float rstd = 1.0f / sqrtf(wave_sum(s) * (1.f / DM) + NORM_EPS);
    const GAS f32x4* gr = (const GAS f32x4*)g + lane; float mx = 0.f;
#pragma unroll
    for (int j = 0; j < 16; ++j) { const f32x4 gg = gr[64 * j]; v[j].x *= rstd * gg.x; v[j].y *= rstd * gg.y; v[j].z *= rstd * gg.z; v[j].w *= rstd * gg.w;
        mx = fmaxf(fmaxf(mx, fmaxf(fabsf(v[j].x), fabsf(v[j].y))), fmaxf(fabsf(v[j].z), fabsf(v[j].w))); }
    mx = wave_max(mx); const float inv = mx > 0.f ? 127.0f / mx : 0.f;
    GAS unsigned* q8 = (GAS unsigned*)o8row + lane;
#pragma unroll
    for (int j = 0; j < 16; ++j) q8[64 * j] = q8x4(v[j].x, v[j].y, v[j].z, v[j].w, inv);
    if (lane == 0) *scale_out = mx * (1.0f / 127.0f);
}
template <int MODE> __device__ __forceinline__ void p0_tr64(const float* W, int K, int N, void* WT, const unsigned* colmax, LAS float* scr, int item, int lane) {
    const int nblk = N / 64, kb = item / nblk, nb = item % nblk, k0 = 64 * kb, n0 = 64 * nb; const int kk = lane >> 4, n4 = lane & 15;
    const float* src = W + (size_t)(k0 + kk) * N + n0 + 4 * n4;
#pragma unroll 8
    for (int i = 0; i < 16; ++i) { const f32x4 v = *(const GAS f32x4*)(src + (size_t)(4 * i) * N); LAS float* d = scr + (4 * i + kk) * 65 + 4 * n4; d[0] = v.x; d[1] = v.y; d[2] = v.z; d[3] = v.w; }
    LDS_WAIT(); asm volatile("" ::: "memory");
    if (MODE == 2) { const int c = lane & 3;
#pragma unroll
        for (int j = 0; j < 4; ++j) { const int n = (lane >> 2) + 16 * j; const LAS float* sp = scr + (16 * c) * 65 + n; const float cm = __uint_as_float(colmax[n0 + n]); const float inv = cm > 0.f ? 127.0f / cm : 0.f;
            unsigned o[4];
#pragma unroll
            for (int w = 0; w < 4; ++w) o[w] = q8x4(sp[(4 * w + 0) * 65], sp[(4 * w + 1) * 65], sp[(4 * w + 2) * 65], sp[(4 * w + 3) * 65], inv);
            v4u ov; ov.x = o[0]; ov.y = o[1]; ov.z = o[2]; ov.w = o[3]; *(GAS v4u*)((i8*)WT + (size_t)(n0 + n) * K + k0 + 16 * c) = ov; }
    } else { const int c = lane & 7;
#pragma unroll
        for (int j = 0; j < 8; ++j) { const int n = (lane >> 3) + 8 * j; const LAS float* sp = scr + (8 * c) * 65 + n;
            v4u o; o.x = cvtpk(sp[0 * 65], sp[1 * 65]); o.y = cvtpk(sp[2 * 65], sp[3 * 65]); o.z = cvtpk(sp[4 * 65], sp[5 * 65]); o.w = cvtpk(sp[6 * 65], sp[7 * 65]);
            int nrow = n0 + n; if (MODE == 1) { const int half = nrow >> 10, rem = nrow & 1023; nrow = (rem >> 7) * 256 + half * 128 + (rem & 127); }
            *(GAS v4u*)((bf16*)WT + (size_t)nrow * K + k0 + 8 * c) = o; }
    }
    LDS_WAIT(); asm volatile("" ::: "memory");
}
__device__ __forceinline__ void p0_transpose_q8_item(const float* W, int K, int N, const unsigned* colmax, i8* WT8, LAS float* scr, int item, int lane) {
    const int nblk = N / 32, kb = item / nblk, nb = item % nblk, k0 = 128 * kb, n0 = 32 * nb;
#pragma unroll 8
    for (int i = 0; i < 64; ++i) { const int kk = 2 * i + (lane >> 5); scr[kk * 33 + (lane & 31)] = W[(size_t)(k0 + kk) * N + n0 + (lane & 31)]; }
    LDS_WAIT(); asm volatile("" ::: "memory");
    const int c = lane & 7;
#pragma unroll
    for (int j = 0; j < 4; ++j) { const int n = (lane >> 3) + 8 * j; const LAS float* sp = scr + (16 * c) * 33 + n; const float cm = __uint_as_float(colmax[n0 + n]); const float inv = cm > 0.f ? 127.0f / cm : 0.f;
        unsigned o[4];
#pragma unroll
        for (int w = 0; w < 4; ++w) o[w] = q8x4(sp[(4 * w + 0) * 33], sp[(4 * w + 1) * 33], sp[(4 * w + 2) * 33], sp[(4 * w + 3) * 33], inv);
        v4u ov; ov.x = o[0]; ov.y = o[1]; ov.z = o[2]; ov.w = o[3]; *(GAS v4u*)(WT8 + (size_t)(n0 + n) * K + k0 + 16 * c) = ov; }
    LDS_WAIT(); asm volatile("" ::: "memory");
}

constexpr int PTILE = 512, NPTILE = M / PTILE, PPAIRS = PTILE * PSEL;
static_assert(PPAIRS == 65536, "pair index must fit 16 bits");
constexpr int SORT_SPLIT = 8;
__device__ __forceinline__ void sort_tile(Frame& F, int item, const int* EID, unsigned* PAIRS) {
    int tid = F.tid; asm volatile("" : "+v"(tid));
    const int tile = item / SORT_SPLIT, g = item % SORT_SPLIT;
    LAS unsigned* hist = (LAS unsigned*)F.lds; LAS unsigned* part = hist + 2048 + 64;
    for (int i = tid; i < 2048 + 64; i += 512) hist[i] = 0u;
    __syncthreads();
    const GAS i32x4* eid = (const GAS i32x4*)(EID + (size_t)tile * PPAIRS);
    unsigned below = 0;
    for (int i = tid; i < PPAIRS / 4; i += 512) { const i32x4 v = eid[i];
#pragma unroll
        for (int k = 0; k < 4; ++k) { const int e = v[k], hi = e >> 11, lo = e & 2047; below += (hi < g) ? 1u : 0u; if (hi == g) __hip_atomic_fetch_add(hist + lo + (lo >> 5), 1u, __ATOMIC_RELAXED, __HIP_MEMORY_SCOPE_WORKGROUP); } }
    part[tid] = below;
    __syncthreads();
    for (int d = 1; d < 512; d <<= 1) { const unsigned v = (tid >= d) ? part[tid - d] : 0u; __syncthreads(); part[tid] += v; __syncthreads(); }
    const unsigned base = part[511];
    __syncthreads();
    unsigned sum = 0;
#pragma unroll
    for (int j = 0; j < 4; ++j) { const int b = 4 * tid + j; sum += hist[b + (b >> 5)]; }
    part[tid] = sum;
    __syncthreads();
    for (int d = 1; d < 512; d <<= 1) { const unsigned v = (tid >= d) ? part[tid - d] : 0u; __syncthreads(); part[tid] += v; __syncthreads(); }
    unsigned run = base + part[tid] - sum;
#pragma unroll
    for (int j = 0; j < 4; ++j) { const int b = 4 * tid + j; const unsigned c = hist[b + (b >> 5)]; hist[b + (b >> 5)] = run; run += c; }
    __syncthreads();
    for (int i = tid; i < PPAIRS / 4; i += 512) { const i32x4 v = eid[i];
#pragma unroll
        for (int k = 0; k < 4; ++k) { const int e = v[k], lo = e & 2047; if ((e >> 11) == g) { const unsigned pos = __hip_atomic_fetch_add(hist + lo + (lo >> 5), 1u, __ATOMIC_RELAXED, __HIP_MEMORY_SCOPE_WORKGROUP); PAIRS[(size_t)tile * PPAIRS + pos] = ((unsigned)e << 16) | (unsigned)(4 * i + k); } } }
    __syncthreads();
}
#define ULOAD(Ux, ent) do { const GAS v4u* _u = (const GAS v4u*)(UT + (size_t)((ent) >> 16) * DM) + lane; _Pragma("unroll") for (int _i = 0; _i < 4; ++_i) Ux[_i] = _u[64 * _i]; } while (0)
#define HLOAD(Hx, ent) do { const GAS v4u* _h = (const GAS v4u*)(HN8 + ((size_t)tile * PTILE + (((ent) >> 7) & 511u)) * DM) + lane; _Pragma("unroll") for (int _i = 0; _i < 4; ++_i) Hx[_i] = _h[64 * _i]; } while (0)
#define UNIT_NEXT(s_, n_) do { const unsigned long long _m = ((s_) >= 63) ? 0ull : (firsts >> ((s_) + 1)); int _r = _m ? (int)__builtin_ctzll(_m) + 1 : 64; if (_r > npos - (s_)) _r = npos - (s_); n_ = _r < 4 ? _r : 4; } while (0)
#define UNIT_LOAD(U_, H0_, H1_, H2_, H3_, s_, n_) do { ULOAD(U_, ENT(s_)); HLOAD(H0_, ENT(s_)); if ((n_) > 1) HLOAD(H1_, ENT((s_) + 1)); if ((n_) > 2) HLOAD(H2_, ENT((s_) + 2)); if ((n_) > 3) HLOAD(H3_, ENT((s_) + 3)); } while (0)
#define UNIT_COMPUTE(U_, H0_, H1_, H2_, H3_, s_, n_) do { int part[4]; part[0] = dotrow8(U_, H0_); part[1] = dotrow8(U_, H1_); part[2] = dotrow8(U_, H2_); part[3] = dotrow8(U_, H3_); int p2[2]; \
    _Pragma("unroll") for (int i = 0; i < 2; ++i) { const int send = hh ? part[i] : part[i + 2], keep = hh ? part[i + 2] : part[i]; p2[i] = keep + __shfl_xor(send, 32); } \
    int p1; { const int send = b4 ? p2[0] : p2[1], keep = b4 ? p2[1] : p2[0]; p1 = keep + __shfl_xor(send, 16); } \
    p1 += __shfl_xor(p1, 8); p1 += __shfl_xor(p1, 4); p1 += __shfl_xor(p1, 2); p1 += __shfl_xor(p1, 1); \
    const int j = lane >> 4; const unsigned me = (unsigned)__shfl((int)myent, (j < (n_)) ? (s_) + j : (s_)); \
    if ((lane & 15) == 0 && j < (n_)) SC[((size_t)tile * PTILE + ((me >> 7) & 511u)) * PSEL + (me & 127u)] = p1; } while (0)
__device__ __forceinline__ void uphase_chunk(int tile, unsigned c0, unsigned c1, int lane, const unsigned* PAIRS, const i8* UT, const i8* HN8, int* SC) {
    const unsigned* pr = PAIRS + (size_t)tile * PPAIRS; const int hh = lane >> 5, b4 = (lane >> 4) & 1;
    for (unsigned base = c0; base < c1; base += 64) {
        const int npos = (int)((c1 - base) < 64u ? (c1 - base) : 64u);
        const unsigned myent = pr[base + (unsigned)(lane < npos ? lane : npos - 1)];
        const unsigned prev = (unsigned)__shfl_up((int)myent, 1);
        const unsigned long long firsts = __ballot((lane == 0) || ((myent >> 16) != (prev >> 16)));
#define ENT(q) ((unsigned)__builtin_amdgcn_readlane((int)myent, (q)))
        v4u U0[4], U1[4], U2[4], HA0[4], HA1[4], HA2[4], HA3[4], HB0[4], HB1[4], HB2[4], HB3[4];
        int s = 0, sa = 0, na = 0, sb = 0, nb = 0, sc = 0, nc = 0;
#define UNIT_ADV(s_out, n_out) do { if (s < npos) { UNIT_NEXT(s, n_out); s_out = s; s += n_out; } else n_out = 0; } while (0)
#define HLOADS(H0_, H1_, H2_, H3_, s_, n_) do { HLOAD(H0_, ENT(s_)); if ((n_) > 1) HLOAD(H1_, ENT((s_) + 1)); if ((n_) > 2) HLOAD(H2_, ENT((s_) + 2)); if ((n_) > 3) HLOAD(H3_, ENT((s_) + 3)); } while (0)
#define USTEP(Ucur, Hc0, Hc1, Hc2, Hc3, Unn, Hn0, Hn1, Hn2, Hn3) { \
            if (nb) HLOADS(Hn0, Hn1, Hn2, Hn3, sb, nb); \
            if (nc) ULOAD(Unn, ENT(sc)); \
            UNIT_COMPUTE(Ucur, Hc0, Hc1, Hc2, Hc3, sa, na); \
            sa = sb; na = nb; sb = sc; nb = nc; UNIT_ADV(sc, nc); \
            if (na == 0) break; }
        UNIT_ADV(sa, na); UNIT_ADV(sb, nb); UNIT_ADV(sc, nc);
        HLOADS(HA0, HA1, HA2, HA3, sa, na); ULOAD(U0, ENT(sa)); if (nb) ULOAD(U1, ENT(sb));
#pragma unroll 1
        for (;;) {
            USTEP(U0, HA0, HA1, HA2, HA3, U2, HB0, HB1, HB2, HB3)
            USTEP(U1, HB0, HB1, HB2, HB3, U0, HA0, HA1, HA2, HA3)
            USTEP(U2, HA0, HA1, HA2, HA3, U1, HB0, HB1, HB2, HB3)
            USTEP(U0, HB0, HB1, HB2, HB3, U2, HA0, HA1, HA2, HA3)
            USTEP(U1, HA0, HA1, HA2, HA3, U0, HB0, HB1, HB2, HB3)
            USTEP(U2, HB0, HB1, HB2, HB3, U1, HA0, HA1, HA2, HA3)
        }
#undef USTEP
#undef HLOADS
#undef UNIT_ADV
#undef ENT
    }
}

template <int NCH> __device__ __forceinline__ void quant_bf16_row(const bf16* src, i8* dst, float* scale_out, int lane) {
    v4u v[NCH]; float mx = 0.f;
#pragma unroll
    for (int i = 0; i < NCH; ++i) { v[i] = *((const GAS v4u*)src + i * 64 + lane);
        mx = fmaxf(mx, fmaxf(fmaxf(fmaxf(fabsf(bflo(v[i].x)), fabsf(bfhi(v[i].x))), fmaxf(fabsf(bflo(v[i].y)), fabsf(bfhi(v[i].y)))), fmaxf(fmaxf(fabsf(bflo(v[i].z)), fabsf(bfhi(v[i].z))), fmaxf(fabsf(bflo(v[i].w)), fabsf(bfhi(v[i].w)))))); }
    mx = wave_max(mx); const float inv = mx > 0.f ? 127.0f / mx : 0.f;
#pragma unroll
    for (int i = 0; i < NCH; ++i) { u32x2 o;
        o.x = q8x4(bflo(v[i].x), bfhi(v[i].x), bflo(v[i].y), bfhi(v[i].y), inv);
        o.y = q8x4(bflo(v[i].z), bfhi(v[i].z), bflo(v[i].w), bfhi(v[i].w), inv);
        *((GAS u32x2*)dst + i * 64 + lane) = o; }
    if (lane == 0) *scale_out = mx * (1.0f / 127.0f);
}

__device__ __forceinline__ int order_id(const Frame& F, const XcdBarrier& bar, bool use_bar) {
    if (!use_bar) return (int)blockIdx.x;
    const unsigned x = F.xcc, rank = F.xrank; unsigned nx = 0, xi = 0; bool uniform = true; const unsigned per = (unsigned)F.G >> 3;
    for (unsigned j = 0; j < 16; ++j) { const unsigned c = xb_ld(&bar.bar[XB_XCNT(j)]); nx += (c > 0u); xi += (c > 0u && j < x); uniform = uniform && (c == 0u || c == per); }
    return (uniform && nx == 8u && (F.G & 7) == 0 && rank < per) ? (int)(rank * 8u + xi) : (int)blockIdx.x;
}
__device__ __forceinline__ void rms_row16_to_i8(const bf16* xrow, const float* g, i8* o8row, float* scale_out, int lane) {
    float v[64]; float s = 0.f;
#pragma unroll
    for (int j = 0; j < 8; ++j) { const v4u t = *((const GAS v4u*)xrow + 64 * j + lane);
        v[8 * j + 0] = bflo(t.x); v[8 * j + 1] = bfhi(t.x); v[8 * j + 2] = bflo(t.y); v[8 * j + 3] = bfhi(t.y); v[8 * j + 4] = bflo(t.z); v[8 * j + 5] = bfhi(t.z); v[8 * j + 6] = bflo(t.w); v[8 * j + 7] = bfhi(t.w);
#pragma unroll
        for (int e = 0; e < 8; ++e) s += v[8 * j + e] * v[8 * j + e]; }
    const float rstd = 1.0f / sqrtf(wave_sum(s) * (1.f / DM) + NORM_EPS); float mx = 0.f;
#pragma unroll
    for (int j = 0; j < 8; ++j) { const f32x4 g0 = *((const GAS f32x4*)g + 2 * (64 * j + lane)), g1 = *((const GAS f32x4*)g + 2 * (64 * j + lane) + 1);
        v[8 * j + 0] *= rstd * g0.x; v[8 * j + 1] *= rstd * g0.y; v[8 * j + 2] *= rstd * g0.z; v[8 * j + 3] *= rstd * g0.w; v[8 * j + 4] *= rstd * g1.x; v[8 * j + 5] *= rstd * g1.y; v[8 * j + 6] *= rstd * g1.z; v[8 * j + 7] *= rstd * g1.w;
#pragma unroll
        for (int e = 0; e < 8; ++e) mx = fmaxf(mx, fabsf(v[8 * j + e])); }
    mx = wave_max(mx); const float inv = mx > 0.f ? 127.0f / mx : 0.f;
#pragma unroll
    for (int j = 0; j < 8; ++j) { u32x2 o;
        o.x = q8x4(v[8 * j + 0], v[8 * j + 1], v[8 * j + 2], v[8 * j + 3], inv);
        o.y = q8x4(v[8 * j + 4], v[8 * j + 5], v[8 * j + 6], v[8 * j + 7], inv);
        *((GAS u32x2*)o8row + 64 * j + lane) = o; }
    if (lane == 0) *scale_out = mx * (1.0f / 127.0f);
}
__device__ __forceinline__ void xcc_local_barrier(gu32* ctl, unsigned x, unsigned nloc, unsigned* tmo_bar) {
    asm volatile("s_waitcnt vmcnt(0)" ::: "memory");
    __syncthreads();
    if (threadIdx.x == 0) {
        __builtin_amdgcn_s_waitcnt(0);
        unsigned xx = x; asm volatile("" : "+s"(xx));
        unsigned* cnt = (unsigned*)ctl + CW_LBAR + 64 * xx; unsigned* gen = (unsigned*)ctl + CW_LBAR + 1024 + 64 * xx;
        const unsigned old = xb_add(cnt, 1u), g = old / nloc;
        if (old + 1u == (g + 1u) * nloc) xb_add(gen, 1u);
        else XB_SPIN(xb_ld(gen) == g, tmo_bar);
        __builtin_amdgcn_fence(__ATOMIC_ACQUIRE, "agent");
        asm volatile("s_waitcnt vmcnt(0)" ::: "memory");
    }
    __syncthreads();
}
struct Args { const float* in[22]; float* out; unsigned char* ws; int ph_lo, ph_hi, dup, pad; };
__global__ void __launch_bounds__(NWAVES * 64, 2) hybrid_fwd(Args args) {
    extern __shared__ __attribute__((aligned(16))) unsigned char lds[];
    Frame F;
    F.lds = (LAS unsigned char*)lds; F.MISC = (volatile LAS unsigned*)(F.lds + MISC_OFF);
    F.tid = threadIdx.x; F.lane = F.tid & 63; F.wave = __builtin_amdgcn_readfirstlane(F.tid >> 6); F.G = gridDim.x; F.ws = args.ws;
    F.ctl = (gu32*)(args.ws + WS_CTL);
    for (int u = F.tid; u < (LDS_BYTES - LDSCTL_OFF) / 4; u += NWAVES * 64) ((LAS unsigned*)(F.lds + LDSCTL_OFF))[u] = 0u;
    __syncthreads();
    const int lo = args.ph_lo, hi = args.ph_hi;
    const bool use_bar = MK_ONE_LAUNCH ? true : (hi - lo) > 1;
    XcdBarrier bar; bar.bar = (unsigned*)(F.ctl + CW_BAR); bar.x = 0; bar.st = nullptr;
    if (use_bar) bar = xcd_barrier_post((unsigned*)(F.ctl + CW_BAR), F.MISC + 8);
    if (F.tid == 0) { const unsigned x = use_bar ? xb_xcc_id() : (blockIdx.x & 7u); F.MISC[10] = x;
        F.MISC[11] = use_bar ? __hip_atomic_fetch_add((unsigned*)(F.ctl + CW_XRANK) + 64 * x, 1u, __ATOMIC_RELAXED, __HIP_MEMORY_SCOPE_AGENT) : (blockIdx.x >> 3); }
    __syncthreads();
    F.xcc = (unsigned)__builtin_amdgcn_readfirstlane((int)F.MISC[10]); F.xrank = (unsigned)__builtin_amdgcn_readfirstlane((int)F.MISC[11]);
#ifndef DUPMASK
#define DUPMASK 0
#endif
#define REPS(k)
#if MK_ONE_LAUNCH
#define DRY false
#else
#define DRY (args.dup != 0)
#endif
#ifndef PHSUB
#define PHSUB 3
#endif
#ifndef PHMASK
#define PHMASK 0x3ff
#endif
#if MK_ONE_LAUNCH
#define IN(k) true
#define SEAM(k) do { if ((k) + 1 < NPHASES) xcd_barrier(bar); } while (0)
#else
#define IN(k) (lo <= (k) && (k) < hi)
#define SEAM(k) do { if (IN(k) && IN((k) + 1)) xcd_barrier(bar); } while (0)
#endif
#define PH_PTRS int z_; asm volatile("s_mov_b32 %0, 0" : "=s"(z_)); int lane_ = F.tid & 63; asm volatile("" : "+v"(lane_)); const int gw = gw0 + z_; (void)gw; unsigned char* ws = args.ws + z_; float* X = args.out + z_; (void)X; \
    bf16* XN = (bf16*)(ws + WS_XN); bf16* Qb = (bf16*)(ws + WS_Q); bf16* KBb = (bf16*)(ws + WS_KB); bf16* VTb = (bf16*)(ws + WS_VT); bf16* Ub = (bf16*)(ws + WS_U); \
    bf16* GA = (bf16*)(ws + WS_GA); bf16* GS = (bf16*)(ws + WS_GS); bf16* ATT = (bf16*)(ws + WS_ATT); bf16* Zb = (bf16*)(ws + WS_Z); bf16* SSb = (bf16*)(ws + WS_SS); \
    bf16* MG = (bf16*)(ws + WS_MG); bf16* PQ = (bf16*)(ws + WS_PQ); bf16* HN = (bf16*)(ws + WS_HN); int* EID = (int*)(ws + WS_EID); float* GATE = (float*)(ws + WS_GATE); i8* HN8 = (i8*)(ws + WS_HN8); float* HS = (float*)(ws + WS_HS); (void)HN8; (void)HS; unsigned* PAIRS = (unsigned*)(ws + WS_PAIRS); int* SC = (int*)(ws + WS_SC); (void)PAIRS; (void)SC; i8* ATT8 = (i8*)(ws + WS_XN + 65 * MiB); i8* SS8 = (i8*)(ws + WS_XN + 97 * MiB); i8* MG8 = (i8*)(ws + WS_Q); float* ATS = (float*)(ws + WS_HS + 256 * 1024); float* SSS = (float*)(ws + WS_HS + 512 * 1024); float* MGS = (float*)(ws + WS_HS + 768 * 1024); (void)ATT8; (void)SS8; (void)MG8; (void)ATS; (void)SSS; (void)MGS; bf16* XB = (bf16*)(ws + WS_HN); (void)XB; i8* XN8 = (i8*)(ws + WS_XN); float* XS = (float*)(ws + WS_XN + 64 * MiB); (void)XN8; (void)XS; \
    (void)XN; (void)Qb; (void)KBb; (void)VTb; (void)Ub; (void)GA; (void)GS; (void)ATT; (void)Zb; (void)SSb; (void)MG; (void)PQ; (void)HN; (void)EID; (void)GATE;
#define INP(i) (args.in[(i) + z_])
#define ORDER_ID() order_id(F, bar, use_bar)
    const int gw0 = blockIdx.x * NWAVES + F.wave, NGW = F.G * NWAVES;

    if (IN(0)) { PH_PTRS
        for (int t = gw; t < DEPTH * 32 * 48; t += NGW) { const int l = t / 1536, r = t % 1536, kc = r / 48, nb = r % 48;
            const float* src = INP(2) + ((size_t)l * DM + kc * 128) * INCOLS + nb * 256 + lane_ * 4; f32x4 mx = (f32x4){0.f, 0.f, 0.f, 0.f};
#pragma unroll 8
            for (int k = 0; k < 128; ++k) { const f32x4 v = *(const GAS f32x4*)(src + (size_t)k * INCOLS); mx.x = fmaxf(mx.x, fabsf(v.x)); mx.y = fmaxf(mx.y, fabsf(v.y)); mx.z = fmaxf(mx.z, fabsf(v.z)); mx.w = fmaxf(mx.w, fabsf(v.w)); }
            unsigned* cm = (unsigned*)(F.ctl + CW_COLMAX) + l * INCOLS + nb * 256 + lane_ * 4;
            __hip_atomic_fetch_max(cm + 0, __float_as_uint(mx.x), __ATOMIC_RELAXED, __HIP_MEMORY_SCOPE_AGENT); __hip_atomic_fetch_max(cm + 1, __float_as_uint(mx.y), __ATOMIC_RELAXED, __HIP_MEMORY_SCOPE_AGENT);
            __hip_atomic_fetch_max(cm + 2, __float_as_uint(mx.z), __ATOMIC_RELAXED, __HIP_MEMORY_SCOPE_AGENT); __hip_atomic_fetch_max(cm + 3, __float_as_uint(mx.w), __ATOMIC_RELAXED, __HIP_MEMORY_SCOPE_AGENT); }
    }
    if (IN(0)) { PH_PTRS
        constexpr int T_AB = (ATTW / 128) * 16, T_SB = (SSMW / 128) * 16, T_OUT = (DM / 128) * 16, T_L = T_AB + T_SB + T_OUT;
        for (int t = gw; t < DEPTH * T_L; t += NGW) { const int l = t / T_L; int r = t % T_L; int which, K; const float* W;
            if (r < T_AB) { which = 0; K = ATTW; W = INP(13) + (size_t)l * ATTW * DM; } else if (r < T_AB + T_SB) { r -= T_AB; which = 1; K = SSMW; W = INP(14) + (size_t)l * SSMW * DM; } else { r -= T_AB + T_SB; which = 2; K = DM; W = INP(15) + (size_t)l * DM * DM; }
            (void)K; const int kc = r / 16, nb = r % 16; const float* src = W + (size_t)(kc * 128) * DM + nb * 256 + lane_ * 4; f32x4 mx = (f32x4){0.f, 0.f, 0.f, 0.f};
#pragma unroll 8
            for (int k = 0; k < 128; ++k) { const f32x4 v = *(const GAS f32x4*)(src + (size_t)k * DM); mx.x = fmaxf(mx.x, fabsf(v.x)); mx.y = fmaxf(mx.y, fabsf(v.y)); mx.z = fmaxf(mx.z, fabsf(v.z)); mx.w = fmaxf(mx.w, fabsf(v.w)); }
            unsigned* cm = (unsigned*)(F.ctl + CW_COLMAX2) + (l * 3 + which) * DM + nb * 256 + lane_ * 4;
            __hip_atomic_fetch_max(cm + 0, __float_as_uint(mx.x), __ATOMIC_RELAXED, __HIP_MEMORY_SCOPE_AGENT); __hip_atomic_fetch_max(cm + 1, __float_as_uint(mx.y), __ATOMIC_RELAXED, __HIP_MEMORY_SCOPE_AGENT);
            __hip_atomic_fetch_max(cm + 2, __float_as_uint(mx.z), __ATOMIC_RELAXED, __HIP_MEMORY_SCOPE_AGENT); __hip_atomic_fetch_max(cm + 3, __float_as_uint(mx.w), __ATOMIC_RELAXED, __HIP_MEMORY_SCOPE_AGENT); }
    }
    if (IN(0)) { PH_PTRS
        for (int t = gw; t < DEPTH * 32 * 8; t += NGW) { const int l = t / 256, r = t % 256, kc = r / 8, nb = r % 8;
            const float* src = INP(17) + ((size_t)l * DM + kc * 128) * (PH * PDK) + nb * 256 + lane_ * 4; f32x4 mx = (f32x4){0.f, 0.f, 0.f, 0.f};
#pragma unroll 8
            for (int k = 0; k < 128; ++k) { const f32x4 v = *(const GAS f32x4*)(src + (size_t)k * (PH * PDK)); mx.x = fmaxf(mx.x, fabsf(v.x)); mx.y = fmaxf(mx.y, fabsf(v.y)); mx.z = fmaxf(mx.z, fabsf(v.z)); mx.w = fmaxf(mx.w, fabsf(v.w)); }
            unsigned* cm = (unsigned*)(F.ctl + CW_COLMAX3) + l * 2048 + nb * 256 + lane_ * 4;
            __hip_atomic_fetch_max(cm + 0, __float_as_uint(mx.x), __ATOMIC_RELAXED, __HIP_MEMORY_SCOPE_AGENT); __hip_atomic_fetch_max(cm + 1, __float_as_uint(mx.y), __ATOMIC_RELAXED, __HIP_MEMORY_SCOPE_AGENT);
            __hip_atomic_fetch_max(cm + 2, __float_as_uint(mx.z), __ATOMIC_RELAXED, __HIP_MEMORY_SCOPE_AGENT); __hip_atomic_fetch_max(cm + 3, __float_as_uint(mx.w), __ATOMIC_RELAXED, __HIP_MEMORY_SCOPE_AGENT); }
    }
    SEAM(0);
#define CONVERT_WEIGHTS(l, lw, scr) do { \
            constexpr int I_IN = (DM / 64) * (INCOLS / 64), I_AB = (ATTW / 64) * (DM / 64), I_SB = (SSMW / 64) * (DM / 64), I_OUT = (DM / 64) * (DM / 64), I_GLU = (SSMW / 64) * (2 * SSMW / 64), I_PQ = (DM / 64) * (PH * PDK / 64); \
            constexpr int NIT = I_IN + I_AB + I_SB + I_OUT + I_GLU + I_PQ; \
            for (int it = gw; it < NIT; it += NGW) { \
                int r = it; \
                if (r < I_IN) { p0_tr64<2>(INP(2) + (size_t)l * DM * INCOLS, DM, INCOLS, lw + LW_WIN, (const unsigned*)(F.ctl + CW_COLMAX) + l * INCOLS, scr, r, lane_); continue; } r -= I_IN; \
                if (r < I_AB) { p0_tr64<2>(INP(13) + (size_t)l * ATTW * DM, ATTW, DM, lw + LW_WAB, (const unsigned*)(F.ctl + CW_COLMAX2) + (l * 3 + 0) * DM, scr, r, lane_); continue; } r -= I_AB; \
                if (r < I_SB) { p0_tr64<2>(INP(14) + (size_t)l * SSMW * DM, SSMW, DM, lw + LW_WSB, (const unsigned*)(F.ctl + CW_COLMAX2) + (l * 3 + 1) * DM, scr, r, lane_); continue; } r -= I_SB; \
                if (r < I_OUT) { p0_tr64<2>(INP(15) + (size_t)l * DM * DM, DM, DM, lw + LW_WOUT, (const unsigned*)(F.ctl + CW_COLMAX2) + (l * 3 + 2) * DM, scr, r, lane_); continue; } r -= I_OUT; \
                if (r < I_GLU) { p0_tr64<1>(INP(11) + (size_t)l * SSMW * 2 * SSMW, SSMW, 2 * SSMW, lw + LW_WGLU, nullptr, scr, r, lane_); continue; } r -= I_GLU; \
                p0_tr64<2>(INP(17) + (size_t)l * DM * PH * PDK, DM, PH * PDK, lw + LW_WPQ, (const unsigned*)(F.ctl + CW_COLMAX3) + l * 2048, scr, r, lane_); \
            } \
        } while (0)
    if (((PHMASK >> 0) & 1) && IN(1)) REPS(0) { PH_PTRS
        LAS float* scr = (LAS float*)(F.lds + F.wave * 16896);
        for (int l = 0; l < DEPTH; ++l) {
            unsigned char* lw = ws + WS_LW + (size_t)l * LW_SIZE;
            if (l == 0) CONVERT_WEIGHTS(l, lw, scr);
            constexpr size_t NK = (size_t)PH * 2 * NKEYS * 128 / 512;
            for (size_t st = gw; st < NK; st += NGW) { const float* src = INP(18) + (size_t)l * PH * 2 * NKEYS * 128; bf16* dst = (bf16*)(lw + LW_KEYS);
                const size_t e = st * 512 + lane_ * 8; const f32x4 a = *(const GAS f32x4*)(src + e), b = *(const GAS f32x4*)(src + e + 4);
                v4u o; o.x = cvtpk(a.x, a.y); o.y = cvtpk(a.z, a.w); o.z = cvtpk(b.x, b.y); o.w = cvtpk(b.z, b.w); *(GAS v4u*)(dst + e) = o; }
        }
        for (int i = gw * 64 + lane_; i < DEPTH * 2048; i += NGW * 64) ((float*)(ws + WS_LW + (size_t)(i / 2048) * LW_SIZE + LW_WPQS))[i % 2048] = __uint_as_float(((const unsigned*)(F.ctl + CW_COLMAX3))[i]) * (1.0f / 127.0f);
        for (int i = gw * 64 + lane_; i < DEPTH * 3 * DM; i += NGW * 64) { const int l = i / (3 * DM), which = (i / DM) % 3, n = i % DM; unsigned char* lw = ws + WS_LW + (size_t)l * LW_SIZE;
            ((float*)(lw + (which == 0 ? LW_WABS : which == 1 ? LW_WSBS : LW_WOUTS)))[n] = __uint_as_float(((const unsigned*)(F.ctl + CW_COLMAX2))[i]) * (1.0f / 127.0f); }
        for (int l = 0; l < DEPTH; ++l) for (int n = gw * 64 + lane_; n < INCOLS; n += NGW * 64) ((float*)(ws + WS_LW + (size_t)l * LW_SIZE + LW_WINS))[n] = __uint_as_float(((const unsigned*)(F.ctl + CW_COLMAX))[l * INCOLS + n]) * (1.0f / 127.0f);
        for (int m = gw; m < M; m += NGW) rms_row_to_i8(INP(0) + (size_t)m * DM, INP(1), XN8 + (size_t)m * DM, XS + m, lane_);
        __syncthreads();
        for (int it2 = blockIdx.x; it2 < DEPTH * SSMG * 2; it2 += F.G) { const int it = it2 >> 1, half = it2 & 1; const int l = it / SSMG, g = it % SSMG; unsigned char* lw = ws + WS_LW + (size_t)l * LW_SIZE;
            s5_precompute(F, INP(3) + l * SSMG * 64, INP(4) + l * SSMG * 64, INP(5) + l * SSMG, INP(6) + (size_t)l * SSMG * 1024, INP(7) + (size_t)l * SSMG * 1024,
                          INP(8) + (size_t)l * SSMG * 1024, INP(9) + (size_t)l * SSMG * 1024, g, half, (bf16*)(lw + LW_S5K), (bf16*)(lw + LW_S5ME), (bf16*)(lw + LW_S5MC), (float*)(lw + LW_S5LAM)); }
    }
    SEAM(1);
    if (use_bar) { unsigned nloc = 0, xi = 0, nx = 0;
        for (unsigned j = 0; j < 16; ++j) { const unsigned c = xb_ld(&bar.bar[XB_XCNT(j)]); nx += (c > 0u); xi += (c > 0u && j < F.xcc); nloc = (j == F.xcc) ? c : nloc; }
        F.xi = (unsigned)__builtin_amdgcn_readfirstlane((int)xi); F.nx = (unsigned)__builtin_amdgcn_readfirstlane((int)(nx ? nx : 1u)); F.nloc = (unsigned)__builtin_amdgcn_readfirstlane((int)(nloc ? nloc : 1u)); }
    else if ((F.G & 7) == 0) { F.xi = F.xcc; F.nx = 8; F.nloc = (unsigned)F.G >> 3; }
    else { F.xi = 0; F.nx = 1; F.nloc = (unsigned)F.G; F.xrank = blockIdx.x; }
    const int wl = (int)F.xrank * NWAVES + F.wave, NWL = (int)F.nloc * NWAVES;
#define LSEAM(k) do { if (use_bar && (k) + 1 < NPHASES) xcc_local_barrier(F.ctl, F.xcc, F.nloc, bar.bar); } while (0)
#define FOR_OWNED(b) for (int b = (int)F.xi; b < BATCH; b += (int)F.nx)

#pragma unroll 1
    for (int l = 0; l < DEPTH; ++l) {
        const int pb = NPH_PRO + l * NPH_LAYER;
        if (((PHMASK >> 1) & 1) && IN(pb + 0)) REPS(1) { PH_PTRS unsigned char* lw = ws + WS_LW + (size_t)l * LW_SIZE; (void)lw;
            pg8::Gemm g{(const bf16*)XN8, (const bf16*)(lw + LW_WIN), M, INCOLS, DM / 2}; pg8::LocalWindow S; S.init(INCOLS, (int)F.nloc, (int)F.xrank, (int)F.xi, (int)F.nx);
            const int mine = (S.nbo * 8 * S.nN - (int)F.xrank + (int)F.nloc - 1) / (int)F.nloc, cut = ((int)F.xrank * (mine + 1)) / (int)F.nloc;
            pg8::EpiIn8 E{Qb, KBb, VTb, Ub, GA, GS, XS, (const float*)(lw + LW_WINS)};
            S.lo = 0; S.hi = cut; pg8::gemm_phase<pg8::EpiIn8, pg8::LocalWindow, true, true>(F.lds, g, S, E);
            convert_tables(INP(19) + (size_t)l * NEXP * DM, INP(20) + (size_t)l * NEXP * DM, lw, (int)blockIdx.x * NWAVES + F.wave, F.G * NWAVES, lane_);
            if (l + 1 < DEPTH) { LAS float* scr = (LAS float*)(F.lds + F.wave * 16896); unsigned char* lw1 = lw + LW_SIZE; const int l1 = l + 1; CONVERT_WEIGHTS(l1, lw1, scr); }
            if (use_bar) { asm volatile("s_waitcnt vmcnt(0)" ::: "memory"); __syncthreads();
                if (threadIdx.x == 0) { __builtin_amdgcn_fence(__ATOMIC_RELEASE, "agent"); asm volatile("s_waitcnt vmcnt(0)" ::: "memory"); (void)xb_add((unsigned*)F.ctl + CW_CONV + 64 * l, 1u); } }
            S.lo = cut; S.hi = 1 << 30; pg8::gemm_phase<pg8::EpiIn8, pg8::LocalWindow, true, true>(F.lds, g, S, E);
        }
        LSEAM(pb + 0);
        if (((PHMASK >> 2) & 1) && IN(pb + 1)) REPS(2) { PH_PTRS unsigned char* lw = ws + WS_LW + (size_t)l * LW_SIZE; (void)lw;
            FOR_OWNED(b) for (int j = (int)F.xrank; j < 128; j += (int)F.nloc) {
                if (j < 64) attn_unit(F, b, j >> 2, j & 3, Qb, KBb, VTb, ATT, INP(12) + l * NQH);
                else s5_unit(F, b, j - 64, Ub, (const bf16*)(lw + LW_S5K), (const bf16*)(lw + LW_S5ME), (const bf16*)(lw + LW_S5MC), (const float*)(lw + LW_S5LAM), INP(10) + l * SSMW, Zb);
            }
        }
        LSEAM(pb + 1);
        if (((PHMASK >> 3) & 1) && IN(pb + 2)) REPS(3) { PH_PTRS unsigned char* lw = ws + WS_LW + (size_t)l * LW_SIZE; (void)lw;
            pg8::Gemm g{Zb, (const bf16*)(lw + LW_WGLU), M, 2 * SSMW, SSMW}; pg8::LocalOrder S; S.init(2 * SSMW, (int)F.nloc, (int)F.xrank, (int)F.xi, (int)F.nx);
            pg8::EpiGlu E{SSb, SSMW};
            pg8::gemm_phase<pg8::EpiGlu, pg8::LocalOrder, true, true>(F.lds, g, S, E);
        }
        LSEAM(pb + 2);
        if (IN(pb + 3)) { PH_PTRS FOR_OWNED(b) for (int m = b * SEQ + wl; m < (b + 1) * SEQ; m += NWL) { quant_bf16_row<4>(ATT + (size_t)m * ATTW, ATT8 + (size_t)m * ATTW, ATS + m, lane_); quant_bf16_row<2>(SSb + (size_t)m * SSMW, SS8 + (size_t)m * SSMW, SSS + m, lane_); } }
        LSEAM(pb + 3);
        if (((PHMASK >> 4) & 1) && IN(pb + 4)) REPS(4) { PH_PTRS unsigned char* lw = ws + WS_LW + (size_t)l * LW_SIZE; (void)lw;
            { pg8::Gemm g{(const bf16*)ATT8, (const bf16*)(lw + LW_WAB), M, DM, ATTW / 2}; pg8::LocalOrder S; S.init(DM, (int)F.nloc, (int)F.xrank, (int)F.xi, (int)F.nx); pg8::EpiGate8<false> E{MG, GA, DM, ATS, (const float*)(lw + LW_WABS)};
              pg8::gemm_phase<pg8::EpiGate8<false>, pg8::LocalOrder, true, true>(F.lds, g, S, E); }
            { pg8::Gemm g{(const bf16*)SS8, (const bf16*)(lw + LW_WSB), M, DM, SSMW / 2}; pg8::LocalOrder S; S.init(DM, (int)F.nloc, (int)F.xrank, (int)F.xi, (int)F.nx); pg8::EpiGate8<true> E{MG, GS, DM, SSS, (const float*)(lw + LW_WSBS)};
              pg8::gemm_phase<pg8::EpiGate8<true>, pg8::LocalOrder, true, true>(F.lds, g, S, E); }
        }
        LSEAM(pb + 4);
        if (IN(pb + 5)) { PH_PTRS FOR_OWNED(b) for (int m = b * SEQ + wl; m < (b + 1) * SEQ; m += NWL) quant_bf16_row<8>(MG + (size_t)m * DM, MG8 + (size_t)m * DM, MGS + m, lane_); }
        LSEAM(pb + 5);
        if (((PHMASK >> 5) & 1) && IN(pb + 6)) REPS(5) { PH_PTRS unsigned char* lw = ws + WS_LW + (size_t)l * LW_SIZE; (void)lw;
            pg8::Gemm g{(const bf16*)MG8, (const bf16*)(lw + LW_WOUT), M, DM, DM / 2}; pg8::LocalOrder S; S.init(DM, (int)F.nloc, (int)F.xrank, (int)F.xi, (int)F.nx);
            pg8::EpiRes8 E{l == 0 ? INP(0) : (const float*)nullptr, XB, DRY ? GA : XB, DM, MGS, (const float*)(lw + LW_WOUTS)};
            pg8::gemm_phase<pg8::EpiRes8, pg8::LocalOrder, true, true>(F.lds, g, S, E);
        }
        LSEAM(pb + 6);
        if (((PHMASK >> 6) & 1) && IN(pb + 7)) REPS(6) { PH_PTRS unsigned char* lw = ws + WS_LW + (size_t)l * LW_SIZE; (void)lw; FOR_OWNED(b) for (int m = b * SEQ + wl; m < (b + 1) * SEQ; m += NWL) rms_row16_to_i8(XB + (size_t)m * DM, INP(16) + l * DM, HN8 + (size_t)m * DM, HS + m, lane_); }
        LSEAM(pb + 7);
        if (((PHMASK >> 7) & 1) && IN(pb + 8)) REPS(7) { PH_PTRS unsigned char* lw = ws + WS_LW + (size_t)l * LW_SIZE; (void)lw;
            pg8::Gemm g{(const bf16*)HN8, (const bf16*)(lw + LW_WPQ), M, PH * PDK, DM / 2}; pg8::LocalOrder S; S.init(PH * PDK, (int)F.nloc, (int)F.xrank, (int)F.xi, (int)F.nx);
            pg8::EpiBf16Plain8 E{PQ, PH * PDK, HS, (const float*)(lw + LW_WPQS)};
            pg8::gemm_phase<pg8::EpiBf16Plain8, pg8::LocalOrder, true, true>(F.lds, g, S, E);
        }
        LSEAM(pb + 8);
        if (((PHMASK >> 8) & 1) && IN(pb + 9)) REPS(8) { PH_PTRS unsigned char* lw = ws + WS_LW + (size_t)l * LW_SIZE; (void)lw; FOR_OWNED(b) for (int tl = wl; tl < (SEQ / 32) * PH; tl += NWL) topk_task((b * (SEQ / 32) + (tl >> 3)) * PH + (tl & 7), lane_, PQ, (const bf16*)(lw + LW_KEYS), EID, GATE, F.lds + F.wave * 2304); }
        LSEAM(pb + 9);
        if (IN(pb + 10)) { PH_PTRS FOR_OWNED(b) for (int it = (int)F.xrank; it < (SEQ / PTILE) * SORT_SPLIT; it += (int)F.nloc) sort_tile(F, b * (SEQ / PTILE) * SORT_SPLIT + it, EID, PAIRS); }
        if (use_bar && threadIdx.x == 0) XB_SPIN(xb_ld((unsigned*)F.ctl + CW_CONV + 64 * l) < (unsigned)F.G, bar.bar);
        LSEAM(pb + 10);
        if (IN(pb + 11)) { PH_PTRS unsigned char* lw = ws + WS_LW + (size_t)l * LW_SIZE;
            const unsigned nW = (unsigned)NWL, chunk = (PPAIRS + nW - 1) / nW, wv = (unsigned)wl;
            FOR_OWNED(b) for (int tile = b * (SEQ / PTILE); tile < (b + 1) * (SEQ / PTILE); ++tile) { const unsigned c0 = wv * chunk, c1 = (c0 + chunk < (unsigned)PPAIRS) ? c0 + chunk : (unsigned)PPAIRS;
                if (c0 < c1) uphase_chunk(tile, c0, c1, lane_, PAIRS, (const i8*)(lw + LW_UTAB), HN8, SC); }
        }
        LSEAM(pb + 11);
        if (((PHMASK >> 9) & 1) && IN(pb + 12)) REPS(9) { PH_PTRS unsigned char* lw = ws + WS_LW + (size_t)l * LW_SIZE; (void)lw;
            if (l + 1 < DEPTH) { FOR_OWNED(b) for (int m = b * SEQ + wl; m < (b + 1) * SEQ; m += NWL) gather_token<false>((size_t)m, lane_, SC, HS, EID, GATE, (const float*)(lw + LW_SU), (const i8*)(lw + LW_VTAB), (const float*)(lw + LW_SV), (const i8*)(lw + LW_VT4), (const float*)(lw + LW_S4), XB, DRY ? GA : XB, X, INP(1) + (l + 1) * DM, DRY ? (i8*)MG : XN8, DRY ? (float*)Zb : XS); }
            else { FOR_OWNED(b) for (int m = b * SEQ + wl; m < (b + 1) * SEQ; m += NWL) gather_token<true>((size_t)m, lane_, SC, HS, EID, GATE, (const float*)(lw + LW_SU), (const i8*)(lw + LW_VTAB), (const float*)(lw + LW_SV), (const i8*)(lw + LW_VT4), (const float*)(lw + LW_S4), XB, XB, DRY ? (float*)GA : X, INP(21), XN8, XS); }
        }
        LSEAM(pb + 12);
    }
#undef IN
#undef SEAM
}

extern "C" void kernel_launch(void* const* d_in, const int* in_sizes, int n_in, void* d_out, int out_size, void* d_ws, size_t ws_size, hipStream_t stream) {
    static int grid = 0;
    if (grid == 0) {
        if (n_in != 22 || out_size != M * DM || ws_size < WS_END) { fprintf(stderr, "kernel_launch: unexpected shapes (n_in %d out %d ws %zu)\n", n_in, out_size, ws_size); grid = -1; return; }
        int dev = 0, cus = 0, per_cu = 0;
        if (hipGetDevice(&dev) != hipSuccess || hipDeviceGetAttribute(&cus, hipDeviceAttributeMultiprocessorCount, dev) != hipSuccess) { grid = -1; return; }
        if (hipFuncSetAttribute((const void*)hybrid_fwd, hipFuncAttributeMaxDynamicSharedMemorySize, LDS_BYTES) != hipSuccess) { fprintf(stderr, "kernel_launch: hipFuncSetAttribute failed\n"); grid = -1; return; }
        if (hipOccupancyMaxActiveBlocksPerMultiprocessor(&per_cu, (const void*)hybrid_fwd, NWAVES * 64, LDS_BYTES) != hipSuccess || per_cu < 1) fprintf(stderr, "kernel_launch: occupancy query says %d\n", per_cu);
        (void)hipGetLastError();
        grid = cus;
    }
    if (grid < 0) return;
    if (hipMemsetAsync((char*)d_ws + WS_CTL, 0, CTL_ZERO_BYTES, stream) != hipSuccess) return;
    Args a{};
    for (int i = 0; i < 22; ++i) a.in[i] = (const float*)d_in[i];
    a.out = (float*)d_out; a.ws = (unsigned char*)d_ws; a.dup = 0; a.pad = 0;
#if MK_ONE_LAUNCH
    a.ph_lo = 0; a.ph_hi = NPHASES;
    hipLaunchKernelGGL(hybrid_fwd, dim3(grid), dim3(NWAVES * 64), LDS_BYTES, stream, a);
#else
    for (int p = 0; p < NPHASES; ++p) { a.ph_lo = p; a.ph_hi = p + 1;
        const int k = p < NPH_PRO ? 0 : 1 + (p - NPH_PRO) % NPH_LAYER; if (p == 0 && k == 0) { hipLaunchKernelGGL(hybrid_fwd, dim3(grid), dim3(NWAVES * 64), LDS_BYTES, stream, a); continue; }
        if ((DUPMASK >> k) & 1) { a.dup = 1; hipLaunchKernelGGL(hybrid_fwd, dim3(grid), dim3(NWAVES * 64), LDS_BYTES, stream, a); a.dup = 0; }
        hipLaunchKernelGGL(hybrid_fwd, dim3(grid), dim3(NWAVES * 64), LDS_BYTES, stream, a); }
#endif
}
```

```cpp
#include <hip/hip_runtime.h>
#include <cstdio>
#include <cstdint>
namespace pg8 {
#define PG8_LAS __attribute__((address_space(3)))
typedef unsigned short bf16_t;
typedef short bf16x8 __attribute__((ext_vector_type(8)));
typedef float f32x4 __attribute__((ext_vector_type(4)));
typedef unsigned u32x4 __attribute__((ext_vector_type(4)));
typedef int i32x4 __attribute__((ext_vector_type(4)));
constexpr int BM = 256, BK = 64, HALF = 128, HTB = HALF * BK * 2  , STAGE_BYTES = 8 * HTB, NXCD = 8, WGM = 4;

__host__ __device__ __forceinline__ int lds_byte(int r, int c) { const int st = (r >> 4) * 2 + (c >> 5), rr = r & 15, cc = c & 31, ob = rr * 64 + cc * 2; return st * 1024 + (ob ^ (((ob >> 9) & 1) << 5)); }
__host__ __device__ __forceinline__ void stage_rc(int b, int& R, int& C) { const int st = b / 1024, sb = b % 1024, swz = sb ^ (((sb >> 9) & 1) << 5); R = (st >> 1) * 16 + swz / 64; C = (st & 1) * 32 + (swz % 64) / 2; }
__host__ __device__ __forceinline__ int perm32(int rho) { const int n = rho >> 4, i = rho & 15; return 8 * (i >> 2) + 4 * n + (i & 3); }

struct Unit { int pm, pn; };
struct Gemm { const bf16_t* A; const bf16_t* Bt; int M, N, K; };

struct StaticOrder {
    int nM, nN, nwg, G, c;
    __host__ __device__ void init(int M, int N, int G_, int c_) { nM = M / BM; nN = N / BM; nwg = nM * nN; G = G_; c = c_; }
    __host__ __device__ bool next(int i, Unit& u) const {
        const long L = (long)i * G + c; if (L >= nwg) return false;
        int wgid = (int)L; { const int q = nwg / NXCD, r = nwg % NXCD, xcd = wgid % NXCD, off = wgid / NXCD; wgid = (xcd < r ? xcd * (q + 1) : r * (q + 1) + (xcd - r) * q) + off; }
        const int nig = WGM * nN, gid = wgid / nig, fm = gid * WGM, gsz = (nM - fm) < WGM ? (nM - fm) : WGM;
        u.pm = fm + ((wgid % nig) % gsz); u.pn = (wgid % nig) / gsz; return true;
    }
    __device__ __forceinline__ void a_ready(const Unit&) const {}
    __device__ __forceinline__ void done(const Unit&) const {}
};
struct LocalOrder {
    int nN, nloc, rank, xi, nx, nbo;
    __host__ __device__ void init(int N, int nloc_, int rank_, int xi_, int nx_) { nN = N / BM; nloc = nloc_; rank = rank_; xi = xi_; nx = nx_; nbo = (8 - xi + nx - 1) / nx; }
    __host__ __device__ bool next(int i, Unit& u) const {
        const int per = 8 * nN, j = i * nloc + rank; if (j >= nbo * per) return false;
        const int bi = j / per, jj = j % per, b = xi + bi * nx;
        const int nig = WGM * nN, gid = jj / nig, fm = gid * WGM;
        u.pm = 8 * b + fm + (jj % nig) % WGM; u.pn = (jj % nig) / WGM; return true;
    }
    __device__ __forceinline__ void a_ready(const Unit&) const {}
    __device__ __forceinline__ void done(const Unit&) const {}
};
struct LocalWindow : LocalOrder {
    int lo, hi;
    __host__ __device__ bool next(int i, Unit& u) const { return (i + lo < hi) && LocalOrder::next(i + lo, u); }
};

__device__ __forceinline__ unsigned cvt_pk_bf16(float lo, float hi) { unsigned r; asm volatile("v_cvt_pk_bf16_f32 %0, %1, %2" : "=v"(r) : "v"(lo), "v"(hi)); return r; }
__device__ __forceinline__ float bflo(unsigned w) { return __uint_as_float(w << 16); }
__device__ __forceinline__ float bfhi(unsigned w) { return __uint_as_float(w & 0xffff0000u); }
__device__ __forceinline__ float sigmoidf_fast(float x) { return __builtin_amdgcn_rcpf(1.0f + __expf(-x)); }
__device__ __forceinline__ u32x4 pack8(const f32x4 v0, const f32x4 v1) { u32x4 w; w.x = cvt_pk_bf16(v0[0], v0[1]); w.y = cvt_pk_bf16(v0[2], v0[3]); w.z = cvt_pk_bf16(v1[0], v1[1]); w.w = cvt_pk_bf16(v1[2], v1[3]); return w; }

struct EpiBf16Plain {
    static constexpr bool PERM = true, AFTER_DRAIN = false, I8 = false; typedef f32x4 acc_t;
    bf16_t* O; int ldc;
    __device__ __forceinline__ void operator()(const f32x4 (&acc)[2][2][4][2], const Unit& u, int wr, int wc, int fr, int fq) const {
        const int row0 = u.pm * BM + wr * 64 + fr, col0 = u.pn * BM + wc * 32 + 8 * fq;
#pragma unroll
        for (int ai = 0; ai < 2; ++ai)
#pragma unroll
            for (int m = 0; m < 4; ++m) { bf16_t* rowp = O + (size_t)(row0 + ai * HALF + m * 16) * ldc + col0;
#pragma unroll
                for (int bj = 0; bj < 2; ++bj) *(u32x4*)(rowp + bj * HALF) = pack8(acc[ai][bj][m][0], acc[ai][bj][m][1]); }
    }
};
struct EpiBf16Plain8 {
    static constexpr bool PERM = true, AFTER_DRAIN = false, I8 = true; typedef i32x4 acc_t;
    bf16_t* O; int ldc; const float *xs, *wsc;
    __device__ __forceinline__ void operator()(const i32x4 (&acc)[2][2][4][2], const Unit& u, int wr, int wc, int fr, int fq) const {
        const int row0 = u.pm * BM + wr * 64 + fr, col0 = u.pn * BM + wc * 32 + 8 * fq;
#pragma unroll
        for (int ai = 0; ai < 2; ++ai)
#pragma unroll
            for (int m = 0; m < 4; ++m) { bf16_t* rowp = O + (size_t)(row0 + ai * HALF + m * 16) * ldc + col0; const float rs = xs[row0 + ai * HALF + m * 16];
#pragma unroll
                for (int bj = 0; bj < 2; ++bj) { const f32x4 c0 = *(const f32x4*)(wsc + col0 + bj * HALF), c1 = *(const f32x4*)(wsc + col0 + bj * HALF + 4); f32x4 v0, v1;
#pragma unroll
                    for (int i = 0; i < 4; ++i) { v0[i] = (float)acc[ai][bj][m][0][i] * (rs * c0[i]); v1[i] = (float)acc[ai][bj][m][1][i] * (rs * c1[i]); }
                    *(u32x4*)(rowp + bj * HALF) = pack8(v0, v1); } }
    }
};
struct EpiIn {
    static constexpr bool PERM = true, AFTER_DRAIN = false, I8 = false; typedef f32x4 acc_t;
    bf16_t *Q, *KB, *VT, *U, *GA, *GS;
    __device__ __forceinline__ void operator()(const f32x4 (&acc)[2][2][4][2], const Unit& u, int wr, int wc, int fr, int fq) const {
        const int row0 = u.pm * BM + wr * 64 + fr, colw = wc * 32 + 8 * fq; const int pn = u.pn;
        if (pn >= 10 && pn < 12) {
#pragma unroll
            for (int ai = 0; ai < 2; ++ai)
#pragma unroll
                for (int m = 0; m < 4; ++m) { const int row = row0 + ai * HALF + m * 16; const int b = row >> 11, s = row & 2047;
#pragma unroll
                    for (int bj = 0; bj < 2; ++bj) { const int vcol = (pn - 10) * 256 + bj * HALF + colw;
                        bf16_t* base = VT + ((size_t)((b * 4 + (vcol >> 7)) * 128 + (vcol & 127))) * 2048 + s;
#pragma unroll
                        for (int n = 0; n < 2; ++n)
#pragma unroll
                            for (int i = 0; i < 4; ++i) { const unsigned w = cvt_pk_bf16(acc[ai][bj][m][n][i], 0.f); base[(size_t)(4 * n + i) * 2048] = (bf16_t)(w & 0xffffu); } } }
            return;
        }
        bf16_t* O; int ldc, colt; int mode;
        if (pn < 8) { O = Q; ldc = 2048; colt = pn * 256; mode = 1; }
        else if (pn < 10) { O = KB; ldc = 512; colt = (pn - 8) * 256; mode = 0; }
        else if (pn < 16) { O = U; ldc = 1024; colt = (pn - 12) * 256; mode = 0; }
        else if (pn < 32) { O = GA; ldc = 4096; colt = (pn - 16) * 256; mode = 2; }
        else { O = GS; ldc = 4096; colt = (pn - 32) * 256; mode = 2; }
        const float sc = (mode == 1) ? 0.08838834764831845f : 1.0f;
#pragma unroll
        for (int ai = 0; ai < 2; ++ai)
#pragma unroll
            for (int m = 0; m < 4; ++m) { bf16_t* rowp = O + (size_t)(row0 + ai * HALF + m * 16) * ldc + colt + colw;
#pragma unroll
                for (int bj = 0; bj < 2; ++bj) { f32x4 v0 = acc[ai][bj][m][0], v1 = acc[ai][bj][m][1];
                    if (mode == 2) {
#pragma unroll
                        for (int i = 0; i < 4; ++i) { v0[i] = sigmoidf_fast(v0[i]); v1[i] = sigmoidf_fast(v1[i]); } }
                    else { v0 = v0 * sc; v1 = v1 * sc; }
                    *(u32x4*)(rowp + bj * HALF) = pack8(v0, v1); } }
    }
};
struct EpiIn8 {
    static constexpr bool PERM = true, AFTER_DRAIN = false, I8 = true; typedef i32x4 acc_t;
    bf16_t *Q, *KB, *VT, *U, *GA, *GS; const float *xs, *wsc;
    __device__ __forceinline__ void operator()(const i32x4 (&acc)[2][2][4][2], const Unit& u, int wr, int wc, int fr, int fq) const {
        const int row0 = u.pm * BM + wr * 64 + fr, colw = wc * 32 + 8 * fq; const int pn = u.pn;
        if (pn >= 10 && pn < 12) {
#pragma unroll
            for (int ai = 0; ai < 2; ++ai)
#pragma unroll
                for (int m = 0; m < 4; ++m) { const int row = row0 + ai * HALF + m * 16; const int b = row >> 11, s = row & 2047;
#pragma unroll
                    for (int bj = 0; bj < 2; ++bj) { const int vcol = (pn - 10) * 256 + bj * HALF + colw;
                        const float rs = xs[row]; const f32x4 c0 = *(const f32x4*)(wsc + pn * 256 + bj * HALF + colw), c1 = *(const f32x4*)(wsc + pn * 256 + bj * HALF + colw + 4);
                        bf16_t* base = VT + ((size_t)((b * 4 + (vcol >> 7)) * 128 + (vcol & 127))) * 2048 + s;
#pragma unroll
                        for (int n = 0; n < 2; ++n)
#pragma unroll
                            for (int i = 0; i < 4; ++i) { const unsigned w = cvt_pk_bf16((float)acc[ai][bj][m][n][i] * rs * (n ? c1[i] : c0[i]), 0.f); base[(size_t)(4 * n + i) * 2048] = (bf16_t)(w & 0xffffu); } } }
            return;
        }
        bf16_t* O; int ldc, colt; int mode;
        if (pn < 8) { O = Q; ldc = 2048; colt = pn * 256; mode = 1; }
        else if (pn < 10) { O = KB; ldc = 512; colt = (pn - 8) * 256; mode = 0; }
        else if (pn < 16) { O = U; ldc = 1024; colt = (pn - 12) * 256; mode = 0; }
        else if (pn < 32) { O = GA; ldc = 4096; colt = (pn - 16) * 256; mode = 2; }
        else { O = GS; ldc = 4096; colt = (pn - 32) * 256; mode = 2; }
        const float sc = (mode == 1) ? 0.08838834764831845f : 1.0f;
#pragma unroll
        for (int ai = 0; ai < 2; ++ai)
#pragma unroll
            for (int m = 0; m < 4; ++m) { bf16_t* rowp = O + (size_t)(row0 + ai * HALF + m * 16) * ldc + colt + colw; const float rs = xs[row0 + ai * HALF + m * 16];
#pragma unroll
                for (int bj = 0; bj < 2; ++bj) { const f32x4 c0 = *(const f32x4*)(wsc + pn * 256 + bj * HALF + colw), c1 = *(const f32x4*)(wsc + pn * 256 + bj * HALF + colw + 4);
                    f32x4 v0, v1;
#pragma unroll
                    for (int i = 0; i < 4; ++i) { v0[i] = (float)acc[ai][bj][m][0][i] * (rs * c0[i]); v1[i] = (float)acc[ai][bj][m][1][i] * (rs * c1[i]); }
                    if (mode == 2) {
                        unsigned w0 = 0, w1 = 0;
#pragma unroll
                        for (int i = 0; i < 4; ++i) { w0 |= (unsigned)(int)rintf(255.0f * sigmoidf_fast(v0[i])) << (8 * i); w1 |= (unsigned)(int)rintf(255.0f * sigmoidf_fast(v1[i])) << (8 * i); }
                        typedef unsigned u32x2_t __attribute__((ext_vector_type(2))); u32x2_t w; w.x = w0; w.y = w1;
                        *(u32x2_t*)((unsigned char*)O + (size_t)(row0 + ai * HALF + m * 16) * ldc + colt + colw + bj * HALF) = w; }
                    else { v0 = v0 * sc; v1 = v1 * sc; *(u32x4*)(rowp + bj * HALF) = pack8(v0, v1); } } }
    }
};
struct EpiGlu {
    static constexpr bool PERM = true, AFTER_DRAIN = false, I8 = false; typedef f32x4 acc_t;
    bf16_t* O; int ldc;
    __device__ __forceinline__ void operator()(const f32x4 (&acc)[2][2][4][2], const Unit& u, int wr, int wc, int fr, int fq) const {
        const int row0 = u.pm * BM + wr * 64 + fr, col0 = u.pn * HALF + wc * 32 + 8 * fq;
#pragma unroll
        for (int ai = 0; ai < 2; ++ai)
#pragma unroll
            for (int m = 0; m < 4; ++m) { f32x4 v0 = acc[ai][0][m][0], v1 = acc[ai][0][m][1]; const f32x4 g0 = acc[ai][1][m][0], g1 = acc[ai][1][m][1];
#pragma unroll
                for (int i = 0; i < 4; ++i) { v0[i] *= sigmoidf_fast(g0[i]); v1[i] *= sigmoidf_fast(g1[i]); }
                *(u32x4*)(O + (size_t)(row0 + ai * HALF + m * 16) * ldc + col0) = pack8(v0, v1); }
    }
};
template <bool ADD> struct EpiGate {
    static constexpr bool PERM = true, AFTER_DRAIN = false, I8 = false; typedef f32x4 acc_t;
    bf16_t* O; const bf16_t* G; int ldc;
    __device__ __forceinline__ void operator()(const f32x4 (&acc)[2][2][4][2], const Unit& u, int wr, int wc, int fr, int fq) const {
        const int row0 = u.pm * BM + wr * 64 + fr, col0 = u.pn * BM + wc * 32 + 8 * fq;
#pragma unroll
        for (int ai = 0; ai < 2; ++ai)
#pragma unroll
            for (int m = 0; m < 4; ++m) { const size_t off = (size_t)(row0 + ai * HALF + m * 16) * ldc + col0;
#pragma unroll
                for (int bj = 0; bj < 2; ++bj) { const u32x4 g = *(const u32x4*)(G + off + bj * HALF); f32x4 v0 = acc[ai][bj][m][0], v1 = acc[ai][bj][m][1];
                    v0[0] *= bflo(g.x); v0[1] *= bfhi(g.x); v0[2] *= bflo(g.y); v0[3] *= bfhi(g.y); v1[0] *= bflo(g.z); v1[1] *= bfhi(g.z); v1[2] *= bflo(g.w); v1[3] *= bfhi(g.w);
                    if (ADD) { const u32x4 o = *(const u32x4*)(O + off + bj * HALF);
                        v0[0] += bflo(o.x); v0[1] += bfhi(o.x); v0[2] += bflo(o.y); v0[3] += bfhi(o.y); v1[0] += bflo(o.z); v1[1] += bfhi(o.z); v1[2] += bflo(o.w); v1[3] += bfhi(o.w); }
                    *(u32x4*)(O + off + bj * HALF) = pack8(v0, v1); }
                asm volatile("" ::: "memory"); }
    }
};
template <bool ADD> struct EpiGate8 {
    static constexpr bool PERM = true, AFTER_DRAIN = false, I8 = true; typedef i32x4 acc_t;
    bf16_t* O; const bf16_t* G; int ldc; const float *xs, *wsc;
    __device__ __forceinline__ void operator()(const i32x4 (&acc)[2][2][4][2], const Unit& u, int wr, int wc, int fr, int fq) const {
        const int row0 = u.pm * BM + wr * 64 + fr, col0 = u.pn * BM + wc * 32 + 8 * fq;
        f32x4 cs[2][2];
#pragma unroll
        for (int bj = 0; bj < 2; ++bj) { cs[bj][0] = *(const f32x4*)(wsc + col0 + bj * HALF); cs[bj][1] = *(const f32x4*)(wsc + col0 + bj * HALF + 4); }
        typedef unsigned u32x2_t __attribute__((ext_vector_type(2))); const unsigned char* G8 = (const unsigned char*)G;
        u32x2_t gcur[2], gnxt[2]; u32x4 ocur[2], onxt[2]; float rcur, rnxt;
        { const size_t off = (size_t)row0 * ldc + col0; gcur[0] = *(const u32x2_t*)(G8 + off); gcur[1] = *(const u32x2_t*)(G8 + off + HALF); if (ADD) { ocur[0] = *(const u32x4*)(O + off); ocur[1] = *(const u32x4*)(O + off + HALF); } rcur = xs[row0]; }
#pragma unroll
        for (int it = 0; it < 8; ++it) { const int ai = it >> 2, m = it & 3; const size_t off = (size_t)(row0 + ai * HALF + m * 16) * ldc + col0;
            if (it + 1 < 8) { const int ai2 = (it + 1) >> 2, m2 = (it + 1) & 3; const int r2 = row0 + ai2 * HALF + m2 * 16; const size_t off2 = (size_t)r2 * ldc + col0;
                gnxt[0] = *(const u32x2_t*)(G8 + off2); gnxt[1] = *(const u32x2_t*)(G8 + off2 + HALF); if (ADD) { onxt[0] = *(const u32x4*)(O + off2); onxt[1] = *(const u32x4*)(O + off2 + HALF); } rnxt = xs[r2]; }
            asm volatile("" ::: "memory");
#pragma unroll
            for (int bj = 0; bj < 2; ++bj) { const u32x2_t g = gcur[bj]; f32x4 v0, v1; constexpr float k255 = 1.0f / 255.0f;
#pragma unroll
                for (int i = 0; i < 4; ++i) { v0[i] = (float)acc[ai][bj][m][0][i] * (rcur * cs[bj][0][i]); v1[i] = (float)acc[ai][bj][m][1][i] * (rcur * cs[bj][1][i]); }
#pragma unroll
                for (int i = 0; i < 4; ++i) { v0[i] *= (float)((g.x >> (8 * i)) & 0xffu) * k255; v1[i] *= (float)((g.y >> (8 * i)) & 0xffu) * k255; }
                if (ADD) { const u32x4 o = ocur[bj];
                    v0[0] += bflo(o.x); v0[1] += bfhi(o.x); v0[2] += bflo(o.y); v0[3] += bfhi(o.y); v1[0] += bflo(o.z); v1[1] += bfhi(o.z); v1[2] += bflo(o.w); v1[3] += bfhi(o.w); }
                *(u32x4*)(O + off + bj * HALF) = pack8(v0, v1); }
            asm volatile("" ::: "memory");
            if (it + 1 < 8) { gcur[0] = gnxt[0]; gcur[1] = gnxt[1]; if (ADD) { ocur[0] = onxt[0]; ocur[1] = onxt[1]; } rcur = rnxt; }
        }
    }
};
struct EpiRes8 {
    static constexpr bool PERM = true, AFTER_DRAIN = false, I8 = true; typedef i32x4 acc_t;
    const float* base32; const bf16_t* base16; bf16_t* out; int ldc; const float *xs, *wsc;
    __device__ __forceinline__ void operator()(const i32x4 (&acc)[2][2][4][2], const Unit& u, int wr, int wc, int fr, int fq) const {
        const int row0 = u.pm * BM + wr * 64 + fr, col0 = u.pn * BM + wc * 32 + 8 * fq;
        f32x4 cs[2][2];
#pragma unroll
        for (int bj = 0; bj < 2; ++bj) { cs[bj][0] = *(const f32x4*)(wsc + col0 + bj * HALF); cs[bj][1] = *(const f32x4*)(wsc + col0 + bj * HALF + 4); }
#pragma unroll
        for (int ai = 0; ai < 2; ++ai)
#pragma unroll
            for (int m = 0; m < 4; ++m) { const size_t off = (size_t)(row0 + ai * HALF + m * 16) * ldc + col0; const float rs = xs[row0 + ai * HALF + m * 16];
#pragma unroll
                for (int bj = 0; bj < 2; ++bj) { f32x4 b0, b1;
                    if (base32) { b0 = *(const f32x4*)(base32 + off + bj * HALF); b1 = *(const f32x4*)(base32 + off + bj * HALF + 4); }
                    else { const u32x4 t = *(const u32x4*)(base16 + off + bj * HALF); b0 = (f32x4){bflo(t.x), bfhi(t.x), bflo(t.y), bfhi(t.y)}; b1 = (f32x4){bflo(t.z), bfhi(t.z), bflo(t.w), bfhi(t.w)}; }
                    f32x4 v0, v1;
#pragma unroll
                    for (int i = 0; i < 4; ++i) { v0[i] = b0[i] + (float)acc[ai][bj][m][0][i] * (rs * cs[bj][0][i]); v1[i] = b1[i] + (float)acc[ai][bj][m][1][i] * (rs * cs[bj][1][i]); }
                    *(u32x4*)(out + off + bj * HALF) = pack8(v0, v1); } }
    }
};
struct EpiRes {
    static constexpr bool PERM = false, AFTER_DRAIN = false, I8 = false; typedef f32x4 acc_t;
    const float* base; float* out; int ldc;
    __device__ __forceinline__ void operator()(const f32x4 (&acc)[2][2][4][2], const Unit& u, int wr, int wc, int fr, int fq) const {
        const int row0 = u.pm * BM + wr * 64 + fr, col0 = u.pn * BM + wc * 32 + 4 * fq;
#pragma unroll
        for (int ai = 0; ai < 2; ++ai)
#pragma unroll
            for (int m = 0; m < 4; ++m) { const size_t off = (size_t)(row0 + ai * HALF + m * 16) * ldc + col0;
#pragma unroll
                for (int bj = 0; bj < 2; ++bj)
#pragma unroll
                    for (int n = 0; n < 2; ++n) { const f32x4 bs = *(const f32x4*)(base + off + bj * HALF + n * 16); *(f32x4*)(out + off + bj * HALF + n * 16) = bs + acc[ai][bj][m][n]; } }
    }
};

__device__ __forceinline__ f32x4 mma16(const bf16x8& b, const bf16x8& a, const f32x4& c) { return __builtin_amdgcn_mfma_f32_16x16x32_bf16(b, a, c, 0, 0, 0); }
__device__ __forceinline__ i32x4 mma16(const bf16x8& b, const bf16x8& a, const i32x4& c) { return __builtin_amdgcn_mfma_i32_16x16x64_i8(__builtin_bit_cast(i32x4, b), __builtin_bit_cast(i32x4, a), c, 0, 0, 0); }
template <class Epi, class Sched, bool ALIGN_EPI = false, bool SP2 = false>
__device__ __forceinline__ void gemm_phase(PG8_LAS unsigned char* lds, const Gemm g, const Sched& S, const Epi& E) {
    int tid = threadIdx.x; asm volatile("" : "+v"(tid));
    const int wid = __builtin_amdgcn_readfirstlane(tid >> 6), lane = tid & 63, wr = wid >> 2, wc = wid & 3, fr = lane & 15, fq = lane >> 4;
    const int K = g.K, nt = K / BK;
    unsigned voffA[2], voffB[2];
#pragma unroll
    for (int i = 0; i < 2; ++i) { int R, C; stage_rc(tid * 16 + i * 8192, R, C); const int Rb = Epi::PERM ? ((R & ~31) + perm32(R & 31)) : R;
        voffA[i] = (unsigned)(R * K + C) * 2u; voffB[i] = (unsigned)(Rb * K + C) * 2u; }
    const size_t kstep = (size_t)(BK * 2);
    const size_t hstep = (size_t)HALF * K * 2;
    const size_t tstep = 2 * hstep;
    const unsigned ldsw = (unsigned)wid * 1024u;
    const int aoff = lds_byte(wr * 64 + fr, fq * 8), boff = lds_byte(wc * 32 + fr, fq * 8);
#define PG8_SA(b, h) (((b) * 2 + (h)) * HTB)
#define PG8_SB(b, h) ((4 + (b) * 2 + (h)) * HTB)
#define PG8_STAGE(bufoff, gbase, voff) do { _Pragma("unroll") for (int _i = 0; _i < 2; ++_i) \
        __builtin_amdgcn_global_load_lds((const unsigned*)((const char*)(gbase) + (voff)[_i]), (PG8_LAS unsigned*)(lds + (bufoff) + ldsw + _i * 8192), 16, 0, 0); } while (0)
#define PG8_LDA(dst, b, h) do { _Pragma("unroll") for (int m = 0; m < 4; ++m) _Pragma("unroll") for (int k = 0; k < 2; ++k) dst[m][k] = *(const PG8_LAS bf16x8*)(lds + PG8_SA(b, h) + aoff + m * 2048 + k * 1024); } while (0)
#define PG8_LDB(dst, b, h) do { _Pragma("unroll") for (int n = 0; n < 2; ++n) _Pragma("unroll") for (int k = 0; k < 2; ++k) dst[n][k] = *(const PG8_LAS bf16x8*)(lds + PG8_SB(b, h) + boff + n * 2048 + k * 1024); } while (0)
#define PG8_MMA(ai, bj, At, Bt) do { __builtin_amdgcn_s_setprio(1); _Pragma("unroll") for (int m = 0; m < 4; ++m) _Pragma("unroll") for (int n = 0; n < 2; ++n) _Pragma("unroll") for (int k = 0; k < 2; ++k) \
        acc[ai][bj][m][n] = mma16(Bt[n][k], At[m][k], acc[ai][bj][m][n]); __builtin_amdgcn_s_setprio(0); } while (0)
#define PG8_WAIT_V(n) asm volatile("s_waitcnt vmcnt(" #n ")" ::: "memory")
#define PG8_WAIT_L(n) asm volatile("s_waitcnt lgkmcnt(" #n ")" ::: "memory")
#define PG8_BAR __builtin_amdgcn_s_barrier()
#define PG8_SCHED __builtin_amdgcn_sched_barrier(0)
    Unit cur, nxt; int ui = 0;
    if (!S.next(0, cur)) return;
    typedef typename Epi::acc_t acc_t; acc_t acc[2][2][4][2];
#pragma unroll
    for (int a = 0; a < 2; ++a)
#pragma unroll
        for (int b = 0; b < 2; ++b)
#pragma unroll
            for (int m = 0; m < 4; ++m)
#pragma unroll
                for (int n = 0; n < 2; ++n) acc[a][b][m][n] = acc_t{};
    bf16x8 At[4][2], B0[2][2], B1[2][2];
    const char* cA = (const char*)g.A + (size_t)cur.pm * tstep; const char* cB = (const char*)g.Bt + (size_t)cur.pn * tstep;
    S.a_ready(cur);
    if constexpr (SP2) {
        PG8_STAGE(PG8_SB(0, 0), cB, voffB); PG8_STAGE(PG8_SB(0, 1), cB + hstep, voffB); PG8_STAGE(PG8_SA(0, 0), cA, voffA); PG8_STAGE(PG8_SA(0, 1), cA + hstep, voffA);
        if (wr == 1) PG8_BAR;
        PG8_WAIT_V(2); PG8_BAR;
        PG8_STAGE(PG8_SB(1, 0), cB + kstep, voffB); PG8_STAGE(PG8_SA(1, 0), cA + kstep, voffA); PG8_STAGE(PG8_SB(1, 1), cB + hstep + kstep, voffB);
        PG8_WAIT_V(6); PG8_BAR;
    } else {
        PG8_STAGE(PG8_SB(0, 0), cB, voffB); PG8_STAGE(PG8_SA(0, 0), cA, voffA); PG8_STAGE(PG8_SB(0, 1), cB + hstep, voffB); PG8_STAGE(PG8_SA(0, 1), cA + hstep, voffA);
        if (wr == 1) PG8_BAR;
        PG8_WAIT_V(4); PG8_BAR;
        PG8_STAGE(PG8_SB(1, 0), cB + kstep, voffB); PG8_STAGE(PG8_SA(1, 0), cA + kstep, voffA); PG8_STAGE(PG8_SB(1, 1), cB + hstep + kstep, voffB);
        PG8_WAIT_V(6); PG8_BAR;
    }
    for (;;) {
        const bool has_next = S.next(ui + 1, nxt);
        const char* nA = has_next ? (const char*)g.A + (size_t)nxt.pm * tstep : cA; const char* nB = has_next ? (const char*)g.Bt + (size_t)nxt.pn * tstep : cB;
        for (int t = 0; t < nt; t += 2) {
            const bool last = (t == nt - 2);
            const char* a1 = cA + (size_t)(t + 1) * kstep;
            const char* a2 = last ? nA : cA + (size_t)(t + 2) * kstep; const char* b2 = last ? nB : cB + (size_t)(t + 2) * kstep;
            const char* a3 = a2 + kstep; const char* b3 = b2 + kstep;
            if (last && has_next) S.a_ready(nxt);
            if constexpr (SP2) {
            PG8_LDB(B0, 0, 0); PG8_LDB(B1, 0, 1); PG8_SCHED; PG8_LDA(At, 0, 0); PG8_STAGE(PG8_SA(1, 1), a1 + hstep, voffA);
            PG8_WAIT_V(8); PG8_WAIT_L(0); PG8_BAR; PG8_MMA(0, 0, At, B0); PG8_MMA(0, 1, At, B1); PG8_BAR; PG8_SCHED;
            PG8_LDA(At, 0, 1); PG8_STAGE(PG8_SB(0, 0), b2, voffB); PG8_STAGE(PG8_SB(0, 1), b2 + hstep, voffB); PG8_STAGE(PG8_SA(0, 0), a2, voffA);
            PG8_WAIT_V(8); PG8_WAIT_L(0); PG8_BAR; PG8_MMA(1, 0, At, B0); PG8_MMA(1, 1, At, B1); PG8_BAR; PG8_SCHED;
            PG8_LDB(B0, 1, 0); PG8_LDB(B1, 1, 1); PG8_SCHED; PG8_LDA(At, 1, 0); PG8_STAGE(PG8_SA(0, 1), a2 + hstep, voffA);
            PG8_WAIT_V(8); PG8_WAIT_L(0); PG8_BAR; PG8_MMA(0, 0, At, B0); PG8_MMA(0, 1, At, B1); PG8_BAR; PG8_SCHED;
            PG8_LDA(At, 1, 1); PG8_STAGE(PG8_SB(1, 0), b3, voffB); PG8_STAGE(PG8_SB(1, 1), b3 + hstep, voffB); PG8_STAGE(PG8_SA(1, 0), a3, voffA);
            PG8_WAIT_V(8); PG8_WAIT_L(0); PG8_BAR; PG8_MMA(1, 0, At, B0); PG8_MMA(1, 1, At, B1); PG8_BAR; PG8_SCHED;
            } else {
            PG8_LDB(B0, 0, 0); PG8_SCHED; PG8_LDA(At, 0, 0); PG8_STAGE(PG8_SA(1, 1), a1 + hstep, voffA);
            PG8_WAIT_L(8); PG8_BAR; PG8_WAIT_L(0); PG8_MMA(0, 0, At, B0); PG8_BAR; PG8_SCHED;
            PG8_LDB(B1, 0, 1); PG8_STAGE(PG8_SB(0, 0), b2, voffB);
            PG8_BAR; PG8_WAIT_L(0); PG8_MMA(0, 1, At, B1); PG8_BAR;
            PG8_LDA(At, 0, 1); PG8_STAGE(PG8_SA(0, 0), a2, voffA);
            PG8_BAR; PG8_WAIT_L(0); PG8_MMA(1, 0, At, B0); PG8_BAR; PG8_SCHED;
            PG8_STAGE(PG8_SB(0, 1), b2 + hstep, voffB);
            PG8_WAIT_V(6); PG8_BAR; PG8_MMA(1, 1, At, B1); PG8_BAR;
            PG8_LDB(B0, 1, 0); PG8_SCHED; PG8_LDA(At, 1, 0); PG8_STAGE(PG8_SA(0, 1), a2 + hstep, voffA);
            PG8_WAIT_L(8); PG8_BAR; PG8_WAIT_L(0); PG8_MMA(0, 0, At, B0); PG8_BAR; PG8_SCHED;
            PG8_LDB(B1, 1, 1); PG8_STAGE(PG8_SB(1, 0), b3, voffB);
            PG8_BAR; PG8_WAIT_L(0); PG8_MMA(0, 1, At, B1); PG8_BAR;
            PG8_LDA(At, 1, 1); PG8_STAGE(PG8_SA(1, 0), a3, voffA);
            PG8_BAR; PG8_WAIT_L(0); PG8_MMA(1, 0, At, B0); PG8_BAR; PG8_SCHED;
            PG8_STAGE(PG8_SB(1, 1), b3 + hstep, voffB);
            PG8_WAIT_V(6); PG8_BAR; PG8_MMA(1, 1, At, B1); PG8_BAR;
            }
        }
        if constexpr (ALIGN_EPI) { if (wr == 0) PG8_BAR; }
        if constexpr (!Epi::AFTER_DRAIN) { E(acc, cur, wr, wc, fr, fq); S.done(cur); }
        if (!has_next) break;
#pragma unroll
        for (int a = 0; a < 2; ++a)
#pragma unroll
            for (int b = 0; b < 2; ++b)
#pragma unroll
                for (int m = 0; m < 4; ++m)
#pragma unroll
                    for (int n = 0; n < 2; ++n) acc[a][b][m][n] = acc_t{};
        cur = nxt; cA = nA; cB = nB; ++ui;
        if constexpr (ALIGN_EPI) { if (wr == 1) PG8_BAR; }
    }
    PG8_WAIT_V(0);
    if constexpr (!ALIGN_EPI) { if (wr == 0) PG8_BAR; }
    PG8_BAR;
    if constexpr (Epi::AFTER_DRAIN) { E.fused(acc, cur, wr, wc, fr, fq, lds, wid, lane); S.done(cur); }
#undef PG8_SA
#undef PG8_SB
#undef PG8_STAGE
#undef PG8_LDA
#undef PG8_LDB
#undef PG8_MMA
#undef PG8_WAIT_V
#undef PG8_WAIT_L
#undef PG8_BAR
#undef PG8_SCHED
}
}

constexpr int NWAVES = 8;
constexpr int DM = 4096, BATCH = 8, SEQ = 2048, DEPTH = 2, M = BATCH * SEQ;
constexpr int HD = 128, NQH = 16, NKVH = 4, ATTW = 2048, KVW = 512, SSMW = 1024, SSMG = 64, INCOLS = 12288;
constexpr int PH = 8, PDK = 256, NKEYS = 128, NEXP = 16384, PTOPK = 16, PSEL = PH * PTOPK;
constexpr float NORM_EPS = 1e-6f;
#ifndef MK_ONE_LAUNCH
#define MK_ONE_LAUNCH 1
#endif
constexpr int NPH_LAYER = 13, NPH_PRO = 2, NPHASES = NPH_PRO + DEPTH * NPH_LAYER;

constexpr size_t MiB = 1u << 20;
constexpr size_t WS_CTL = 0, CTL_ZERO_BYTES = 1 * MiB;
constexpr size_t LW_WIN = 0, LW_WAB = 96 * MiB, LW_WSB = 112 * MiB, LW_WOUT = 120 * MiB, LW_WGLU = 152 * MiB, LW_WPQ = 156 * MiB, LW_UTAB = 172 * MiB, LW_VTAB = 300 * MiB,
                 LW_KEYS = 428 * MiB, LW_S5K = 429 * MiB, LW_S5ME = 431 * MiB, LW_S5MC = 447 * MiB, LW_S5LAM = 463 * MiB, LW_SIZE = 464 * MiB;
constexpr size_t LW_WINS = LW_WIN + 48 * MiB, LW_WABS = LW_WAB + 8 * MiB, LW_WSBS = LW_WSB + 4 * MiB, LW_WOUTS = LW_WOUT + 16 * MiB, LW_WPQS = LW_WPQ + 8 * MiB;
constexpr size_t LW_SU = LW_UTAB + 64 * MiB, LW_SV = LW_VTAB + 64 * MiB, LW_VT4 = LW_VTAB + 72 * MiB, LW_S4 = LW_VTAB + 112 * MiB;
constexpr size_t WS_LW = 1 * MiB;
constexpr size_t WS_ACT = WS_LW + DEPTH * LW_SIZE;
constexpr size_t WS_XN = WS_ACT, WS_Q = WS_XN + 128 * MiB, WS_KB = WS_Q + 64 * MiB, WS_VT = WS_KB + 16 * MiB, WS_U = WS_VT + 16 * MiB, WS_GA = WS_U + 32 * MiB, WS_GS = WS_GA + 128 * MiB,
                 WS_ATT = WS_GS + 128 * MiB, WS_Z = WS_ATT + 64 * MiB, WS_SS = WS_Z + 32 * MiB, WS_MG = WS_SS + 32 * MiB, WS_PQ = WS_MG + 128 * MiB, WS_EID = WS_PQ + 64 * MiB,
                 WS_GATE = WS_EID + 8 * MiB, WS_HN = WS_GATE + 8 * MiB, WS_HN8 = WS_HN + 128 * MiB, WS_HS = WS_HN8 + 64 * MiB, WS_PAIRS = WS_HS + 1 * MiB, WS_SC = WS_PAIRS + 8 * MiB, WS_END = WS_SC + 8 * MiB;
static_assert(WS_END <= 2048 * MiB, "d_ws map exceeds the guaranteed 2 GiB");
constexpr int CW_TMO = 0, CW_CODE = 1, CW_BAR = 4096, CW_XRANK = 8192, CW_LBAR = 90112  , CW_CONV = 94208  , CW_COLMAX = 16384;
constexpr int CW_COLMAX2 = CW_COLMAX + DEPTH * INCOLS, CW_COLMAX3 = CW_COLMAX2 + DEPTH * 3 * DM;
static_assert((CW_COLMAX3 + DEPTH * 2048) * 4 <= (int)CTL_ZERO_BYTES, "CTL words inside the memset region");

constexpr int SCR_BYTES = 139264;
constexpr int LDSCTL_OFF = SCR_BYTES, MISC_OFF = LDSCTL_OFF + 320, LDS_BYTES = SCR_BYTES + 1024;
static_assert(MISC_OFF + 128 <= LDS_BYTES, "LDS map");
#define GAS __attribute__((address_space(1)))
#define LAS __attribute__((address_space(3)))
typedef unsigned short bf16;
typedef unsigned v4u __attribute__((ext_vector_type(4)));
typedef float f32x4 __attribute__((ext_vector_type(4)));
typedef short bf16x8 __attribute__((ext_vector_type(8)));
typedef GAS unsigned gu32;
typedef GAS unsigned long long gu64;
#define RLX_AGENT __ATOMIC_RELAXED, __HIP_MEMORY_SCOPE_AGENT
#define LDS_WAIT() asm volatile("s_waitcnt lgkmcnt(0)" ::: "memory")
#define VM_WAIT() asm volatile("s_waitcnt vmcnt(0)" ::: "memory")
__device__ __forceinline__ unsigned long long rt() { return __builtin_amdgcn_s_memrealtime(); }
__device__ __forceinline__ unsigned f2bf(float f) { unsigned u = __builtin_bit_cast(unsigned, f); return (u + 0x7fffu + ((u >> 16) & 1u)) >> 16; }
__device__ __forceinline__ unsigned pk2(float lo, float hi) { return f2bf(lo) | (f2bf(hi) << 16); }

#define XB_TMO      128
#define XB_XCNT(j)  (256  + 64 * (j))
#define XB_XSUB(j)  (1280 + 64 * (j))
#define XB_XGEN(j)  (2304 + 64 * (j))
#define XB_TOP      3328
#define XB_TOPGEN   3392
#define XCD_BAR_WORDS 3456
#define XB_SPIN_CAP (1u << 18)

__device__ __forceinline__ unsigned xb_ld(unsigned* p)              { return __hip_atomic_load(p, __ATOMIC_RELAXED, __HIP_MEMORY_SCOPE_AGENT); }
__device__ __forceinline__ unsigned xb_add(unsigned* p, unsigned v) { return __hip_atomic_fetch_add(p, v, __ATOMIC_RELAXED, __HIP_MEMORY_SCOPE_AGENT); }
__device__ __forceinline__ unsigned xb_xcc_id() { return (unsigned)__builtin_amdgcn_s_getreg((3 << 11) | 20) & 0xFu; }
#define XB_SPIN(cond, bar) do { unsigned _sp = 0; while (cond) { __builtin_amdgcn_s_sleep(1); \
    if ((++_sp & 255u) == 0u) { if (xb_ld(&(bar)[XB_TMO])) break; if (_sp > XB_SPIN_CAP) { atomicAdd(&(bar)[XB_TMO], 1u); break; } } } } while (0)

struct XcdBarrier {
    unsigned* bar; unsigned x;
    volatile LAS unsigned* st;
};

__device__ __forceinline__ XcdBarrier xcd_barrier_post(unsigned* bar, volatile LAS unsigned* st) {
    XcdBarrier b; b.bar = bar; b.x = xb_xcc_id(); b.st = st;
    if (threadIdx.x == 0) (void)xb_add(&bar[XB_XCNT(b.x)], 1u);
    return b;
}
__device__ __forceinline__ void xcd_barrier_complete(unsigned* bar, unsigned x, unsigned& nloc, unsigned& nx) {
    const unsigned G = gridDim.x * gridDim.y * gridDim.z;
    unsigned sum, cnt, mine, sp = 0u;
    for (;;) {
        sum = 0u; cnt = 0u; mine = 0u;
#pragma unroll
        for (unsigned j = 0; j < 16; ++j) { const unsigned c = xb_ld(&bar[XB_XCNT(j)]); sum += c; cnt += (c > 0u) ? 1u : 0u; mine = (j == x) ? c : mine; }
        if (sum == G) break;
        __builtin_amdgcn_s_sleep(1);
        if ((++sp & 255u) == 0u) { if (xb_ld(&bar[XB_TMO])) break; if (sp > XB_SPIN_CAP) { atomicAdd(&bar[XB_TMO], 1u); break; } }
    }
    nloc = mine > 0u ? mine : 1u; nx = cnt > 0u ? cnt : 1u;
}

__device__ __forceinline__ void xcd_barrier(const XcdBarrier& b) {
    asm volatile("s_waitcnt vmcnt(0)" ::: "memory");
    __syncthreads();
    if (threadIdx.x == 0) {
        unsigned* bar = b.bar; unsigned bx = b.x; asm volatile("" : "+s"(bx));
        __builtin_amdgcn_s_waitcnt(0);
        unsigned nloc = b.st[0], nx = b.st[1];
        if (nloc == 0u) { xcd_barrier_complete(bar, bx, nloc, nx); b.st[0] = nloc; b.st[1] = nx; }
        const unsigned old = xb_add(&bar[XB_XSUB(bx)], 1u);
        const unsigned gen = old / nloc;
        if (old + 1u == (gen + 1u) * nloc) {
            __builtin_amdgcn_fence(__ATOMIC_RELEASE, "agent");
            asm volatile("s_waitcnt vmcnt(0)" ::: "memory");
            const unsigned og = xb_add(&bar[XB_TOP], 1u);
            const unsigned tg = og / nx;
            if (og + 1u == (tg + 1u) * nx) xb_add(&bar[XB_TOPGEN], 1u);
            else XB_SPIN(xb_ld(&bar[XB_TOPGEN]) == tg, bar);
            __builtin_amdgcn_fence(__ATOMIC_ACQUIRE, "agent");
            xb_add(&bar[XB_XGEN(bx)], 1u);
            asm volatile("s_waitcnt vmcnt(0)" ::: "memory");
        } else {
            XB_SPIN(xb_ld(&bar[XB_XGEN(bx)]) == gen, bar);
            __builtin_amdgcn_fence(__ATOMIC_ACQUIRE, "agent");
            asm volatile("s_waitcnt vmcnt(0)" ::: "memory");
        }
    }
    __syncthreads();
}

typedef float f32x16 __attribute__((ext_vector_type(16)));
typedef float f32x2 __attribute__((ext_vector_type(2)));
typedef unsigned u32x2 __attribute__((ext_vector_type(2)));
typedef __bf16 bf16v2 __attribute__((ext_vector_type(2)));
typedef int i32x4 __attribute__((ext_vector_type(4)));
typedef int i32x2 __attribute__((ext_vector_type(2)));
__device__ __forceinline__ unsigned cvtpk(float lo, float hi) { unsigned r; asm volatile("v_cvt_pk_bf16_f32 %0, %1, %2" : "=v"(r) : "v"(lo), "v"(hi)); return r; }
__device__ __forceinline__ float bflo(unsigned w) { return __uint_as_float(w << 16); }
__device__ __forceinline__ float bfhi(unsigned w) { return __uint_as_float(w & 0xffff0000u); }
__device__ __forceinline__ float gelu_tanh(float x) { const float t = x + 0.044715f * x * x * x; return x * __builtin_amdgcn_rcpf(1.0f + __expf(-1.5957691216057308f * t)); }
__device__ __forceinline__ float dot2bf(unsigned a, unsigned b, float c) { return __builtin_amdgcn_fdot2_f32_bf16(__builtin_bit_cast(bf16v2, a), __builtin_bit_cast(bf16v2, b), c, false); }
__device__ __forceinline__ float wave_sum(float v) {
#pragma unroll
    for (int o = 1; o < 64; o <<= 1) v += __shfl_xor(v, o);
    return v;
}

struct Frame {
    LAS unsigned char* lds;
    volatile LAS unsigned* MISC;
    gu32* ctl;
    int tid, lane, wave, G;
    unsigned xcc, xrank, xi, nx, nloc;
    unsigned char* ws;
};

__device__ __forceinline__ void p0_transpose_item(const float* W, int K, int N, bf16* WT, bool glu, LAS float* scr, int item, int lane) {
    const int nblk = N / 32, kb = item / nblk, nb = item % nblk, k0 = 64 * kb, n0 = 32 * nb;
#pragma unroll 8
    for (int i = 0; i < 32; ++i) { const int kk = 2 * i + (lane >> 5); scr[kk * 33 + (lane & 31)] = W[(size_t)(k0 + kk) * N + n0 + (lane & 31)]; }
    LDS_WAIT(); asm volatile("" ::: "memory");
    const int c = lane & 7;
#pragma unroll
    for (int j = 0; j < 4; ++j) { const int n = (lane >> 3) + 8 * j; const LAS float* s = scr + (8 * c) * 33 + n;
        v4u o; o.x = cvtpk(s[0 * 33], s[1 * 33]); o.y = cvtpk(s[2 * 33], s[3 * 33]); o.z = cvtpk(s[4 * 33], s[5 * 33]); o.w = cvtpk(s[6 * 33], s[7 * 33]);
        int nrow = n0 + n; if (glu) { const int half = nrow >> 10, rem = nrow & 1023; nrow = (rem >> 7) * 256 + half * 128 + (rem & 127); }
        *(GAS v4u*)(WT + (size_t)nrow * K + k0 + 8 * c) = o; }
    LDS_WAIT(); asm volatile("" ::: "memory");
}
__device__ __forceinline__ void rms_row_to_bf16(const float* xrow, const float* g, bf16* orow, int lane) {
    const GAS f32x4* xr = (const GAS f32x4*)xrow + lane;
    f32x4 v[16]; float s = 0.f;
#pragma unroll
    for (int j = 0; j < 16; ++j) { v[j] = xr[64 * j]; s += (v[j].x * v[j].x + v[j].y * v[j].y) + (v[j].z * v[j].z + v[j].w * v[j].w); }
    const float rstd = 1.0f / sqrtf(wave_sum(s) * (1.f / DM) + NORM_EPS);
    const GAS f32x4* gr = (const GAS f32x4*)g + lane;
    GAS u32x2* o8 = (GAS u32x2*)orow + lane;
#pragma unroll
    for (int j = 0; j < 16; ++j) { const f32x4 gg = gr[64 * j]; u32x2 w; w.x = cvtpk(v[j].x * rstd * gg.x, v[j].y * rstd * gg.y); w.y = cvtpk(v[j].z * rstd * gg.z, v[j].w * rstd * gg.w); o8[64 * j] = w; }
}
__device__ __forceinline__ void s5_precompute(Frame& F, const float* a_re, const float* a_im, const float* log_step, const float* b_re, const float* b_im, const float* c_re, const float* c_im,
                                              int g, int half, bf16* KT, bf16* MEf, bf16* MCf, float* LAM) {
    LAS float* LPr = (LAS float*)F.lds; LAS float* LPi = LPr + 65 * 64; LAS float* Bbr = LPi + 65 * 64; LAS float* Bbi = Bbr + 1024; LAS float* Cr = Bbi + 1024; LAS float* Ci = Cr + 1024;
    const int tid = F.tid;
    { const float dt = expf(log_step[g]);
      for (int idx = tid; idx < 65 * 64; idx += 512) { const int t = idx >> 6, p = idx & 63; const float ar = a_re[g * 64 + p], ai = a_im[g * 64 + p];
          const float mag = expf(ar * dt * (float)t); float sn, cs; sincosf(ai * dt * (float)t, &sn, &cs); LPr[idx] = mag * cs; LPi[idx] = mag * sn; } }
    for (int i = tid; i < 1024; i += 512) { Cr[i] = c_re[g * 1024 + i]; Ci[i] = c_im[g * 1024 + i]; }
    __syncthreads();
    for (int i = tid; i < 1024; i += 512) { const int p = i >> 4, h = i & 15; const float ar = a_re[g * 64 + p], ai = a_im[g * 64 + p];
        const float lr = LPr[64 + p], li = LPi[64 + p], den = ar * ar + ai * ai, nr = lr - 1.0f;
        const float zr = (nr * ar + li * ai) / den, zi = (li * ar - nr * ai) / den;
        const float br = b_re[(g * 64 + p) * 16 + h], bi = b_im[(g * 64 + p) * 16 + h]; Bbr[i] = zr * br - zi * bi; Bbi[i] = zr * bi + zi * br; }
    if (half == 0 && tid < 64) { LAM[(g * 64 + tid) * 2] = LPr[64 * 64 + tid]; LAM[(g * 64 + tid) * 2 + 1] = LPi[64 * 64 + tid]; }
    __syncthreads();
    for (int o = half * 8192 + tid; o < half * 8192 + 8192; o += 512) { const int tau = o >> 8, h = (o >> 4) & 15, h2 = o & 15; float s = 0.f;
        for (int p = 0; p < 64; ++p) { const float cr = Cr[h * 64 + p], ci = Ci[h * 64 + p], lr = LPr[tau * 64 + p], li = LPi[tau * 64 + p]; const float wr = cr * lr - ci * li, wi = cr * li + ci * lr; s += wr * Bbr[p * 16 + h2] - wi * Bbi[p * 16 + h2]; }
        KT[(size_t)g * 16384 + o] = (bf16)(cvtpk(s, 0.f) & 0xffffu); }
    if (half == 0) for (int e = tid; e < 131072; e += 512) { const int j = e & 7, ln = (e >> 3) & 63, s = (e >> 9) & 63, mt = e >> 15; const int r = mt * 32 + (ln & 31), h = 8 * (ln >> 5) + j, p = r & 63;
        const float lr = LPr[(63 - s) * 64 + p], li = LPi[(63 - s) * 64 + p], br = Bbr[p * 16 + h], bi = Bbi[p * 16 + h]; const float v = (r < 64) ? (lr * br - li * bi) : (lr * bi + li * br);
        MEf[(size_t)g * 131072 + e] = (bf16)(cvtpk(v, 0.f) & 0xffffu); }
    if (half == 1) for (int e = tid; e < 131072; e += 512) { const int j = e & 7, ln = (e >> 3) & 63, kr = (e >> 9) & 7, mt = e >> 12; const int rr = ln & 31, t = 2 * mt + (rr >> 4), h = rr & 15, r = kr * 16 + 8 * (ln >> 5) + j, p = r & 63;
        const float cr = Cr[h * 64 + p], ci = Ci[h * 64 + p], lr = LPr[(t + 1) * 64 + p], li = LPi[(t + 1) * 64 + p]; const float v = (r < 64) ? (cr * lr - ci * li) : -(cr * li + ci * lr);
        MCf[(size_t)g * 131072 + e] = (bf16)(cvtpk(v, 0.f) & 0xffffu); }
    __syncthreads();
}

constexpr int ATT_KS_STRIDE = 272, ATT_VS_STRIDE = 528, ATT_VS_OFF = 256 * ATT_KS_STRIDE;
static_assert(ATT_VS_OFF + 128 * ATT_VS_STRIDE <= SCR_BYTES, "attention LDS");
__device__ __forceinline__ void attn_unit(Frame& F, int b, int nb, int kvh, const bf16* Q, const bf16* KB, const bf16* VT, bf16* ATT, const float* sinks) {
    int tid = F.tid; asm volatile("" : "+v"(tid)); const int lane = tid & 63, w = __builtin_amdgcn_readfirstlane(tid >> 6), r = lane & 31, hh = lane >> 5;
    LAS unsigned char* Ks = F.lds; LAS unsigned char* Vs = F.lds + ATT_VS_OFF;
    const int t0 = b * SEQ + nb * 128;
#pragma unroll
    for (int i = 0; i < 8; ++i) { const int idx = tid + 512 * i, j = idx >> 4, ch = idx & 15; int tk = t0 - 128 + j; if (nb == 0 && j < 128) tk = t0 + j;
        const v4u v = *(const GAS v4u*)(KB + (size_t)tk * KVW + kvh * 128 + ch * 8); *(LAS v4u*)(Ks + j * ATT_KS_STRIDE + ch * 16) = v; }
#pragma unroll
    for (int i = 0; i < 8; ++i) { const int idx = tid + 512 * i, d = idx >> 5, ch = idx & 31; int j0 = ch * 8; int srcj = nb * 128 - 128 + j0; if (nb == 0 && j0 < 128) srcj = j0;
        const v4u v = *(const GAS v4u*)(VT + ((size_t)((b * 4 + kvh) * 128 + d)) * SEQ + srcj); *(LAS v4u*)(Vs + d * ATT_VS_STRIDE + ch * 16) = v; }
    __syncthreads();
    const int hq = kvh * 4 + (w >> 1), hw = w & 1;
    const float slope = exp2f(-0.5f * (float)(hq + 1)), sink = sinks[hq];
#pragma unroll 1
    for (int qt = 0; qt < 2; ++qt) {
        const int qrow = hw * 64 + qt * 32 + r; const size_t tq = (size_t)(t0 + qrow);
        bf16x8 qf[8];
#pragma unroll
        for (int ks = 0; ks < 8; ++ks) qf[ks] = *(const GAS bf16x8*)(Q + tq * ATTW + hq * 128 + ks * 16 + 8 * hh);
        f32x16 S[6];
#pragma unroll
        for (int k6 = 0; k6 < 6; ++k6) { S[k6] = (f32x16){0.f};
            const int kt = 2 * hw + k6;
#pragma unroll
            for (int ks = 0; ks < 8; ++ks) { const bf16x8 a = *(const LAS bf16x8*)(Ks + (kt * 32 + r) * ATT_KS_STRIDE + ks * 32 + hh * 16); S[k6] = __builtin_amdgcn_mfma_f32_32x32x16_bf16(a, qf[ks], S[k6], 0, 0, 0); }
            asm volatile("" ::: "memory"); }
        float mx = sink;
#pragma unroll
        for (int k6 = 0; k6 < 6; ++k6)
#pragma unroll
            for (int rg = 0; rg < 16; ++rg) { const int j = (2 * hw + k6) * 32 + (rg & 3) + 8 * (rg >> 2) + 4 * hh; const int dist = qrow - j + 128;
                const bool valid = (dist >= 0) && (dist < 128) && (nb > 0 || j >= 128);
                const float lg = valid ? (S[k6][rg] - slope * (float)dist) : -1e30f; S[k6][rg] = lg; mx = fmaxf(mx, lg); }
        mx = fmaxf(mx, __shfl_xor(mx, 32));
        float sum = 0.f;
#pragma unroll
        for (int k6 = 0; k6 < 6; ++k6)
#pragma unroll
            for (int rg = 0; rg < 16; ++rg) { const float p = __expf(S[k6][rg] - mx); S[k6][rg] = p; sum += p; }
        sum += __shfl_xor(sum, 32); sum += __expf(sink - mx);
        const float inv = 1.0f / sum;
        f32x16 O[4];
#pragma unroll
        for (int dt = 0; dt < 4; ++dt) O[dt] = (f32x16){0.f};
#pragma unroll
        for (int k6 = 0; k6 < 6; ++k6)
#pragma unroll
            for (int s2 = 0; s2 < 2; ++s2) { v4u pw; pw.x = cvtpk(S[k6][8 * s2 + 0], S[k6][8 * s2 + 1]); pw.y = cvtpk(S[k6][8 * s2 + 2], S[k6][8 * s2 + 3]); pw.z = cvtpk(S[k6][8 * s2 + 4], S[k6][8 * s2 + 5]); pw.w = cvtpk(S[k6][8 * s2 + 6], S[k6][8 * s2 + 7]);
                const bf16x8 pb = __builtin_bit_cast(bf16x8, pw); const int key0 = (2 * hw + k6) * 32 + 16 * s2 + 4 * hh;
#pragma unroll
                for (int dt = 0; dt < 4; ++dt) { const LAS unsigned char* vp = Vs + (dt * 32 + r) * ATT_VS_STRIDE + key0 * 2; const u32x2 a0 = *(const LAS u32x2*)vp, a1 = *(const LAS u32x2*)(vp + 16);
                    v4u aw; aw.x = a0.x; aw.y = a0.y; aw.z = a1.x; aw.w = a1.y; O[dt] = __builtin_amdgcn_mfma_f32_32x32x16_bf16(__builtin_bit_cast(bf16x8, aw), pb, O[dt], 0, 0, 0); }
                asm volatile("" ::: "memory"); }
        bf16* orow = ATT + tq * ATTW + hq * 128;
#pragma unroll
        for (int dt = 0; dt < 4; ++dt)
#pragma unroll
            for (int g4 = 0; g4 < 4; ++g4) { u32x2 o; o.x = cvtpk(O[dt][4 * g4 + 0] * inv, O[dt][4 * g4 + 1] * inv); o.y = cvtpk(O[dt][4 * g4 + 2] * inv, O[dt][4 * g4 + 3] * inv);
                *(GAS u32x2*)(orow + dt * 32 + 8 * g4 + 4 * hh) = o; }
    }
    __syncthreads();
}

constexpr int S5_US_STRIDE = 2064, S5_ES_OFF = 32 * S5_US_STRIDE, S5_XS_OFF = S5_ES_OFF + 2 * 128 * 33 * 4, S5_XS_STRIDE = 272;
static_assert(S5_XS_OFF + 32 * S5_XS_STRIDE <= SCR_BYTES && 2 * 128 * 33 * 4 >= 32768, "S5 LDS");
__device__ __forceinline__ void s5_unit(Frame& F, int b, int g, const bf16* U, const bf16* KT, const bf16* MEf, const bf16* MCf, const float* LAM, const float* dskip, bf16* Z) {
    int tid = F.tid; asm volatile("" : "+v"(tid)); const int lane = tid & 63, w = __builtin_amdgcn_readfirstlane(tid >> 6), r = lane & 31, hh = lane >> 5;
    LAS unsigned char* Us = F.lds; LAS float* Es = (LAS float*)(F.lds + S5_ES_OFF); LAS unsigned char* Kt = F.lds + S5_ES_OFF; LAS unsigned char* Xs = F.lds + S5_XS_OFF;
#pragma unroll
    for (int i = 0; i < 8; ++i) { const int idx = tid + 512 * i, t = idx >> 1, half = idx & 1;
        const v4u v = *(const GAS v4u*)(U + ((size_t)(b * SEQ + t)) * SSMW + g * 16 + half * 8); *(LAS v4u*)(Us + (t >> 6) * S5_US_STRIDE + (t & 63) * 32 + half * 16) = v; }
    __syncthreads();
    {
        const int mtile = w & 3, sh = w >> 2; f32x16 acc = (f32x16){0.f};
        const bf16* mep = MEf + ((size_t)(g * 4 + mtile) * 64 + sh * 32) * 512 + lane * 8;
#pragma unroll 8
        for (int s2 = 0; s2 < 32; ++s2) { const bf16x8 a = *(const GAS bf16x8*)(mep + (size_t)s2 * 512);
            const bf16x8 bb = *(const LAS bf16x8*)(Us + r * S5_US_STRIDE + (sh * 32 + s2) * 32 + hh * 16); acc = __builtin_amdgcn_mfma_f32_32x32x16_bf16(a, bb, acc, 0, 0, 0); }
#pragma unroll
        for (int rg = 0; rg < 16; ++rg) { const int row = mtile * 32 + (rg & 3) + 8 * (rg >> 2) + 4 * hh; Es[(sh * 128 + row) * 33 + r] = acc[rg]; }
    }
    __syncthreads();
    if (tid < 64) {
        const int p = tid; const float lr = LAM[(g * 64 + p) * 2], li = LAM[(g * 64 + p) * 2 + 1]; float xr = 0.f, xi = 0.f;
        for (int c = 0; c < 32; ++c) {
            *(LAS bf16*)(Xs + c * S5_XS_STRIDE + p * 2) = (bf16)(cvtpk(xr, 0.f) & 0xffffu); *(LAS bf16*)(Xs + c * S5_XS_STRIDE + (64 + p) * 2) = (bf16)(cvtpk(xi, 0.f) & 0xffffu);
            const float er = Es[p * 33 + c] + Es[(128 + p) * 33 + c], ei = Es[(64 + p) * 33 + c] + Es[(128 + 64 + p) * 33 + c];
            const float nr = lr * xr - li * xi + er, ni = lr * xi + li * xr + ei; xr = nr; xi = ni; }
    }
    __syncthreads();
#pragma unroll
    for (int i = 0; i < 4; ++i) { const int idx = tid + 512 * i; *(LAS v4u*)(Kt + idx * 16) = *(const GAS v4u*)(KT + (size_t)g * 16384 + idx * 8); }
    __syncthreads();
#pragma unroll 1
    for (int q = 0; q < 4; ++q) {
        const int mt = (q == 0) ? w : (q == 1) ? 15 - w : (q == 2) ? 16 + w : 31 - w;
        const int tl = 2 * mt + (r >> 4), h = r & 15; f32x16 acc = (f32x16){0.f};
        for (int s = 0; s <= 2 * mt + 1; ++s) { const int tau = tl - s; const int tc = tau < 0 ? 0 : tau;
            bf16x8 a = *(const LAS bf16x8*)(Kt + tc * 512 + h * 32 + hh * 16); if (tau < 0) a = (bf16x8){0, 0, 0, 0, 0, 0, 0, 0};
            const bf16x8 bb = *(const LAS bf16x8*)(Us + r * S5_US_STRIDE + s * 32 + hh * 16); acc = __builtin_amdgcn_mfma_f32_32x32x16_bf16(a, bb, acc, 0, 0, 0); }
        const bf16* mcp = MCf + ((size_t)(g * 32 + mt) * 8) * 512 + lane * 8;
#pragma unroll
        for (int kr = 0; kr < 8; ++kr) { const bf16x8 a = *(const GAS bf16x8*)(mcp + (size_t)kr * 512);
            const bf16x8 bb = *(const LAS bf16x8*)(Xs + r * S5_XS_STRIDE + kr * 32 + hh * 16); acc = __builtin_amdgcn_mfma_f32_32x32x16_bf16(a, bb, acc, 0, 0, 0); }
#pragma unroll
        for (int g4 = 0; g4 < 4; ++g4) { const int ts = 2 * mt + (g4 >> 1), h0 = 8 * (g4 & 1) + 4 * hh;
            const u32x2 uu = *(const LAS u32x2*)(Us + r * S5_US_STRIDE + ts * 32 + h0 * 2); const f32x4 dd = *(const GAS f32x4*)(dskip + g * 16 + h0);
            const float y0 = acc[4 * g4 + 0] + dd.x * bflo(uu.x), y1 = acc[4 * g4 + 1] + dd.y * bfhi(uu.x), y2 = acc[4 * g4 + 2] + dd.z * bflo(uu.y), y3 = acc[4 * g4 + 3] + dd.w * bfhi(uu.y);
            u32x2 o; o.x = cvtpk(gelu_tanh(y0), gelu_tanh(y1)); o.y = cvtpk(gelu_tanh(y2), gelu_tanh(y3));
            *(GAS u32x2*)(Z + ((size_t)(b * SEQ + r * 64 + ts)) * SSMW + g * 16 + h0) = o; }
    }
    __syncthreads();
}

constexpr float NEGBIG = -3.0e38f;
template <int N> __device__ __forceinline__ void bitonic_sort_desc(float (&a)[N]) {
#pragma unroll
    for (int k = 2; k <= N; k <<= 1)
#pragma unroll
        for (int j = k >> 1; j > 0; j >>= 1)
#pragma unroll
            for (int i = 0; i < N; ++i) { const int l = i ^ j; if (l > i) { const bool up = ((i & k) == 0); const float hi = fmaxf(a[i], a[l]), lo = fminf(a[i], a[l]); a[i] = up ? hi : lo; a[l] = up ? lo : hi; } }
}
template <int N> __device__ __forceinline__ void bitonic_merge_desc(float (&a)[N]) {
#pragma unroll
    for (int j = N >> 1; j > 0; j >>= 1)
#pragma unroll
        for (int i = 0; i < N; ++i) { const int l = i ^ j; if (l > i) { const float hi = fmaxf(a[i], a[l]), lo = fminf(a[i], a[l]); a[i] = hi; a[l] = lo; } }
}
__device__ __forceinline__ void top16_merge(float (&a)[16], const float (&b)[16]) {
#pragma unroll
    for (int i = 0; i < 16; ++i) a[i] = fmaxf(a[i], b[15 - i]);
    bitonic_merge_desc<16>(a);
}
__device__ __forceinline__ void topk_task(int task, int lane, const bf16* PQ, const bf16* KEYS, int* EID, float* GATE, LAS unsigned char* wl) {
    asm volatile("" : "+v"(lane));
    const int tt = task >> 3, h = task & 7, r = lane & 31, hh = lane >> 5; const size_t token = (size_t)tt * 32 + r;
    float sv[2][16];
#pragma unroll
    for (int c = 0; c < 2; ++c) {
        bf16x8 qf[8];
#pragma unroll
        for (int ks = 0; ks < 8; ++ks) qf[ks] = *(const GAS bf16x8*)(PQ + token * (PH * PDK) + h * PDK + c * 128 + ks * 16 + 8 * hh);
        float g[4][16];
#pragma unroll
        for (int mt = 0; mt < 4; ++mt) { f32x16 acc = (f32x16){0.f};
#pragma unroll
            for (int ks = 0; ks < 8; ++ks) { const bf16x8 a = *(const GAS bf16x8*)(KEYS + ((size_t)((h * 2 + c) * 128 + mt * 32 + r)) * 128 + ks * 16 + 8 * hh); acc = __builtin_amdgcn_mfma_f32_32x32x16_bf16(a, qf[ks], acc, 0, 0, 0); }
#pragma unroll
            for (int rg = 0; rg < 16; ++rg) { const unsigned n = (unsigned)(mt * 32 + (rg & 3) + 8 * (rg >> 2) + 4 * hh); g[mt][rg] = __uint_as_float((__float_as_uint(acc[rg]) & ~127u) | n); }
            bitonic_sort_desc<16>(g[mt]); }
        top16_merge(g[0], g[1]); top16_merge(g[2], g[3]); top16_merge(g[0], g[2]);
        float u[16];
#pragma unroll
        for (int i = 0; i < 16; ++i) u[i] = fmaxf(g[0][i], __shfl_xor(g[0][15 - i], 32));
        bitonic_merge_desc<16>(u);
#pragma unroll
        for (int i = 0; i < 16; ++i) sv[c][i] = u[i];
    }
    { unsigned w[8];
#pragma unroll
      for (int d = 0; d < 8; ++d) { const int c = d >> 2, i0 = (d & 3) * 4; w[d] = (__float_as_uint(sv[c][i0]) & 127u) | ((__float_as_uint(sv[c][i0 + 1]) & 127u) << 8) | ((__float_as_uint(sv[c][i0 + 2]) & 127u) << 16) | ((__float_as_uint(sv[c][i0 + 3]) & 127u) << 24); }
      LAS unsigned* tp = (LAS unsigned*)(wl + lane * 36);
#pragma unroll
      for (int d = 0; d < 8; ++d) tp[d] = w[d]; }
    float cd[4][16];
    { int q = 0;
#pragma unroll
      for (int i = 0; i < 16; ++i)
#pragma unroll
        for (int j = 0; j < 16; ++j) if ((i + 1) * (j + 1) <= 16) {
            const float s = __uint_as_float(__float_as_uint(sv[0][i]) & ~127u) + __uint_as_float(__float_as_uint(sv[1][j]) & ~127u);
            cd[q >> 4][q & 15] = __uint_as_float((__float_as_uint(s) & ~255u) | (unsigned)((i << 4) | j)); ++q; }
#pragma unroll
      for (int p = 50; p < 64; ++p) cd[p >> 4][p & 15] = NEGBIG; }
#pragma unroll
    for (int t = 0; t < 4; ++t) bitonic_sort_desc<16>(cd[t]);
    top16_merge(cd[0], cd[1]); top16_merge(cd[2], cd[3]); top16_merge(cd[0], cd[2]);
    const float s0 = __uint_as_float(__float_as_uint(cd[0][0]) & ~255u);
    float ex[16]; int we[16]; float sum = 0.f;
    const LAS unsigned char* tb = wl + lane * 36;
#pragma unroll
    for (int k = 0; k < 16; ++k) { const unsigned bits = __float_as_uint(cd[0][k]); ex[k] = __expf(__uint_as_float(bits & ~255u) - s0); sum += ex[k];
        we[k] = (int)tb[(bits >> 4) & 15u] * 128 + (int)tb[16 + (bits & 15u)]; }
    const float inv = 1.0f / sum;
    int eo[8]; float go[8];
#pragma unroll
    for (int k = 0; k < 8; ++k) { eo[k] = hh ? we[k + 8] : we[k]; go[k] = (hh ? ex[k + 8] : ex[k]) * inv; }
    int* ep = EID + token * PSEL + h * 16 + hh * 8; float* gp = GATE + token * PSEL + h * 16 + hh * 8;
    *(GAS i32x4*)ep = (i32x4){eo[0], eo[1], eo[2], eo[3]}; *(GAS i32x4*)(ep + 4) = (i32x4){eo[4], eo[5], eo[6], eo[7]};
    *(GAS f32x4*)gp = (f32x4){go[0], go[1], go[2], go[3]}; *(GAS f32x4*)(gp + 4) = (f32x4){go[4], go[5], go[6], go[7]};
}

typedef signed char i8;
#define ROWLOAD8(dst, tab, e) do { const GAS v4u* _p = (const GAS v4u*)((tab) + (size_t)(e) * DM) + lane; _Pragma("unroll") for (int _i = 0; _i < 4; ++_i) dst[_i] = _p[64 * _i]; } while (0)
#define HALFLOAD8(dst, tab, e, hf) do { const GAS v4u* _p = (const GAS v4u*)((tab) + (size_t)(e) * DM) + lane + 128 * (hf); dst[0] = _p[0]; dst[1] = _p[64]; } while (0)
__device__ __forceinline__ int dotrow8(const v4u (&a)[4], const v4u (&x)[4]) {
    int s0 = 0, s1 = 0, s2 = 0, s3 = 0;
#pragma unroll
    for (int i = 0; i < 4; ++i) { s0 = __builtin_amdgcn_sdot4((int)a[i].x, (int)x[i].x, s0, false); s1 = __builtin_amdgcn_sdot4((int)a[i].y, (int)x[i].y, s1, false);
                                  s2 = __builtin_amdgcn_sdot4((int)a[i].z, (int)x[i].z, s2, false); s3 = __builtin_amdgcn_sdot4((int)a[i].w, (int)x[i].w, s3, false); }
    return (s0 + s1) + (s2 + s3);
}
template <int HF> __device__ __forceinline__ void vquad(int (&acc)[64], const v4u (&r0)[2], const v4u (&r1)[2], const v4u (&r2)[2], const v4u (&r3)[2], int a4) {
#pragma unroll
    for (int i = 0; i < 2; ++i) {
        const unsigned x0[4] = {r0[i].x, r0[i].y, r0[i].z, r0[i].w}, x1[4] = {r1[i].x, r1[i].y, r1[i].z, r1[i].w}, x2[4] = {r2[i].x, r2[i].y, r2[i].z, r2[i].w}, x3[4] = {r3[i].x, r3[i].y, r3[i].z, r3[i].w};
#pragma unroll
        for (int w = 0; w < 4; ++w) {
            const unsigned t0 = __builtin_amdgcn_perm(x1[w], x0[w], 0x05010400u), t1 = __builtin_amdgcn_perm(x1[w], x0[w], 0x07030602u);
            const unsigned u0 = __builtin_amdgcn_perm(x3[w], x2[w], 0x05010400u), u1 = __builtin_amdgcn_perm(x3[w], x2[w], 0x07030602u);
            const unsigned y0 = __builtin_amdgcn_perm(u0, t0, 0x05040100u), y1 = __builtin_amdgcn_perm(u0, t0, 0x07060302u), y2 = __builtin_amdgcn_perm(u1, t1, 0x05040100u), y3 = __builtin_amdgcn_perm(u1, t1, 0x07060302u);
            const int b = (2 * HF + i) * 16 + w * 4;
            acc[b + 0] = __builtin_amdgcn_sdot4((int)y0, a4, acc[b + 0], false); acc[b + 1] = __builtin_amdgcn_sdot4((int)y1, a4, acc[b + 1], false);
            acc[b + 2] = __builtin_amdgcn_sdot4((int)y2, a4, acc[b + 2], false); acc[b + 3] = __builtin_amdgcn_sdot4((int)y3, a4, acc[b + 3], false); } }
}
__device__ __forceinline__ unsigned pack_lo8(unsigned a, unsigned b, unsigned c, unsigned d) {
    return __builtin_amdgcn_perm(__builtin_amdgcn_perm(d, c, 0x0c0c0400u), __builtin_amdgcn_perm(b, a, 0x0c0c0400u), 0x05040100u);
}
__device__ __forceinline__ unsigned q8x4(float a, float b, float c, float d, float inv) {
    return pack_lo8(__float_as_uint(fmaf(a, inv, 12582912.0f)), __float_as_uint(fmaf(b, inv, 12582912.0f)), __float_as_uint(fmaf(c, inv, 12582912.0f)), __float_as_uint(fmaf(d, inv, 12582912.0f)));
}
__device__ __forceinline__ float wave_max(float v) {
#pragma unroll
    for (int o = 1; o < 64; o <<= 1) v = fmaxf(v, __shfl_xor(v, o));
    return v;
}
__device__ __forceinline__ void wave_sort128(unsigned& k0, unsigned& k1, int lane) {
#pragma unroll
    for (int k = 2; k <= 128; k <<= 1)
#pragma unroll
        for (int j = k >> 1; j > 0; j >>= 1) {
            const bool asc = ((2 * lane) & k) == 0;
            if (j == 1) { const unsigned lo = k0 < k1 ? k0 : k1, hi = k0 < k1 ? k1 : k0; k0 = asc ? lo : hi; k1 = asc ? hi : lo; }
            else { const int m = j >> 1; const bool takemin = (((lane & m) == 0) == asc);
                const unsigned o0 = (unsigned)__shfl_xor((int)k0, m), o1 = (unsigned)__shfl_xor((int)k1, m);
                k0 = takemin ? (k0 < o0 ? k0 : o0) : (k0 < o0 ? o0 : k0); k1 = takemin ? (k1 < o1 ? k1 : o1) : (k1 < o1 ? o1 : k1); }
        }
}
__device__ __forceinline__ void vquad4(int (&acc)[64], const v4u (&r0)[2], const v4u (&r1)[2], const v4u (&r2)[2], const v4u (&r3)[2], int a4) {
#pragma unroll
    for (int j = 0; j < 2; ++j) {
        const unsigned d0[4] = {r0[j].x, r0[j].y, r0[j].z, r0[j].w}, d1[4] = {r1[j].x, r1[j].y, r1[j].z, r1[j].w}, d2[4] = {r2[j].x, r2[j].y, r2[j].z, r2[j].w}, d3[4] = {r3[j].x, r3[j].y, r3[j].z, r3[j].w};
#pragma unroll
        for (int c = 0; c < 4; ++c) { const int i = 2 * j + (c >> 1), p = c & 1;
            const unsigned x0 = d0[c], x1 = d1[c], x2 = d2[c], x3 = d3[c];
            const unsigned t0 = __builtin_amdgcn_perm(x1, x0, 0x05010400u), t1 = __builtin_amdgcn_perm(x1, x0, 0x07030602u);
            const unsigned u0 = __builtin_amdgcn_perm(x3, x2, 0x05010400u), u1 = __builtin_amdgcn_perm(x3, x2, 0x07030602u);
            const unsigned y[4] = {__builtin_amdgcn_perm(u0, t0, 0x05040100u), __builtin_amdgcn_perm(u0, t0, 0x07060302u), __builtin_amdgcn_perm(u1, t1, 0x05040100u), __builtin_amdgcn_perm(u1, t1, 0x07060302u)};
            const int bl = i * 16 + p * 4, bh = bl + 8;
#pragma unroll
            for (int e = 0; e < 4; ++e) { acc[bl + e] = __builtin_amdgcn_sdot4((int)(y[e] & 0x0f0f0f0fu), a4, acc[bl + e], false); acc[bh + e] = __builtin_amdgcn_sdot4((int)y[e], a4, acc[bh + e], false); } } }
}
__device__ __forceinline__ void vquad4_fix(int (&acc)[64]) {
#pragma unroll
    for (int i = 0; i < 4; ++i)
#pragma unroll
        for (int k = 0; k < 8; ++k) acc[i * 16 + 8 + k] = (acc[i * 16 + 8 + k] - acc[i * 16 + k]) >> 4;
}
#define ROWLOAD4(dst, tab, e) do { const GAS v4u* _p = (const GAS v4u*)((tab) + (size_t)(e) * (DM / 2)) + lane; dst[0] = _p[0]; dst[1] = _p[64]; } while (0)
constexpr float INT4_CLIP = 2.7f;
constexpr int N8ROWS = 0;
template <bool LAST>
__device__ __forceinline__ void gather_token(size_t token, int lane, const int* SC, const float* HS, const int* EID, const float* GATE, const float* SU, const i8* VTB, const float* SV, const i8* VT4, const float* S4,
                                             const bf16* X, bf16* Xo, float* Fo, const float* gnext, i8* XNout, float* XSout) {
    asm volatile("" : "+v"(lane));
    const i32x2 ee = *(const GAS i32x2*)(EID + token * PSEL + 2 * lane); const f32x2 gg = *(const GAS f32x2*)(GATE + token * PSEL + 2 * lane); const i32x2 scv = *(const GAS i32x2*)(SC + token * PSEL + 2 * lane);
    const f32x4 scl0 = *((const GAS f32x4*)SU + ee.x), scl1 = *((const GAS f32x4*)SU + ee.y);
    const float hs = HS[token], su0 = scl0.x, su1 = scl1.x, s80 = scl0.y, s81 = scl1.y, s40 = scl0.z, s41 = scl1.z;
    const float g0 = gelu_tanh((float)scv.x * su0 * hs) * gg.x, g1 = gelu_tanh((float)scv.y * su1 * hs) * gg.y;
    const float m0 = fabsf(g0 * s80), m1 = fabsf(g1 * s81);
    unsigned t0 = __float_as_uint(m0), t1 = __float_as_uint(m1); wave_sort128(t0, t1, lane);
    const float thr = N8ROWS > 0 ? __uint_as_float((unsigned)__builtin_amdgcn_readlane((int)t0, N8ROWS > 0 ? (128 - N8ROWS) / 2 : 0)) : 3.0e38f;
    const unsigned c0 = (m0 < thr) ? 1u : 0u, c1 = (m1 < thr) ? 1u : 0u;
    const float a0 = g0 * (c0 ? s40 : s80), a1 = g1 * (c1 ? s41 : s81);
    const float amax = wave_max(fmaxf(fabsf(a0), fabsf(a1))); const float sa = amax * (1.0f / 127.0f), ainv = amax > 0.f ? 127.0f / amax : 0.f;
    const int q0 = (int)rintf(a0 * ainv), q1 = (int)rintf(a1 * ainv);
    unsigned k0 = (c0 << 23) | ((unsigned)ee.x << 8) | (unsigned)(q0 & 0xff), k1 = (c1 << 23) | ((unsigned)ee.y << 8) | (unsigned)(q1 & 0xff);
    wave_sort128(k0, k1, lane);
    const int e0 = (int)((k0 >> 8) & 0x3fffu), e1 = (int)((k1 >> 8) & 0x3fffu); const bool i40 = (k0 >> 23) & 1u, i41 = (k1 >> 23) & 1u;
    const int n0 = __builtin_popcountll(__ballot(!i40)) + __builtin_popcountll(__ballot(!i41));
    const int pair8 = (int)((i40 ? 0u : (k0 & 0xffu)) | ((i41 ? 0u : (k1 & 0xffu)) << 8));
    const int pair4 = (int)((i40 ? (k0 & 0xffu) : 0u) | ((i41 ? (k1 & 0xffu) : 0u) << 8));
    int corr = (i40 ? (int)(signed char)(k0 & 0xffu) : 0) + (i41 ? (int)(signed char)(k1 & 0xffu) : 0);
#pragma unroll
    for (int o = 1; o < 64; o <<= 1) corr += __shfl_xor(corr, o);
    corr *= 8;
    int acc[64];
#pragma unroll
    for (int i = 0; i < 64; ++i) acc[i] = 0;
    const int nq8 = (n0 + 3) >> 2, q4s = n0 >> 2;
    if (q4s < 32) {
        v4u P0[2], P1[2], P2[2], P3[2], R0[2], R1[2], R2[2], R3[2];
#define QLOAD4(S0, S1, S2, S3, q_) do { const int ea = __builtin_amdgcn_readlane(e0, 2 * (q_)), eb = __builtin_amdgcn_readlane(e1, 2 * (q_)), ec = __builtin_amdgcn_readlane(e0, 2 * (q_) + 1), ed = __builtin_amdgcn_readlane(e1, 2 * (q_) + 1); \
            ROWLOAD4(S0, VT4, ea); ROWLOAD4(S1, VT4, eb); ROWLOAD4(S2, VT4, ec); ROWLOAD4(S3, VT4, ed); } while (0)
#define A4OF(q_) (__builtin_amdgcn_readlane(pair4, 2 * (q_)) | (__builtin_amdgcn_readlane(pair4, 2 * (q_) + 1) << 16))
        QLOAD4(P0, P1, P2, P3, q4s);
#pragma unroll 1
        for (int q = q4s; q < 32; q += 2) {
            if (q + 1 < 32) QLOAD4(R0, R1, R2, R3, q + 1);
            vquad4(acc, P0, P1, P2, P3, A4OF(q));
            if (q + 2 < 32) QLOAD4(P0, P1, P2, P3, q + 2);
            if (q + 1 < 32) vquad4(acc, R0, R1, R2, R3, A4OF(q + 1));
        }
#undef QLOAD4
#undef A4OF
        vquad4_fix(acc);
    }
    if (nq8 > 0) {
        v4u A0[2], A1[2], A2[2], A3[2], B0[2], B1[2], B2[2], B3[2];
        { const int ea = __builtin_amdgcn_readlane(e0, 0), eb = __builtin_amdgcn_readlane(e1, 0), ec = __builtin_amdgcn_readlane(e0, 1), ed = __builtin_amdgcn_readlane(e1, 1);
          HALFLOAD8(A0, VTB, ea, 0); HALFLOAD8(A1, VTB, eb, 0); HALFLOAD8(A2, VTB, ec, 0); HALFLOAD8(A3, VTB, ed, 0); }
#pragma unroll 1
        for (int q = 0; q < nq8; ++q) {
            const int a4 = __builtin_amdgcn_readlane(pair8, 2 * q) | (__builtin_amdgcn_readlane(pair8, 2 * q + 1) << 16);
            { const int ea = __builtin_amdgcn_readlane(e0, 2 * q), eb = __builtin_amdgcn_readlane(e1, 2 * q), ec = __builtin_amdgcn_readlane(e0, 2 * q + 1), ed = __builtin_amdgcn_readlane(e1, 2 * q + 1);
              HALFLOAD8(B0, VTB, ea, 1); HALFLOAD8(B1, VTB, eb, 1); HALFLOAD8(B2, VTB, ec, 1); HALFLOAD8(B3, VTB, ed, 1); }
            vquad<0>(acc, A0, A1, A2, A3, a4);
            if (q + 1 < nq8) { const int ea = __builtin_amdgcn_readlane(e0, 2 * q + 2), eb = __builtin_amdgcn_readlane(e1, 2 * q + 2), ec = __builtin_amdgcn_readlane(e0, 2 * q + 3), ed = __builtin_amdgcn_readlane(e1, 2 * q + 3);
              HALFLOAD8(A0, VTB, ea, 0); HALFLOAD8(A1, VTB, eb, 0); HALFLOAD8(A2, VTB, ec, 0); HALFLOAD8(A3, VTB, ed, 0); }
            vquad<1>(acc, B0, B1, B2, B3, a4);
        }
    }
#pragma unroll
    for (int i = 0; i < 64; ++i) if ((i & 8) == 0) acc[i] -= corr;
    const bf16* xrow = X + token * DM + lane * 16; bf16* orow = Xo + token * DM + lane * 16; float* frow = Fo + token * DM + lane * 16; float ss = 0.f; float xv[64];
#pragma unroll
    for (int i = 0; i < 4; ++i) { const v4u t0 = *(const GAS v4u*)(xrow + i * 1024), t1 = *(const GAS v4u*)(xrow + i * 1024 + 8); const int b = i * 16;
        const float xin[16] = {bflo(t0.x), bfhi(t0.x), bflo(t0.y), bfhi(t0.y), bflo(t0.z), bfhi(t0.z), bflo(t0.w), bfhi(t0.w), bflo(t1.x), bfhi(t1.x), bflo(t1.y), bfhi(t1.y), bflo(t1.z), bfhi(t1.z), bflo(t1.w), bfhi(t1.w)};
#pragma unroll
        for (int e = 0; e < 16; ++e) { xv[b + e] = xin[e] + sa * (float)acc[b + e]; ss += xv[b + e] * xv[b + e]; }
        if (!LAST) { v4u o0, o1; o0.x = cvtpk(xv[b + 0], xv[b + 1]); o0.y = cvtpk(xv[b + 2], xv[b + 3]); o0.z = cvtpk(xv[b + 4], xv[b + 5]); o0.w = cvtpk(xv[b + 6], xv[b + 7]); o1.x = cvtpk(xv[b + 8], xv[b + 9]); o1.y = cvtpk(xv[b + 10], xv[b + 11]); o1.z = cvtpk(xv[b + 12], xv[b + 13]); o1.w = cvtpk(xv[b + 14], xv[b + 15]);
            *(GAS v4u*)(orow + i * 1024) = o0; *(GAS v4u*)(orow + i * 1024 + 8) = o1; } }
    const float rstd = 1.0f / sqrtf(wave_sum(ss) * (1.f / DM) + NORM_EPS); float mx = 0.f;
#pragma unroll
    for (int i = 0; i < 4; ++i)
#pragma unroll
        for (int w = 0; w < 4; ++w) { const f32x4 ga = *(const GAS f32x4*)(gnext + i * 1024 + lane * 16 + w * 4); const int b = i * 16 + w * 4;
            xv[b + 0] *= rstd * ga.x; xv[b + 1] *= rstd * ga.y; xv[b + 2] *= rstd * ga.z; xv[b + 3] *= rstd * ga.w;
            if (LAST) *(GAS f32x4*)(frow + i * 1024 + w * 4) = (f32x4){xv[b + 0], xv[b + 1], xv[b + 2], xv[b + 3]};
            else mx = fmaxf(fmaxf(mx, fmaxf(fabsf(xv[b + 0]), fabsf(xv[b + 1]))), fmaxf(fabsf(xv[b + 2]), fabsf(xv[b + 3]))); }
    if (!LAST) {
        mx = wave_max(mx); const float inv = mx > 0.f ? 127.0f / mx : 0.f;
#pragma unroll
        for (int i = 0; i < 4; ++i) { unsigned o[4];
#pragma unroll
            for (int w = 0; w < 4; ++w) { const int b = i * 16 + w * 4; o[w] = q8x4(xv[b + 0], xv[b + 1], xv[b + 2], xv[b + 3], inv); }
            v4u ov; ov.x = o[0]; ov.y = o[1]; ov.z = o[2]; ov.w = o[3]; *(GAS v4u*)(XNout + token * DM + i * 1024 + lane * 16) = ov; }
        if (lane == 0) XSout[token] = mx * (1.0f / 127.0f);
    }
}
__device__ __forceinline__ unsigned nib4(const f32x4 t, float inv4) {
#define NIB1(x_) __float_as_uint(fminf(fmaxf(fmaf((x_), inv4, 12582920.0f), 12582913.0f), 12582927.0f))
    return pack_lo8(NIB1(t.x), NIB1(t.y), NIB1(t.z), NIB1(t.w));
#undef NIB1
}
__device__ __forceinline__ void quant_row_load(f32x4 (&v)[16], const float* src, int lane) {
#pragma unroll
    for (int c = 0; c < 16; ++c) v[c] = *(const GAS f32x4*)(src + c * 256 + lane * 4);
}
__device__ __forceinline__ void quant_row_store(const f32x4 (&v)[16], i8* dst, float* scale_out, i8* dst4, float* scale4_out, int lane) {
    float mx = 0.f;
#pragma unroll
    for (int c = 0; c < 16; ++c) { const f32x4 t = v[c]; mx = fmaxf(fmaxf(mx, fmaxf(fabsf(t.x), fabsf(t.y))), fmaxf(fabsf(t.z), fabsf(t.w))); }
    mx = wave_max(mx); const float inv = mx > 0.f ? 127.0f / mx : 0.f;
#pragma unroll
    for (int c = 0; c < 16; ++c) { const f32x4 t = v[c];
        if (dst) *(GAS unsigned*)(dst + c * 256 + lane * 4) = q8x4(t.x, t.y, t.z, t.w, inv); }
    if (lane == 0) *scale_out = mx * (1.0f / 127.0f);
    if (dst4) { float ss = 0.f;
#pragma unroll
        for (int c = 0; c < 16; ++c) { const f32x4 t = v[c]; ss += (t.x * t.x + t.y * t.y) + (t.z * t.z + t.w * t.w); }
        const float clip = fminf(mx, INT4_CLIP * sqrtf(wave_sum(ss) * (1.0f / DM))), inv4 = clip > 0.f ? 7.0f / clip : 0.f; const bool lowp = (lane & 3) < 2;
#pragma unroll
        for (int k = 0; k < 8; ++k) { const int ca = (k & 3) + (k >> 2) * 8, cb = ca + 4;
            const unsigned fix = lowp ? 0u : 0x08080808u, qa = nib4(v[ca], inv4) ^ fix, qb = nib4(v[cb], inv4) ^ fix;
            const unsigned r = (unsigned)__builtin_amdgcn_mov_dpp((int)(lowp ? qb : qa), 0x4E, 0xF, 0xF, true);
            *(GAS unsigned*)(dst4 + (size_t)((k >> 2) * 64 + (k & 3) * 16 + (lane >> 2)) * 16 + (lane & 3) * 4) = lowp ? (qa | (r << 4)) : (r | (qb << 4)); }
        if (lane == 0) *scale4_out = clip * (1.0f / 7.0f); }
}
__device__ __forceinline__ void quant_row8(const float* src, i8* dst, float* scale_out, i8* dst4, float* scale4_out, int lane) {
    f32x4 v[16]; quant_row_load(v, src, lane); quant_row_store(v, dst, scale_out, dst4, scale4_out, lane);
}
__device__ __forceinline__ void convert_tables(const float* srcu, const float* srcv, unsigned char* lw, int cw, int ncw, int lane) {
#define CT_LOAD(R, rw_) do { const int t_ = (rw_) >= NEXP, e_ = (rw_) - t_ * NEXP; quant_row_load(R, (t_ ? srcv : srcu) + (size_t)e_ * DM, lane); } while (0)
#define CT_STORE(R, rw_) do { const int t_ = (rw_) >= NEXP, e_ = (rw_) - t_ * NEXP; \
        quant_row_store(R, (t_ && N8ROWS == 0) ? (i8*)nullptr : (i8*)(lw + (t_ ? LW_VTAB : LW_UTAB)) + (size_t)e_ * DM, (float*)(lw + LW_SU) + 4 * e_ + t_, t_ ? (i8*)(lw + LW_VT4) + (size_t)e_ * (DM / 2) : (i8*)nullptr, (float*)(lw + LW_SU) + 4 * e_ + 2, lane); } while (0)
    f32x4 A[16], B[16];
    if (cw < 2 * NEXP) CT_LOAD(A, cw);
#pragma unroll 1
    for (int rw = cw; rw < 2 * NEXP; rw += 2 * ncw) {
        const int r1 = rw + ncw, r2 = rw + 2 * ncw;
        if (r1 < 2 * NEXP) CT_LOAD(B, r1);
        CT_STORE(A, rw);
        if (r2 < 2 * NEXP) CT_LOAD(A, r2);
        if (r1 < 2 * NEXP) CT_STORE(B, r1);
    }
#undef CT_LOAD
#undef CT_STORE
}
__device__ __forceinline__ void rms_row_to_bf16_i8(const float* xrow, const float* g, bf16* orow, i8* o8row, float* scale_out, int lane) {
    const GAS f32x4* xr = (const GAS f32x4*)xrow + lane;
    f32x4 v[16]; float s = 0.f;
#pragma unroll
    for (int j = 0; j < 16; ++j) { v[j] = xr[64 * j]; s += (v[j].x * v[j].x + v[j].y * v[j].y) + (v[j].z * v[j].z + v[j].w * v[j].w); }
    const float rstd = 1.0f / sqrtf(wave_sum(s) * (1.f / DM) + NORM_EPS);
    const GAS f32x4* gr = (const GAS f32x4*)g + lane;
    GAS u32x2* o8 = (GAS u32x2*)orow + lane; float mx = 0.f;
#pragma unroll
    for (int j = 0; j < 16; ++j) { const f32x4 gg = gr[64 * j]; v[j].x *= rstd * gg.x; v[j].y *= rstd * gg.y; v[j].z *= rstd * gg.z; v[j].w *= rstd * gg.w;
        u32x2 w; w.x = cvtpk(v[j].x, v[j].y); w.y = cvtpk(v[j].z, v[j].w); o8[64 * j] = w; mx = fmaxf(fmaxf(mx, fmaxf(fabsf(v[j].x), fabsf(v[j].y))), fmaxf(fabsf(v[j].z), fabsf(v[j].w))); }
    mx = wave_max(mx); const float inv = mx > 0.f ? 127.0f / mx : 0.f;
    GAS unsigned* q8 = (GAS unsigned*)o8row + lane;
#pragma unroll
    for (int j = 0; j < 16; ++j) q8[64 * j] = q8x4(v[j].x, v[j].y, v[j].z, v[j].w, inv);
    if (lane == 0) *scale_out = mx * (1.0f / 127.0f);
}

__device__ __forceinline__ void rms_row_to_i8(const float* xrow, const float* g, i8* o8row, float* scale_out, int lane) {
    const GAS f32x4* xr = (const GAS f32x4*)xrow + lane;
    f32x4 v[16]; float s = 0.f;
#pragma unroll
    for (int j = 0; j < 16; ++j) { v[j] = xr[64 * j]; s += (v[j].x * v[j].x + v[j].y * v[j].y) + (v[j].z * v[j].z + v[j].w * v[j].w); }
    const float rstd = 1.0f / sqrtf(wave_sum(s) * (1.f / DM) + NORM_EPS);
    const GAS f32x4* gr = (const GAS f32x4*)g + lane; float mx = 0.f;
#pragma unroll
    for (int j = 0; j < 16; ++j) { const f32x4 gg = gr[64 * j]; v[j].x *= rstd * gg.x; v[j].y *= rstd * gg.y; v[j].z *= rstd * gg.z; v[j].w *= rstd * gg.w;
        mx = fmaxf(fmaxf(mx, fmaxf(fabsf(v[j].x), fabsf(v[j].y))), fmaxf(fabsf(v[j].z), fabsf(v[j].w))); }
    mx = wave_max(mx); const float inv = mx > 0.f ? 127.0f / mx : 0.f;
    GAS unsigned* q8 = (GAS unsigned*)o8row + lane;
#pragma unroll
    for (int j = 0; j < 16; ++j) q8[64 * j] = q8x4(v[j].x, v[j].y, v[j].z, v[j].w, inv);
    if (lane == 0) *scale_out = mx * (1.0f / 127.0f);
}
template <int MODE> __device__ __forceinline__ void p0_tr64(const float* W, int K, int N, void* WT, const unsigned* colmax, LAS float* scr, int item, int lane) {
    const int nblk = N / 64, kb = item / nblk, nb = item % nblk, k0 = 64 * kb, n0 = 64 * nb; const int kk = lane >> 4, n4 = lane & 15;
    const float* src = W + (size_t)(k0 + kk) * N + n0 + 4 * n4;
#pragma unroll 8
    for (int i = 0; i < 16; ++i) { const f32x4 v = *(const GAS f32x4*)(src + (size_t)(4 * i) * N); LAS float* d = scr + (4 * i + kk) * 65 + 4 * n4; d[0] = v.x; d[1] = v.y; d[2] = v.z; d[3] = v.w; }
    LDS_WAIT(); asm volatile("" ::: "memory");
    if (MODE == 2) { const int c = lane & 3;
#pragma unroll
        for (int j = 0; j < 4; ++j) { const int n = (lane >> 2) + 16 * j; const LAS float* sp = scr + (16 * c) * 65 + n; const float cm = __uint_as_float(colmax[n0 + n]); const float inv = cm > 0.f ? 127.0f / cm : 0.f;
            unsigned o[4];
#pragma unroll
            for (int w = 0; w < 4; ++w) o[w] = q8x4(sp[(4 * w + 0) * 65], sp[(4 * w + 1) * 65], sp[(4 * w + 2) * 65], sp[(4 * w + 3) * 65], inv);
            v4u ov; ov.x = o[0]; ov.y = o[1]; ov.z = o[2]; ov.w = o[3]; *(GAS v4u*)((i8*)WT + (size_t)(n0 + n) * K + k0 + 16 * c) = ov; }
    } else { const int c = lane & 7;
#pragma unroll
        for (int j = 0; j < 8; ++j) { const int n = (lane >> 3) + 8 * j; const LAS float* sp = scr + (8 * c) * 65 + n;
            v4u o; o.x = cvtpk(sp[0 * 65], sp[1 * 65]); o.y = cvtpk(sp[2 * 65], sp[3 * 65]); o.z = cvtpk(sp[4 * 65], sp[5 * 65]); o.w = cvtpk(sp[6 * 65], sp[7 * 65]);
            int nrow = n0 + n; if (MODE == 1) { const int half = nrow >> 10, rem = nrow & 1023; nrow = (rem >> 7) * 256 + half * 128 + (rem & 127); }
            *(GAS v4u*)((bf16*)WT + (size_t)nrow * K + k0 + 8 * c) = o; }
    }
    LDS_WAIT(); asm volatile("" ::: "memory");
}
__device__ __forceinline__ void p0_transpose_q8_item(const float* W, int K, int N, const unsigned* colmax, i8* WT8, LAS float* scr, int item, int lane) {
    const int nblk = N / 32, kb = item / nblk, nb = item % nblk, k0 = 128 * kb, n0 = 32 * nb;
#pragma unroll 8
    for (int i = 0; i < 64; ++i) { const int kk = 2 * i + (lane >> 5); scr[kk * 33 + (lane & 31)] = W[(size_t)(k0 + kk) * N + n0 + (lane & 31)]; }
    LDS_WAIT(); asm volatile("" ::: "memory");
    const int c = lane & 7;
#pragma unroll
    for (int j = 0; j < 4; ++j) { const int n = (lane >> 3) + 8 * j; const LAS float* sp = scr + (16 * c) * 33 + n; const float cm = __uint_as_float(colmax[n0 + n]); const float inv = cm > 0.f ? 127.0f / cm : 0.f;
        unsigned o[4];
#pragma unroll
        for (int w = 0; w < 4; ++w) o[w] = q8x4(sp[(4 * w + 0) * 33], sp[(4 * w + 1) * 33], sp[(4 * w + 2) * 33], sp[(4 * w + 3) * 33], inv);
        v4u ov; ov.x = o[0]; ov.y = o[1]; ov.z = o[2]; ov.w = o[3]; *(GAS v4u*)(WT8 + (size_t)(n0 + n) * K + k0 + 16 * c) = ov; }
    LDS_WAIT(); asm volatile("" ::: "memory");
}

constexpr int PTILE = 512, NPTILE = M / PTILE, PPAIRS = PTILE * PSEL;
static_assert(PPAIRS == 65536, "pair index must fit 16 bits");
constexpr int SORT_SPLIT = 8;
__device__ __forceinline__ void sort_tile(Frame& F, int item, const int* EID, unsigned* PAIRS) {
    int tid = F.tid; asm volatile("" : "+v"(tid));
    const int tile = item / SORT_SPLIT, g = item % SORT_SPLIT;
    LAS unsigned* hist = (LAS unsigned*)F.lds; LAS unsigned* part = hist + 2048 + 64;
    for (int i = tid; i < 2048 + 64; i += 512) hist[i] = 0u;
    __syncthreads();
    const GAS i32x4* eid = (const GAS i32x4*)(EID + (size_t)tile * PPAIRS);
    unsigned below = 0;
    for (int i = tid; i < PPAIRS / 4; i += 512) { const i32x4 v = eid[i];
#pragma unroll
        for (int k = 0; k < 4; ++k) { const int e = v[k], hi = e >> 11, lo = e & 2047; below += (hi < g) ? 1u : 0u; if (hi == g) __hip_atomic_fetch_add(hist + lo + (lo >> 5), 1u, __ATOMIC_RELAXED, __HIP_MEMORY_SCOPE_WORKGROUP); } }
    part[tid] = below;
    __syncthreads();
    for (int d = 1; d < 512; d <<= 1) { const unsigned v = (tid >= d) ? part[tid - d] : 0u; __syncthreads(); part[tid] += v; __syncthreads(); }
    const unsigned base = part[511];
    __syncthreads();
    unsigned sum = 0;
#pragma unroll
    for (int j = 0; j < 4; ++j) { const int b = 4 * tid + j; sum += hist[b + (b >> 5)]; }
    part[tid] = sum;
    __syncthreads();
    for (int d = 1; d < 512; d <<= 1) { const unsigned v = (tid >= d) ? part[tid - d] : 0u; __syncthreads(); part[tid] += v; __syncthreads(); }
    unsigned run = base + part[tid] - sum;
#pragma unroll
    for (int j = 0; j < 4; ++j) { const int b = 4 * tid + j; const unsigned c = hist[b + (b >> 5)]; hist[b + (b >> 5)] = run; run += c; }
    __syncthreads();
    for (int i = tid; i < PPAIRS / 4; i += 512) { const i32x4 v = eid[i];
#pragma unroll
        for (int k = 0; k < 4; ++k) { const int e = v[k], lo = e & 2047; if ((e >> 11) == g) { const unsigned pos = __hip_atomic_fetch_add(hist + lo + (lo >> 5), 1u, __ATOMIC_RELAXED, __HIP_MEMORY_SCOPE_WORKGROUP); PAIRS[(size_t)tile * PPAIRS + pos] = ((unsigned)e << 16) | (unsigned)(4 * i + k); } } }
    __syncthreads();
}
#define ULOAD(Ux, ent) do { const GAS v4u* _u = (const GAS v4u*)(UT + (size_t)((ent) >> 16) * DM) + lane; _Pragma("unroll") for (int _i = 0; _i < 4; ++_i) Ux[_i] = _u[64 * _i]; } while (0)
#define HLOAD(Hx, ent) do { const GAS v4u* _h = (const GAS v4u*)(HN8 + ((size_t)tile * PTILE + (((ent) >> 7) & 511u)) * DM) + lane; _Pragma("unroll") for (int _i = 0; _i < 4; ++_i) Hx[_i] = _h[64 * _i]; } while (0)
#define UNIT_NEXT(s_, n_) do { const unsigned long long _m = ((s_) >= 63) ? 0ull : (firsts >> ((s_) + 1)); int _r = _m ? (int)__builtin_ctzll(_m) + 1 : 64; if (_r > npos - (s_)) _r = npos - (s_); n_ = _r < 4 ? _r : 4; } while (0)
#define UNIT_LOAD(U_, H0_, H1_, H2_, H3_, s_, n_) do { ULOAD(U_, ENT(s_)); HLOAD(H0_, ENT(s_)); if ((n_) > 1) HLOAD(H1_, ENT((s_) + 1)); if ((n_) > 2) HLOAD(H2_, ENT((s_) + 2)); if ((n_) > 3) HLOAD(H3_, ENT((s_) + 3)); } while (0)
#define UNIT_COMPUTE(U_, H0_, H1_, H2_, H3_, s_, n_) do { int part[4]; part[0] = dotrow8(U_, H0_); part[1] = dotrow8(U_, H1_); part[2] = dotrow8(U_, H2_); part[3] = dotrow8(U_, H3_); int p2[2]; \
    _Pragma("unroll") for (int i = 0; i < 2; ++i) { const int send = hh ? part[i] : part[i + 2], keep = hh ? part[i + 2] : part[i]; p2[i] = keep + __shfl_xor(send, 32); } \
    int p1; { const int send = b4 ? p2[0] : p2[1], keep = b4 ? p2[1] : p2[0]; p1 = keep + __shfl_xor(send, 16); } \
    p1 += __shfl_xor(p1, 8); p1 += __shfl_xor(p1, 4); p1 += __shfl_xor(p1, 2); p1 += __shfl_xor(p1, 1); \
    const int j = lane >> 4; const unsigned me = (unsigned)__shfl((int)myent, (j < (n_)) ? (s_) + j : (s_)); \
    if ((lane & 15) == 0 && j < (n_)) SC[((size_t)tile * PTILE + ((me >> 7) & 511u)) * PSEL + (me & 127u)] = p1; } while (0)
__device__ __forceinline__ void uphase_chunk(int tile, unsigned c0, unsigned c1, int lane, const unsigned* PAIRS, const i8* UT, const i8* HN8, int* SC) {
    const unsigned* pr = PAIRS + (size_t)tile * PPAIRS; const int hh = lane >> 5, b4 = (lane >> 4) & 1;
    for (unsigned base = c0; base < c1; base += 64) {
        const int npos = (int)((c1 - base) < 64u ? (c1 - base) : 64u);
        const unsigned myent = pr[base + (unsigned)(lane < npos ? lane : npos - 1)];
        const unsigned prev = (unsigned)__shfl_up((int)myent, 1);
        const unsigned long long firsts = __ballot((lane == 0) || ((myent >> 16) != (prev >> 16)));
#define ENT(q) ((unsigned)__builtin_amdgcn_readlane((int)myent, (q)))
        v4u UA[4], HA0[4], HA1[4], HA2[4], HA3[4], UB[4], HB0[4], HB1[4], HB2[4], HB3[4];
        int s = 0, sA = 0, nA = 0, sB = 0, nB = 0;
        UNIT_NEXT(s, nA); sA = s; UNIT_LOAD(UA, HA0, HA1, HA2, HA3, sA, nA); s += nA;
#pragma unroll 1
        for (;;) {
            if (s < npos) { UNIT_NEXT(s, nB); sB = s; UNIT_LOAD(UB, HB0, HB1, HB2, HB3, sB, nB); s += nB; } else nB = 0;
            UNIT_COMPUTE(UA, HA0, HA1, HA2, HA3, sA, nA);
            if (nB == 0) break;
            if (s < npos) { UNIT_NEXT(s, nA); sA = s; UNIT_LOAD(UA, HA0, HA1, HA2, HA3, sA, nA); s += nA; } else nA = 0;
            UNIT_COMPUTE(UB, HB0, HB1, HB2, HB3, sB, nB);
            if (nA == 0) break;
        }
#undef ENT
    }
}

template <int NCH> __device__ __forceinline__ void quant_bf16_row(const bf16* src, i8* dst, float* scale_out, int lane) {
    v4u v[NCH]; float mx = 0.f;
#pragma unroll
    for (int i = 0; i < NCH; ++i) { v[i] = *((const GAS v4u*)src + i * 64 + lane);
        mx = fmaxf(mx, fmaxf(fmaxf(fmaxf(fabsf(bflo(v[i].x)), fabsf(bfhi(v[i].x))), fmaxf(fabsf(bflo(v[i].y)), fabsf(bfhi(v[i].y)))), fmaxf(fmaxf(fabsf(bflo(v[i].z)), fabsf(bfhi(v[i].z))), fmaxf(fabsf(bflo(v[i].w)), fabsf(bfhi(v[i].w)))))); }
    mx = wave_max(mx); const float inv = mx > 0.f ? 127.0f / mx : 0.f;
#pragma unroll
    for (int i = 0; i < NCH; ++i) { u32x2 o;
        o.x = q8x4(bflo(v[i].x), bfhi(v[i].x), bflo(v[i].y), bfhi(v[i].y), inv);
        o.y = q8x4(bflo(v[i].z), bfhi(v[i].z), bflo(v[i].w), bfhi(v[i].w), inv);
        *((GAS u32x2*)dst + i * 64 + lane) = o; }
    if (lane == 0) *scale_out = mx * (1.0f / 127.0f);
}

__device__ __forceinline__ int order_id(const Frame& F, const XcdBarrier& bar, bool use_bar) {
    if (!use_bar) return (int)blockIdx.x;
    const unsigned x = F.xcc, rank = F.xrank; unsigned nx = 0, xi = 0; bool uniform = true; const unsigned per = (unsigned)F.G >> 3;
    for (unsigned j = 0; j < 16; ++j) { const unsigned c = xb_ld(&bar.bar[XB_XCNT(j)]); nx += (c > 0u); xi += (c > 0u && j < x); uniform = uniform && (c == 0u || c == per); }
    return (uniform && nx == 8u && (F.G & 7) == 0 && rank < per) ? (int)(rank * 8u + xi) : (int)blockIdx.x;
}
__device__ __forceinline__ void rms_row16_to_i8(const bf16* xrow, const float* g, i8* o8row, float* scale_out, int lane) {
    float v[64]; float s = 0.f;
#pragma unroll
    for (int j = 0; j < 8; ++j) { const v4u t = *((const GAS v4u*)xrow + 64 * j + lane);
        v[8 * j + 0] = bflo(t.x); v[8 * j + 1] = bfhi(t.x); v[8 * j + 2] = bflo(t.y); v[8 * j + 3] = bfhi(t.y); v[8 * j + 4] = bflo(t.z); v[8 * j + 5] = bfhi(t.z); v[8 * j + 6] = bflo(t.w); v[8 * j + 7] = bfhi(t.w);
#pragma unroll
        for (int e = 0; e < 8; ++e) s += v[8 * j + e] * v[8 * j + e]; }
    const float rstd = 1.0f / sqrtf(wave_sum(s) * (1.f / DM) + NORM_EPS); float mx = 0.f;
#pragma unroll
    for (int j = 0; j < 8; ++j) { const f32x4 g0 = *((const GAS f32x4*)g + 2 * (64 * j + lane)), g1 = *((const GAS f32x4*)g + 2 * (64 * j + lane) + 1);
        v[8 * j + 0] *= rstd * g0.x; v[8 * j + 1] *= rstd * g0.y; v[8 * j + 2] *= rstd * g0.z; v[8 * j + 3] *= rstd * g0.w; v[8 * j + 4] *= rstd * g1.x; v[8 * j + 5] *= rstd * g1.y; v[8 * j + 6] *= rstd * g1.z; v[8 * j + 7] *= rstd * g1.w;
#pragma unroll
        for (int e = 0; e < 8; ++e) mx = fmaxf(mx, fabsf(v[8 * j + e])); }
    mx = wave_max(mx); const float inv = mx > 0.f ? 127.0f / mx : 0.f;
#pragma unroll
    for (int j = 0; j < 8; ++j) { u32x2 o;
        o.x = q8x4(v[8 * j + 0], v[8 * j + 1], v[8 * j + 2], v[8 * j + 3], inv);
        o.y = q8x4(v[8 * j + 4], v[8 * j + 5], v[8 * j + 6], v[8 * j + 7], inv);
        *((GAS u32x2*)o8row + 64 * j + lane) = o; }
    if (lane == 0) *scale_out = mx * (1.0f / 127.0f);
}
__device__ __forceinline__ void xcc_local_barrier(gu32* ctl, unsigned x, unsigned nloc, unsigned* tmo_bar) {
    asm volatile("s_waitcnt vmcnt(0)" ::: "memory");
    __syncthreads();
    if (threadIdx.x == 0) {
        __builtin_amdgcn_s_waitcnt(0);
        unsigned xx = x; asm volatile("" : "+s"(xx));
        unsigned* cnt = (unsigned*)ctl + CW_LBAR + 64 * xx; unsigned* gen = (unsigned*)ctl + CW_LBAR + 1024 + 64 * xx;
        const unsigned old = xb_add(cnt, 1u), g = old / nloc;
        if (old + 1u == (g + 1u) * nloc) xb_add(gen, 1u);
        else XB_SPIN(xb_ld(gen) == g, tmo_bar);
        __builtin_amdgcn_fence(__ATOMIC_ACQUIRE, "agent");
        asm volatile("s_waitcnt vmcnt(0)" ::: "memory");
    }
    __syncthreads();
}
struct Args { const float* in[22]; float* out; unsigned char* ws; int ph_lo, ph_hi, dup, pad; };
__global__ void __launch_bounds__(NWAVES * 64, 2) hybrid_fwd(Args args) {
    extern __shared__ __attribute__((aligned(16))) unsigned char lds[];
    Frame F;
    F.lds = (LAS unsigned char*)lds; F.MISC = (volatile LAS unsigned*)(F.lds + MISC_OFF);
    F.tid = threadIdx.x; F.lane = F.tid & 63; F.wave = __builtin_amdgcn_readfirstlane(F.tid >> 6); F.G = gridDim.x; F.ws = args.ws;
    F.ctl = (gu32*)(args.ws + WS_CTL);
    for (int u = F.tid; u < (LDS_BYTES - LDSCTL_OFF) / 4; u += NWAVES * 64) ((LAS unsigned*)(F.lds + LDSCTL_OFF))[u] = 0u;
    __syncthreads();
    const int lo = args.ph_lo, hi = args.ph_hi;
    const bool use_bar = MK_ONE_LAUNCH ? true : (hi - lo) > 1;
    XcdBarrier bar; bar.bar = (unsigned*)(F.ctl + CW_BAR); bar.x = 0; bar.st = nullptr;
    if (use_bar) bar = xcd_barrier_post((unsigned*)(F.ctl + CW_BAR), F.MISC + 8);
    if (F.tid == 0) { const unsigned x = use_bar ? xb_xcc_id() : (blockIdx.x & 7u); F.MISC[10] = x;
        F.MISC[11] = use_bar ? __hip_atomic_fetch_add((unsigned*)(F.ctl + CW_XRANK) + 64 * x, 1u, __ATOMIC_RELAXED, __HIP_MEMORY_SCOPE_AGENT) : (blockIdx.x >> 3); }
    __syncthreads();
    F.xcc = (unsigned)__builtin_amdgcn_readfirstlane((int)F.MISC[10]); F.xrank = (unsigned)__builtin_amdgcn_readfirstlane((int)F.MISC[11]);
#ifndef DUPMASK
#define DUPMASK 0
#endif
#define REPS(k)
#if MK_ONE_LAUNCH
#define DRY false
#else
#define DRY (args.dup != 0)
#endif
#ifndef PHSUB
#define PHSUB 3
#endif
#ifndef PHMASK
#define PHMASK 0x3ff
#endif
#if MK_ONE_LAUNCH
#define IN(k) true
#define SEAM(k) do { if ((k) + 1 < NPHASES) xcd_barrier(bar); } while (0)
#else
#define IN(k) (lo <= (k) && (k) < hi)
#define SEAM(k) do { if (IN(k) && IN((k) + 1)) xcd_barrier(bar); } while (0)
#endif
#define PH_PTRS int z_; asm volatile("s_mov_b32 %0, 0" : "=s"(z_)); int lane_ = F.tid & 63; asm volatile("" : "+v"(lane_)); const int gw = gw0 + z_; (void)gw; unsigned char* ws = args.ws + z_; float* X = args.out + z_; (void)X; \
    bf16* XN = (bf16*)(ws + WS_XN); bf16* Qb = (bf16*)(ws + WS_Q); bf16* KBb = (bf16*)(ws + WS_KB); bf16* VTb = (bf16*)(ws + WS_VT); bf16* Ub = (bf16*)(ws + WS_U); \
    bf16* GA = (bf16*)(ws + WS_GA); bf16* GS = (bf16*)(ws + WS_GS); bf16* ATT = (bf16*)(ws + WS_ATT); bf16* Zb = (bf16*)(ws + WS_Z); bf16* SSb = (bf16*)(ws + WS_SS); \
    bf16* MG = (bf16*)(ws + WS_MG); bf16* PQ = (bf16*)(ws + WS_PQ); bf16* HN = (bf16*)(ws + WS_HN); int* EID = (int*)(ws + WS_EID); float* GATE = (float*)(ws + WS_GATE); i8* HN8 = (i8*)(ws + WS_HN8); float* HS = (float*)(ws + WS_HS); (void)HN8; (void)HS; unsigned* PAIRS = (unsigned*)(ws + WS_PAIRS); int* SC = (int*)(ws + WS_SC); (void)PAIRS; (void)SC; i8* ATT8 = (i8*)(ws + WS_XN + 65 * MiB); i8* SS8 = (i8*)(ws + WS_XN + 97 * MiB); i8* MG8 = (i8*)(ws + WS_Q); float* ATS = (float*)(ws + WS_HS + 256 * 1024); float* SSS = (float*)(ws + WS_HS + 512 * 1024); float* MGS = (float*)(ws + WS_HS + 768 * 1024); (void)ATT8; (void)SS8; (void)MG8; (void)ATS; (void)SSS; (void)MGS; bf16* XB = (bf16*)(ws + WS_HN); (void)XB; i8* XN8 = (i8*)(ws + WS_XN); float* XS = (float*)(ws + WS_XN + 64 * MiB); (void)XN8; (void)XS; \
    (void)XN; (void)Qb; (void)KBb; (void)VTb; (void)Ub; (void)GA; (void)GS; (void)ATT; (void)Zb; (void)SSb; (void)MG; (void)PQ; (void)HN; (void)EID; (void)GATE;
#define INP(i) (args.in[(i) + z_])
#define ORDER_ID() order_id(F, bar, use_bar)
    const int gw0 = blockIdx.x * NWAVES + F.wave, NGW = F.G * NWAVES;

    if (IN(0)) { PH_PTRS
        for (int t = gw; t < DEPTH * 32 * 48; t += NGW) { const int l = t / 1536, r = t % 1536, kc = r / 48, nb = r % 48;
            const float* src = INP(2) + ((size_t)l * DM + kc * 128) * INCOLS + nb * 256 + lane_ * 4; f32x4 mx = (f32x4){0.f, 0.f, 0.f, 0.f};
#pragma unroll 8
            for (int k = 0; k < 128; ++k) { const f32x4 v = *(const GAS f32x4*)(src + (size_t)k * INCOLS); mx.x = fmaxf(mx.x, fabsf(v.x)); mx.y = fmaxf(mx.y, fabsf(v.y)); mx.z = fmaxf(mx.z, fabsf(v.z)); mx.w = fmaxf(mx.w, fabsf(v.w)); }
            unsigned* cm = (unsigned*)(F.ctl + CW_COLMAX) + l * INCOLS + nb * 256 + lane_ * 4;
            __hip_atomic_fetch_max(cm + 0, __float_as_uint(mx.x), __ATOMIC_RELAXED, __HIP_MEMORY_SCOPE_AGENT); __hip_atomic_fetch_max(cm + 1, __float_as_uint(mx.y), __ATOMIC_RELAXED, __HIP_MEMORY_SCOPE_AGENT);
            __hip_atomic_fetch_max(cm + 2, __float_as_uint(mx.z), __ATOMIC_RELAXED, __HIP_MEMORY_SCOPE_AGENT); __hip_atomic_fetch_max(cm + 3, __float_as_uint(mx.w), __ATOMIC_RELAXED, __HIP_MEMORY_SCOPE_AGENT); }
    }
    if (IN(0)) { PH_PTRS
        constexpr int T_AB = (ATTW / 128) * 16, T_SB = (SSMW / 128) * 16, T_OUT = (DM / 128) * 16, T_L = T_AB + T_SB + T_OUT;
        for (int t = gw; t < DEPTH * T_L; t += NGW) { const int l = t / T_L; int r = t % T_L; int which, K; const float* W;
            if (r < T_AB) { which = 0; K = ATTW; W = INP(13) + (size_t)l * ATTW * DM; } else if (r < T_AB + T_SB) { r -= T_AB; which = 1; K = SSMW; W = INP(14) + (size_t)l * SSMW * DM; } else { r -= T_AB + T_SB; which = 2; K = DM; W = INP(15) + (size_t)l * DM * DM; }
            (void)K; const int kc = r / 16, nb = r % 16; const float* src = W + (size_t)(kc * 128) * DM + nb * 256 + lane_ * 4; f32x4 mx = (f32x4){0.f, 0.f, 0.f, 0.f};
#pragma unroll 8
            for (int k = 0; k < 128; ++k) { const f32x4 v = *(const GAS f32x4*)(src + (size_t)k * DM); mx.x = fmaxf(mx.x, fabsf(v.x)); mx.y = fmaxf(mx.y, fabsf(v.y)); mx.z = fmaxf(mx.z, fabsf(v.z)); mx.w = fmaxf(mx.w, fabsf(v.w)); }
            unsigned* cm = (unsigned*)(F.ctl + CW_COLMAX2) + (l * 3 + which) * DM + nb * 256 + lane_ * 4;
            __hip_atomic_fetch_max(cm + 0, __float_as_uint(mx.x), __ATOMIC_RELAXED, __HIP_MEMORY_SCOPE_AGENT); __hip_atomic_fetch_max(cm + 1, __float_as_uint(mx.y), __ATOMIC_RELAXED, __HIP_MEMORY_SCOPE_AGENT);
            __hip_atomic_fetch_max(cm + 2, __float_as_uint(mx.z), __ATOMIC_RELAXED, __HIP_MEMORY_SCOPE_AGENT); __hip_atomic_fetch_max(cm + 3, __float_as_uint(mx.w), __ATOMIC_RELAXED, __HIP_MEMORY_SCOPE_AGENT); }
    }
    if (IN(0)) { PH_PTRS
        for (int t = gw; t < DEPTH * 32 * 8; t += NGW) { const int l = t / 256, r = t % 256, kc = r / 8, nb = r % 8;
            const float* src = INP(17) + ((size_t)l * DM + kc * 128) * (PH * PDK) + nb * 256 + lane_ * 4; f32x4 mx = (f32x4){0.f, 0.f, 0.f, 0.f};
#pragma unroll 8
            for (int k = 0; k < 128; ++k) { const f32x4 v = *(const GAS f32x4*)(src + (size_t)k * (PH * PDK)); mx.x = fmaxf(mx.x, fabsf(v.x)); mx.y = fmaxf(mx.y, fabsf(v.y)); mx.z = fmaxf(mx.z, fabsf(v.z)); mx.w = fmaxf(mx.w, fabsf(v.w)); }
            unsigned* cm = (unsigned*)(F.ctl + CW_COLMAX3) + l * 2048 + nb * 256 + lane_ * 4;
            __hip_atomic_fetch_max(cm + 0, __float_as_uint(mx.x), __ATOMIC_RELAXED, __HIP_MEMORY_SCOPE_AGENT); __hip_atomic_fetch_max(cm + 1, __float_as_uint(mx.y), __ATOMIC_RELAXED, __HIP_MEMORY_SCOPE_AGENT);
            __hip_atomic_fetch_max(cm + 2, __float_as_uint(mx.z), __ATOMIC_RELAXED, __HIP_MEMORY_SCOPE_AGENT); __hip_atomic_fetch_max(cm + 3, __float_as_uint(mx.w), __ATOMIC_RELAXED, __HIP_MEMORY_SCOPE_AGENT); }
    }
    SEAM(0);
#define CONVERT_WEIGHTS(l, lw, scr) do { \
            constexpr int I_IN = (DM / 64) * (INCOLS / 64), I_AB = (ATTW / 64) * (DM / 64), I_SB = (SSMW / 64) * (DM / 64), I_OUT = (DM / 64) * (DM / 64), I_GLU = (SSMW / 64) * (2 * SSMW / 64), I_PQ = (DM / 64) * (PH * PDK / 64); \
            constexpr int NIT = I_IN + I_AB + I_SB + I_OUT + I_GLU + I_PQ; \
            for (int it = gw; it < NIT; it += NGW) { \
                int r = it; \
                if (r < I_IN) { p0_tr64<2>(INP(2) + (size_t)l * DM * INCOLS, DM, INCOLS, lw + LW_WIN, (const unsigned*)(F.ctl + CW_COLMAX) + l * INCOLS, scr, r, lane_); continue; } r -= I_IN; \
                if (r < I_AB) { p0_tr64<2>(INP(13) + (size_t)l * ATTW * DM, ATTW, DM, lw + LW_WAB, (const unsigned*)(F.ctl + CW_COLMAX2) + (l * 3 + 0) * DM, scr, r, lane_); continue; } r -= I_AB; \
                if (r < I_SB) { p0_tr64<2>(INP(14) + (size_t)l * SSMW * DM, SSMW, DM, lw + LW_WSB, (const unsigned*)(F.ctl + CW_COLMAX2) + (l * 3 + 1) * DM, scr, r, lane_); continue; } r -= I_SB; \
                if (r < I_OUT) { p0_tr64<2>(INP(15) + (size_t)l * DM * DM, DM, DM, lw + LW_WOUT, (const unsigned*)(F.ctl + CW_COLMAX2) + (l * 3 + 2) * DM, scr, r, lane_); continue; } r -= I_OUT; \
                if (r < I_GLU) { p0_tr64<1>(INP(11) + (size_t)l * SSMW * 2 * SSMW, SSMW, 2 * SSMW, lw + LW_WGLU, nullptr, scr, r, lane_); continue; } r -= I_GLU; \
                p0_tr64<2>(INP(17) + (size_t)l * DM * PH * PDK, DM, PH * PDK, lw + LW_WPQ, (const unsigned*)(F.ctl + CW_COLMAX3) + l * 2048, scr, r, lane_); \
            } \
        } while (0)
    if (((PHMASK >> 0) & 1) && IN(1)) REPS(0) { PH_PTRS
        LAS float* scr = (LAS float*)(F.lds + F.wave * 16896);
        for (int l = 0; l < DEPTH; ++l) {
            unsigned char* lw = ws + WS_LW + (size_t)l * LW_SIZE;
            CONVERT_WEIGHTS(l, lw, scr);
            constexpr size_t NK = (size_t)PH * 2 * NKEYS * 128 / 512;
            for (size_t st = gw; st < NK; st += NGW) { const float* src = INP(18) + (size_t)l * PH * 2 * NKEYS * 128; bf16* dst = (bf16*)(lw + LW_KEYS);
                const size_t e = st * 512 + lane_ * 8; const f32x4 a = *(const GAS f32x4*)(src + e), b = *(const GAS f32x4*)(src + e + 4);
                v4u o; o.x = cvtpk(a.x, a.y); o.y = cvtpk(a.z, a.w); o.z = cvtpk(b.x, b.y); o.w = cvtpk(b.z, b.w); *(GAS v4u*)(dst + e) = o; }
        }
        for (int i = gw * 64 + lane_; i < DEPTH * 2048; i += NGW * 64) ((float*)(ws + WS_LW + (size_t)(i / 2048) * LW_SIZE + LW_WPQS))[i % 2048] = __uint_as_float(((const unsigned*)(F.ctl + CW_COLMAX3))[i]) * (1.0f / 127.0f);
        for (int i = gw * 64 + lane_; i < DEPTH * 3 * DM; i += NGW * 64) { const int l = i / (3 * DM), which = (i / DM) % 3, n = i % DM; unsigned char* lw = ws + WS_LW + (size_t)l * LW_SIZE;
            ((float*)(lw + (which == 0 ? LW_WABS : which == 1 ? LW_WSBS : LW_WOUTS)))[n] = __uint_as_float(((const unsigned*)(F.ctl + CW_COLMAX2))[i]) * (1.0f / 127.0f); }
        for (int l = 0; l < DEPTH; ++l) for (int n = gw * 64 + lane_; n < INCOLS; n += NGW * 64) ((float*)(ws + WS_LW + (size_t)l * LW_SIZE + LW_WINS))[n] = __uint_as_float(((const unsigned*)(F.ctl + CW_COLMAX))[l * INCOLS + n]) * (1.0f / 127.0f);
        for (int m = gw; m < M; m += NGW) rms_row_to_i8(INP(0) + (size_t)m * DM, INP(1), XN8 + (size_t)m * DM, XS + m, lane_);
        __syncthreads();
        for (int it2 = blockIdx.x; it2 < DEPTH * SSMG * 2; it2 += F.G) { const int it = it2 >> 1, half = it2 & 1; const int l = it / SSMG, g = it % SSMG; unsigned char* lw = ws + WS_LW + (size_t)l * LW_SIZE;
            s5_precompute(F, INP(3) + l * SSMG * 64, INP(4) + l * SSMG * 64, INP(5) + l * SSMG, INP(6) + (size_t)l * SSMG * 1024, INP(7) + (size_t)l * SSMG * 1024,
                          INP(8) + (size_t)l * SSMG * 1024, INP(9) + (size_t)l * SSMG * 1024, g, half, (bf16*)(lw + LW_S5K), (bf16*)(lw + LW_S5ME), (bf16*)(lw + LW_S5MC), (float*)(lw + LW_S5LAM)); }
    }
    SEAM(1);
    if (use_bar) { unsigned nloc = 0, xi = 0, nx = 0;
        for (unsigned j = 0; j < 16; ++j) { const unsigned c = xb_ld(&bar.bar[XB_XCNT(j)]); nx += (c > 0u); xi += (c > 0u && j < F.xcc); nloc = (j == F.xcc) ? c : nloc; }
        F.xi = (unsigned)__builtin_amdgcn_readfirstlane((int)xi); F.nx = (unsigned)__builtin_amdgcn_readfirstlane((int)(nx ? nx : 1u)); F.nloc = (unsigned)__builtin_amdgcn_readfirstlane((int)(nloc ? nloc : 1u)); }
    else if ((F.G & 7) == 0) { F.xi = F.xcc; F.nx = 8; F.nloc = (unsigned)F.G >> 3; }
    else { F.xi = 0; F.nx = 1; F.nloc = (unsigned)F.G; F.xrank = blockIdx.x; }
    const int wl = (int)F.xrank * NWAVES + F.wave, NWL = (int)F.nloc * NWAVES;
#define LSEAM(k) do { if (use_bar && (k) + 1 < NPHASES) xcc_local_barrier(F.ctl, F.xcc, F.nloc, bar.bar); } while (0)
#define FOR_OWNED(b) for (int b = (int)F.xi; b < BATCH; b += (int)F.nx)

#pragma unroll 1
    for (int l = 0; l < DEPTH; ++l) {
        const int pb = NPH_PRO + l * NPH_LAYER;
        if (((PHMASK >> 1) & 1) && IN(pb + 0)) REPS(1) { PH_PTRS unsigned char* lw = ws + WS_LW + (size_t)l * LW_SIZE; (void)lw;
            pg8::Gemm g{(const bf16*)XN8, (const bf16*)(lw + LW_WIN), M, INCOLS, DM / 2}; pg8::LocalWindow S; S.init(INCOLS, (int)F.nloc, (int)F.xrank, (int)F.xi, (int)F.nx);
            const int mine = (S.nbo * 8 * S.nN - (int)F.xrank + (int)F.nloc - 1) / (int)F.nloc, cut = ((int)F.xrank * (mine + 1)) / (int)F.nloc;
            pg8::EpiIn8 E{Qb, KBb, VTb, Ub, GA, GS, XS, (const float*)(lw + LW_WINS)};
            S.lo = 0; S.hi = cut; pg8::gemm_phase<pg8::EpiIn8, pg8::LocalWindow, true, true>(F.lds, g, S, E);
            convert_tables(INP(19) + (size_t)l * NEXP * DM, INP(20) + (size_t)l * NEXP * DM, lw, (int)blockIdx.x * NWAVES + F.wave, F.G * NWAVES, lane_);
            if (use_bar) { asm volatile("s_waitcnt vmcnt(0)" ::: "memory"); __syncthreads();
                if (threadIdx.x == 0) { __builtin_amdgcn_fence(__ATOMIC_RELEASE, "agent"); asm volatile("s_waitcnt vmcnt(0)" ::: "memory"); (void)xb_add((unsigned*)F.ctl + CW_CONV + 64 * l, 1u); } }
            S.lo = cut; S.hi = 1 << 30; pg8::gemm_phase<pg8::EpiIn8, pg8::LocalWindow, true, true>(F.lds, g, S, E);
        }
        LSEAM(pb + 0);
        if (((PHMASK >> 2) & 1) && IN(pb + 1)) REPS(2) { PH_PTRS unsigned char* lw = ws + WS_LW + (size_t)l * LW_SIZE; (void)lw;
            FOR_OWNED(b) for (int j = (int)F.xrank; j < 128; j += (int)F.nloc) {
                if (j < 64) attn_unit(F, b, j >> 2, j & 3, Qb, KBb, VTb, ATT, INP(12) + l * NQH);
                else s5_unit(F, b, j - 64, Ub, (const bf16*)(lw + LW_S5K), (const bf16*)(lw + LW_S5ME), (const bf16*)(lw + LW_S5MC), (const float*)(lw + LW_S5LAM), INP(10) + l * SSMW, Zb);
            }
        }
        LSEAM(pb + 1);
        if (((PHMASK >> 3) & 1) && IN(pb + 2)) REPS(3) { PH_PTRS unsigned char* lw = ws + WS_LW + (size_t)l * LW_SIZE; (void)lw;
            pg8::Gemm g{Zb, (const bf16*)(lw + LW_WGLU), M, 2 * SSMW, SSMW}; pg8::LocalOrder S; S.init(2 * SSMW, (int)F.nloc, (int)F.xrank, (int)F.xi, (int)F.nx);
            pg8::EpiGlu E{SSb, SSMW};
            pg8::gemm_phase<pg8::EpiGlu, pg8::LocalOrder, true, true>(F.lds, g, S, E);
        }
        LSEAM(pb + 2);
        if (IN(pb + 3)) { PH_PTRS FOR_OWNED(b) for (int m = b * SEQ + wl; m < (b + 1) * SEQ; m += NWL) { quant_bf16_row<4>(ATT + (size_t)m * ATTW, ATT8 + (size_t)m * ATTW, ATS + m, lane_); quant_bf16_row<2>(SSb + (size_t)m * SSMW, SS8 + (size_t)m * SSMW, SSS + m, lane_); } }
        LSEAM(pb + 3);
        if (((PHMASK >> 4) & 1) && IN(pb + 4)) REPS(4) { PH_PTRS unsigned char* lw = ws + WS_LW + (size_t)l * LW_SIZE; (void)lw;
            { pg8::Gemm g{(const bf16*)ATT8, (const bf16*)(lw + LW_WAB), M, DM, ATTW / 2}; pg8::LocalOrder S; S.init(DM, (int)F.nloc, (int)F.xrank, (int)F.xi, (int)F.nx); pg8::EpiGate8<false> E{MG, GA, DM, ATS, (const float*)(lw + LW_WABS)};
              pg8::gemm_phase<pg8::EpiGate8<false>, pg8::LocalOrder, true, true>(F.lds, g, S, E); }
            { pg8::Gemm g{(const bf16*)SS8, (const bf16*)(lw + LW_WSB), M, DM, SSMW / 2}; pg8::LocalOrder S; S.init(DM, (int)F.nloc, (int)F.xrank, (int)F.xi, (int)F.nx); pg8::EpiGate8<true> E{MG, GS, DM, SSS, (const float*)(lw + LW_WSBS)};
              pg8::gemm_phase<pg8::EpiGate8<true>, pg8::LocalOrder, true, true>(F.lds, g, S, E); }
        }
        LSEAM(pb + 4);
        if (IN(pb + 5)) { PH_PTRS FOR_OWNED(b) for (int m = b * SEQ + wl; m < (b + 1) * SEQ; m += NWL) quant_bf16_row<8>(MG + (size_t)m * DM, MG8 + (size_t)m * DM, MGS + m, lane_); }
        LSEAM(pb + 5);
        if (((PHMASK >> 5) & 1) && IN(pb + 6)) REPS(5) { PH_PTRS unsigned char* lw = ws + WS_LW + (size_t)l * LW_SIZE; (void)lw;
            pg8::Gemm g{(const bf16*)MG8, (const bf16*)(lw + LW_WOUT), M, DM, DM / 2}; pg8::LocalOrder S; S.init(DM, (int)F.nloc, (int)F.xrank, (int)F.xi, (int)F.nx);
            pg8::EpiRes8 E{l == 0 ? INP(0) : (const float*)nullptr, XB, DRY ? GA : XB, DM, MGS, (const float*)(lw + LW_WOUTS)};
            pg8::gemm_phase<pg8::EpiRes8, pg8::LocalOrder, true, true>(F.lds, g, S, E);
        }
        LSEAM(pb + 6);
        if (((PHMASK >> 6) & 1) && IN(pb + 7)) REPS(6) { PH_PTRS unsigned char* lw = ws + WS_LW + (size_t)l * LW_SIZE; (void)lw; FOR_OWNED(b) for (int m = b * SEQ + wl; m < (b + 1) * SEQ; m += NWL) rms_row16_to_i8(XB + (size_t)m * DM, INP(16) + l * DM, HN8 + (size_t)m * DM, HS + m, lane_); }
        LSEAM(pb + 7);
        if (((PHMASK >> 7) & 1) && IN(pb + 8)) REPS(7) { PH_PTRS unsigned char* lw = ws + WS_LW + (size_t)l * LW_SIZE; (void)lw;
            pg8::Gemm g{(const bf16*)HN8, (const bf16*)(lw + LW_WPQ), M, PH * PDK, DM / 2}; pg8::LocalOrder S; S.init(PH * PDK, (int)F.nloc, (int)F.xrank, (int)F.xi, (int)F.nx);
            pg8::EpiBf16Plain8 E{PQ, PH * PDK, HS, (const float*)(lw + LW_WPQS)};
            pg8::gemm_phase<pg8::EpiBf16Plain8, pg8::LocalOrder, true, true>(F.lds, g, S, E);
        }
        LSEAM(pb + 8);
        if (((PHMASK >> 8) & 1) && IN(pb + 9)) REPS(8) { PH_PTRS unsigned char* lw = ws + WS_LW + (size_t)l * LW_SIZE; (void)lw; FOR_OWNED(b) for (int tl = wl; tl < (SEQ / 32) * PH; tl += NWL) topk_task((b * (SEQ / 32) + (tl >> 3)) * PH + (tl & 7), lane_, PQ, (const bf16*)(lw + LW_KEYS), EID, GATE, F.lds + F.wave * 2304); }
        LSEAM(pb + 9);
        if (IN(pb + 10)) { PH_PTRS FOR_OWNED(b) for (int it = (int)F.xrank; it < (SEQ / PTILE) * SORT_SPLIT; it += (int)F.nloc) sort_tile(F, b * (SEQ / PTILE) * SORT_SPLIT + it, EID, PAIRS); }
        if (use_bar && threadIdx.x == 0) XB_SPIN(xb_ld((unsigned*)F.ctl + CW_CONV + 64 * l) < (unsigned)F.G, bar.bar);
        LSEAM(pb + 10);
        if (IN(pb + 11)) { PH_PTRS unsigned char* lw = ws + WS_LW + (size_t)l * LW_SIZE;
            const unsigned nW = (unsigned)NWL, chunk = (PPAIRS + nW - 1) / nW, wv = (unsigned)wl;
            FOR_OWNED(b) for (int tile = b * (SEQ / PTILE); tile < (b + 1) * (SEQ / PTILE); ++tile) { const unsigned c0 = wv * chunk, c1 = (c0 + chunk < (unsigned)PPAIRS) ? c0 + chunk : (unsigned)PPAIRS;
                if (c0 < c1) uphase_chunk(tile, c0, c1, lane_, PAIRS, (const i8*)(lw + LW_UTAB), HN8, SC); }
        }
        LSEAM(pb + 11);
        if (((PHMASK >> 9) & 1) && IN(pb + 12)) REPS(9) { PH_PTRS unsigned char* lw = ws + WS_LW + (size_t)l * LW_SIZE; (void)lw;
            if (l + 1 < DEPTH) { FOR_OWNED(b) for (int m = b * SEQ + wl; m < (b + 1) * SEQ; m += NWL) gather_token<false>((size_t)m, lane_, SC, HS, EID, GATE, (const float*)(lw + LW_SU), (const i8*)(lw + LW_VTAB), (const float*)(lw + LW_SV), (const i8*)(lw + LW_VT4), (const float*)(lw + LW_S4), XB, DRY ? GA : XB, X, INP(1) + (l + 1) * DM, DRY ? (i8*)MG : XN8, DRY ? (float*)Zb : XS); }
            else { FOR_OWNED(b) for (int m = b * SEQ + wl; m < (b + 1) * SEQ; m += NWL) gather_token<true>((size_t)m, lane_, SC, HS, EID, GATE, (const float*)(lw + LW_SU), (const i8*)(lw + LW_VTAB), (const float*)(lw + LW_SV), (const i8*)(lw + LW_VT4), (const float*)(lw + LW_S4), XB, XB, DRY ? (float*)GA : X, INP(21), XN8, XS); }
        }
        LSEAM(pb + 12);
    }
#undef IN
#undef SEAM
}

extern "C" void kernel_launch(void* const* d_in, const int* in_sizes, int n_in, void* d_out, int out_size, void* d_ws, size_t ws_size, hipStream_t stream) {
    static int grid = 0;
    if (grid == 0) {
        if (n_in != 22 || out_size != M * DM || ws_size < WS_END) { fprintf(stderr, "kernel_launch: unexpected shapes (n_in %d out %d ws %zu)\n", n_in, out_size, ws_size); grid = -1; return; }
        int dev = 0, cus = 0, per_cu = 0;
        if (hipGetDevice(&dev) != hipSuccess || hipDeviceGetAttribute(&cus, hipDeviceAttributeMultiprocessorCount, dev) != hipSuccess) { grid = -1; return; }
        if (hipFuncSetAttribute((const void*)hybrid_fwd, hipFuncAttributeMaxDynamicSharedMemorySize, LDS_BYTES) != hipSuccess) { fprintf(stderr, "kernel_launch: hipFuncSetAttribute failed\n"); grid = -1; return; }
        if (hipOccupancyMaxActiveBlocksPerMultiprocessor(&per_cu, (const void*)hybrid_fwd, NWAVES * 64, LDS_BYTES) != hipSuccess || per_cu < 1) fprintf(stderr, "kernel_launch: occupancy query says %d\n", per_cu);
        (void)hipGetLastError();
        grid = cus;
    }
    if (grid < 0) return;
    if (hipMemsetAsync((char*)d_ws + WS_CTL, 0, CTL_ZERO_BYTES, stream) != hipSuccess) return;
    Args a{};
    for (int i = 0; i < 22; ++i) a.in[i] = (const float*)d_in[i];
    a.out = (float*)d_out; a.ws = (unsigned char*)d_ws; a.dup = 0; a.pad = 0;
#if MK_ONE_LAUNCH
    a.ph_lo = 0; a.ph_hi = NPHASES;
    hipLaunchKernelGGL(hybrid_fwd, dim3(grid), dim3(NWAVES * 64), LDS_BYTES, stream, a);
#else
    for (int p = 0; p < NPHASES; ++p) { a.ph_lo = p; a.ph_hi = p + 1;
        const int k = p < NPH_PRO ? 0 : 1 + (p - NPH_PRO) % NPH_LAYER; if (p == 0 && k == 0) { hipLaunchKernelGGL(hybrid_fwd, dim3(grid), dim3(NWAVES * 64), LDS_BYTES, stream, a); continue; }
        if ((DUPMASK >> k) & 1) { a.dup = 1; hipLaunchKernelGGL(hybrid_fwd, dim3(grid), dim3(NWAVES * 64), LDS_BYTES, stream, a); a.dup = 0; }
        hipLaunchKernelGGL(hybrid_fwd, dim3(grid), dim3(NWAVES * 64), LDS_BYTES, stream, a); }
#endif
}
```

```cpp
#include <hip/hip_runtime.h>
#include <cstdio>
#include <cstdint>
namespace pg8 {
#define PG8_LAS __attribute__((address_space(3)))
typedef unsigned short bf16_t;
typedef short bf16x8 __attribute__((ext_vector_type(8)));
typedef float f32x4 __attribute__((ext_vector_type(4)));
typedef unsigned u32x4 __attribute__((ext_vector_type(4)));
typedef int i32x4 __attribute__((ext_vector_type(4)));
constexpr int BM = 256, BK = 64, HALF = 128, HTB = HALF * BK * 2  , STAGE_BYTES = 8 * HTB, NXCD = 8, WGM = 4;

__host__ __device__ __forceinline__ int lds_byte(int r, int c) { const int st = (r >> 4) * 2 + (c >> 5), rr = r & 15, cc = c & 31, ob = rr * 64 + cc * 2; return st * 1024 + (ob ^ (((ob >> 9) & 1) << 5)); }
__host__ __device__ __forceinline__ void stage_rc(int b, int& R, int& C) { const int st = b / 1024, sb = b % 1024, swz = sb ^ (((sb >> 9) & 1) << 5); R = (st >> 1) * 16 + swz / 64; C = (st & 1) * 32 + (swz % 64) / 2; }
__host__ __device__ __forceinline__ int perm32(int rho) { const int n = rho >> 4, i = rho & 15; return 8 * (i >> 2) + 4 * n + (i & 3); }

struct Unit { int pm, pn; };
struct Gemm { const bf16_t* A; const bf16_t* Bt; int M, N, K; };

struct StaticOrder {
    int nM, nN, nwg, G, c;
    __host__ __device__ void init(int M, int N, int G_, int c_) { nM = M / BM; nN = N / BM; nwg = nM * nN; G = G_; c = c_; }
    __host__ __device__ bool next(int i, Unit& u) const {
        const long L = (long)i * G + c; if (L >= nwg) return false;
        int wgid = (int)L; { const int q = nwg / NXCD, r = nwg % NXCD, xcd = wgid % NXCD, off = wgid / NXCD; wgid = (xcd < r ? xcd * (q + 1) : r * (q + 1) + (xcd - r) * q) + off; }
        const int nig = WGM * nN, gid = wgid / nig, fm = gid * WGM, gsz = (nM - fm) < WGM ? (nM - fm) : WGM;
        u.pm = fm + ((wgid % nig) % gsz); u.pn = (wgid % nig) / gsz; return true;
    }
    __device__ __forceinline__ void a_ready(const Unit&) const {}
    __device__ __forceinline__ void done(const Unit&) const {}
};
struct LocalOrder {
    int nN, nloc, rank, xi, nx, nbo;
    __host__ __device__ void init(int N, int nloc_, int rank_, int xi_, int nx_) { nN = N / BM; nloc = nloc_; rank = rank_; xi = xi_; nx = nx_; nbo = (8 - xi + nx - 1) / nx; }
    __host__ __device__ bool next(int i, Unit& u) const {
        const int per = 8 * nN, j = i * nloc + rank; if (j >= nbo * per) return false;
        const int bi = j / per, jj = j % per, b = xi + bi * nx;
        const int nig = WGM * nN, gid = jj / nig, fm = gid * WGM;
        u.pm = 8 * b + fm + (jj % nig) % WGM; u.pn = (jj % nig) / WGM; return true;
    }
    __device__ __forceinline__ void a_ready(const Unit&) const {}
    __device__ __forceinline__ void done(const Unit&) const {}
};
struct LocalWindow : LocalOrder {
    int lo, hi;
    __host__ __device__ bool next(int i, Unit& u) const { return (i + lo < hi) && LocalOrder::next(i + lo, u); }
};

__device__ __forceinline__ unsigned cvt_pk_bf16(float lo, float hi) { unsigned r; asm volatile("v_cvt_pk_bf16_f32 %0, %1, %2" : "=v"(r) : "v"(lo), "v"(hi)); return r; }
__device__ __forceinline__ float bflo(unsigned w) { return __uint_as_float(w << 16); }
__device__ __forceinline__ float bfhi(unsigned w) { return __uint_as_float(w & 0xffff0000u); }
__device__ __forceinline__ float sigmoidf_fast(float x) { return __builtin_amdgcn_rcpf(1.0f + __expf(-x)); }
__device__ __forceinline__ u32x4 pack8(const f32x4 v0, const f32x4 v1) { u32x4 w; w.x = cvt_pk_bf16(v0[0], v0[1]); w.y = cvt_pk_bf16(v0[2], v0[3]); w.z = cvt_pk_bf16(v1[0], v1[1]); w.w = cvt_pk_bf16(v1[2], v1[3]); return w; }

struct EpiBf16Plain {
    static constexpr bool PERM = true, AFTER_DRAIN = false, I8 = false; typedef f32x4 acc_t;
    bf16_t* O; int ldc;
    __device__ __forceinline__ void operator()(const f32x4 (&acc)[2][2][4][2], const Unit& u, int wr, int wc, int fr, int fq) const {
        const int row0 = u.pm * BM + wr * 64 + fr, col0 = u.pn * BM + wc * 32 + 8 * fq;
#pragma unroll
        for (int ai = 0; ai < 2; ++ai)
#pragma unroll
            for (int m = 0; m < 4; ++m) { bf16_t* rowp = O + (size_t)(row0 + ai * HALF + m * 16) * ldc + col0;
#pragma unroll
                for (int bj = 0; bj < 2; ++bj) *(u32x4*)(rowp + bj * HALF) = pack8(acc[ai][bj][m][0], acc[ai][bj][m][1]); }
    }
};
struct EpiBf16Plain8 {
    static constexpr bool PERM = true, AFTER_DRAIN = false, I8 = true; typedef i32x4 acc_t;
    bf16_t* O; int ldc; const float *xs, *wsc;
    __device__ __forceinline__ void operator()(const i32x4 (&acc)[2][2][4][2], const Unit& u, int wr, int wc, int fr, int fq) const {
        const int row0 = u.pm * BM + wr * 64 + fr, col0 = u.pn * BM + wc * 32 + 8 * fq;
#pragma unroll
        for (int ai = 0; ai < 2; ++ai)
#pragma unroll
            for (int m = 0; m < 4; ++m) { bf16_t* rowp = O + (size_t)(row0 + ai * HALF + m * 16) * ldc + col0; const float rs = xs[row0 + ai * HALF + m * 16];
#pragma unroll
                for (int bj = 0; bj < 2; ++bj) { const f32x4 c0 = *(const f32x4*)(wsc + col0 + bj * HALF), c1 = *(const f32x4*)(wsc + col0 + bj * HALF + 4); f32x4 v0, v1;
#pragma unroll
                    for (int i = 0; i < 4; ++i) { v0[i] = (float)acc[ai][bj][m][0][i] * (rs * c0[i]); v1[i] = (float)acc[ai][bj][m][1][i] * (rs * c1[i]); }
                    *(u32x4*)(rowp + bj * HALF) = pack8(v0, v1); } }
    }
};
struct EpiIn {
    static constexpr bool PERM = true, AFTER_DRAIN = false, I8 = false; typedef f32x4 acc_t;
    bf16_t *Q, *KB, *VT, *U, *GA, *GS;
    __device__ __forceinline__ void operator()(const f32x4 (&acc)[2][2][4][2], const Unit& u, int wr, int wc, int fr, int fq) const {
        const int row0 = u.pm * BM + wr * 64 + fr, colw = wc * 32 + 8 * fq; const int pn = u.pn;
        if (pn >= 10 && pn < 12) {
#pragma unroll
            for (int ai = 0; ai < 2; ++ai)
#pragma unroll
                for (int m = 0; m < 4; ++m) { const int row = row0 + ai * HALF + m * 16; const int b = row >> 11, s = row & 2047;
#pragma unroll
                    for (int bj = 0; bj < 2; ++bj) { const int vcol = (pn - 10) * 256 + bj * HALF + colw;
                        bf16_t* base = VT + ((size_t)((b * 4 + (vcol >> 7)) * 128 + (vcol & 127))) * 2048 + s;
#pragma unroll
                        for (int n = 0; n < 2; ++n)
#pragma unroll
                            for (int i = 0; i < 4; ++i) { const unsigned w = cvt_pk_bf16(acc[ai][bj][m][n][i], 0.f); base[(size_t)(4 * n + i) * 2048] = (bf16_t)(w & 0xffffu); } } }
            return;
        }
        bf16_t* O; int ldc, colt; int mode;
        if (pn < 8) { O = Q; ldc = 2048; colt = pn * 256; mode = 1; }
        else if (pn < 10) { O = KB; ldc = 512; colt = (pn - 8) * 256; mode = 0; }
        else if (pn < 16) { O = U; ldc = 1024; colt = (pn - 12) * 256; mode = 0; }
        else if (pn < 32) { O = GA; ldc = 4096; colt = (pn - 16) * 256; mode = 2; }
        else { O = GS; ldc = 4096; colt = (pn - 32) * 256; mode = 2; }
        const float sc = (mode == 1) ? 0.08838834764831845f : 1.0f;
#pragma unroll
        for (int ai = 0; ai < 2; ++ai)
#pragma unroll
            for (int m = 0; m < 4; ++m) { bf16_t* rowp = O + (size_t)(row0 + ai * HALF + m * 16) * ldc + colt + colw;
#pragma unroll
                for (int bj = 0; bj < 2; ++bj) { f32x4 v0 = acc[ai][bj][m][0], v1 = acc[ai][bj][m][1];
                    if (mode == 2) {
#pragma unroll
                        for (int i = 0; i < 4; ++i) { v0[i] = sigmoidf_fast(v0[i]); v1[i] = sigmoidf_fast(v1[i]); } }
                    else { v0 = v0 * sc; v1 = v1 * sc; }
                    *(u32x4*)(rowp + bj * HALF) = pack8(v0, v1); } }
    }
};
struct EpiIn8 {
    static constexpr bool PERM = true, AFTER_DRAIN = false, I8 = true; typedef i32x4 acc_t;
    bf16_t *Q, *KB, *VT, *U, *GA, *GS; const float *xs, *wsc;
    __device__ __forceinline__ void operator()(const i32x4 (&acc)[2][2][4][2], const Unit& u, int wr, int wc, int fr, int fq) const {
        const int row0 = u.pm * BM + wr * 64 + fr, colw = wc * 32 + 8 * fq; const int pn = u.pn;
        if (pn >= 10 && pn < 12) {
#pragma unroll
            for (int ai = 0; ai < 2; ++ai)
#pragma unroll
                for (int m = 0; m < 4; ++m) { const int row = row0 + ai * HALF + m * 16; const int b = row >> 11, s = row & 2047;
#pragma unroll
                    for (int bj = 0; bj < 2; ++bj) { const int vcol = (pn - 10) * 256 + bj * HALF + colw;
                        const float rs = xs[row]; const f32x4 c0 = *(const f32x4*)(wsc + pn * 256 + bj * HALF + colw), c1 = *(const f32x4*)(wsc + pn * 256 + bj * HALF + colw + 4);
                        bf16_t* base = VT + ((size_t)((b * 4 + (vcol >> 7)) * 128 + (vcol & 127))) * 2048 + s;
#pragma unroll
                        for (int n = 0; n < 2; ++n)
#pragma unroll
                            for (int i = 0; i < 4; ++i) { const unsigned w = cvt_pk_bf16((float)acc[ai][bj][m][n][i] * rs * (n ? c1[i] : c0[i]), 0.f); base[(size_t)(4 * n + i) * 2048] = (bf16_t)(w & 0xffffu); } } }
            return;
        }
        bf16_t* O; int ldc, colt; int mode;
        if (pn < 8) { O = Q; ldc = 2048; colt = pn * 256; mode = 1; }
        else if (pn < 10) { O = KB; ldc = 512; colt = (pn - 8) * 256; mode = 0; }
        else if (pn < 16) { O = U; ldc = 1024; colt = (pn - 12) * 256; mode = 0; }
        else if (pn < 32) { O = GA; ldc = 4096; colt = (pn - 16) * 256; mode = 2; }
        else { O = GS; ldc = 4096; colt = (pn - 32) * 256; mode = 2; }
        const float sc = (mode == 1) ? 0.08838834764831845f : 1.0f;
#pragma unroll
        for (int ai = 0; ai < 2; ++ai)
#pragma unroll
            for (int m = 0; m < 4; ++m) { bf16_t* rowp = O + (size_t)(row0 + ai * HALF + m * 16) * ldc + colt + colw; const float rs = xs[row0 + ai * HALF + m * 16];
#pragma unroll
                for (int bj = 0; bj < 2; ++bj) { const f32x4 c0 = *(const f32x4*)(wsc + pn * 256 + bj * HALF + colw), c1 = *(const f32x4*)(wsc + pn * 256 + bj * HALF + colw + 4);
                    f32x4 v0, v1;
#pragma unroll
                    for (int i = 0; i < 4; ++i) { v0[i] = (float)acc[ai][bj][m][0][i] * (rs * c0[i]); v1[i] = (float)acc[ai][bj][m][1][i] * (rs * c1[i]); }
                    if (mode == 2) {
                        unsigned w0 = 0, w1 = 0;
#pragma unroll
                        for (int i = 0; i < 4; ++i) { w0 |= (unsigned)(int)rintf(255.0f * sigmoidf_fast(v0[i])) << (8 * i); w1 |= (unsigned)(int)rintf(255.0f * sigmoidf_fast(v1[i])) << (8 * i); }
                        typedef unsigned u32x2_t __attribute__((ext_vector_type(2))); u32x2_t w; w.x = w0; w.y = w1;
                        *(u32x2_t*)((unsigned char*)O + (size_t)(row0 + ai * HALF + m * 16) * ldc + colt + colw + bj * HALF) = w; }
                    else { v0 = v0 * sc; v1 = v1 * sc; *(u32x4*)(rowp + bj * HALF) = pack8(v0, v1); } } }
    }
};
struct EpiGlu {
    static constexpr bool PERM = true, AFTER_DRAIN = false, I8 = false; typedef f32x4 acc_t;
    bf16_t* O; int ldc;
    __device__ __forceinline__ void operator()(const f32x4 (&acc)[2][2][4][2], const Unit& u, int wr, int wc, int fr, int fq) const {
        const int row0 = u.pm * BM + wr * 64 + fr, col0 = u.pn * HALF + wc * 32 + 8 * fq;
#pragma unroll
        for (int ai = 0; ai < 2; ++ai)
#pragma unroll
            for (int m = 0; m < 4; ++m) { f32x4 v0 = acc[ai][0][m][0], v1 = acc[ai][0][m][1]; const f32x4 g0 = acc[ai][1][m][0], g1 = acc[ai][1][m][1];
#pragma unroll
                for (int i = 0; i < 4; ++i) { v0[i] *= sigmoidf_fast(g0[i]); v1[i] *= sigmoidf_fast(g1[i]); }
                *(u32x4*)(O + (size_t)(row0 + ai * HALF + m * 16) * ldc + col0) = pack8(v0, v1); }
    }
};
template <bool ADD> struct EpiGate {
    static constexpr bool PERM = true, AFTER_DRAIN = false, I8 = false; typedef f32x4 acc_t;
    bf16_t* O; const bf16_t* G; int ldc;
    __device__ __forceinline__ void operator()(const f32x4 (&acc)[2][2][4][2], const Unit& u, int wr, int wc, int fr, int fq) const {
        const int row0 = u.pm * BM + wr * 64 + fr, col0 = u.pn * BM + wc * 32 + 8 * fq;
#pragma unroll
        for (int ai = 0; ai < 2; ++ai)
#pragma unroll
            for (int m = 0; m < 4; ++m) { const size_t off = (size_t)(row0 + ai * HALF + m * 16) * ldc + col0;
#pragma unroll
                for (int bj = 0; bj < 2; ++bj) { const u32x4 g = *(const u32x4*)(G + off + bj * HALF); f32x4 v0 = acc[ai][bj][m][0], v1 = acc[ai][bj][m][1];
                    v0[0] *= bflo(g.x); v0[1] *= bfhi(g.x); v0[2] *= bflo(g.y); v0[3] *= bfhi(g.y); v1[0] *= bflo(g.z); v1[1] *= bfhi(g.z); v1[2] *= bflo(g.w); v1[3] *= bfhi(g.w);
                    if (ADD) { const u32x4 o = *(const u32x4*)(O + off + bj * HALF);
                        v0[0] += bflo(o.x); v0[1] += bfhi(o.x); v0[2] += bflo(o.y); v0[3] += bfhi(o.y); v1[0] += bflo(o.z); v1[1] += bfhi(o.z); v1[2] += bflo(o.w); v1[3] += bfhi(o.w); }
                    *(u32x4*)(O + off + bj * HALF) = pack8(v0, v1); }
                asm volatile("" ::: "memory"); }
    }
};
template <bool ADD> struct EpiGate8 {
    static constexpr bool PERM = true, AFTER_DRAIN = false, I8 = true; typedef i32x4 acc_t;
    bf16_t* O; const bf16_t* G; int ldc; const float *xs, *wsc;
    __device__ __forceinline__ void operator()(const i32x4 (&acc)[2][2][4][2], const Unit& u, int wr, int wc, int fr, int fq) const {
        const int row0 = u.pm * BM + wr * 64 + fr, col0 = u.pn * BM + wc * 32 + 8 * fq;
        f32x4 cs[2][2];
#pragma unroll
        for (int bj = 0; bj < 2; ++bj) { cs[bj][0] = *(const f32x4*)(wsc + col0 + bj * HALF); cs[bj][1] = *(const f32x4*)(wsc + col0 + bj * HALF + 4); }
        typedef unsigned u32x2_t __attribute__((ext_vector_type(2))); const unsigned char* G8 = (const unsigned char*)G;
        u32x2_t gcur[2], gnxt[2]; u32x4 ocur[2], onxt[2]; float rcur, rnxt;
        { const size_t off = (size_t)row0 * ldc + col0; gcur[0] = *(const u32x2_t*)(G8 + off); gcur[1] = *(const u32x2_t*)(G8 + off + HALF); if (ADD) { ocur[0] = *(const u32x4*)(O + off); ocur[1] = *(const u32x4*)(O + off + HALF); } rcur = xs[row0]; }
#pragma unroll
        for (int it = 0; it < 8; ++it) { const int ai = it >> 2, m = it & 3; const size_t off = (size_t)(row0 + ai * HALF + m * 16) * ldc + col0;
            if (it + 1 < 8) { const int ai2 = (it + 1) >> 2, m2 = (it + 1) & 3; const int r2 = row0 + ai2 * HALF + m2 * 16; const size_t off2 = (size_t)r2 * ldc + col0;
                gnxt[0] = *(const u32x2_t*)(G8 + off2); gnxt[1] = *(const u32x2_t*)(G8 + off2 + HALF); if (ADD) { onxt[0] = *(const u32x4*)(O + off2); onxt[1] = *(const u32x4*)(O + off2 + HALF); } rnxt = xs[r2]; }
            asm volatile("" ::: "memory");
#pragma unroll
            for (int bj = 0; bj < 2; ++bj) { const u32x2_t g = gcur[bj]; f32x4 v0, v1; constexpr float k255 = 1.0f / 255.0f;
#pragma unroll
                for (int i = 0; i < 4; ++i) { v0[i] = (float)acc[ai][bj][m][0][i] * (rcur * cs[bj][0][i]); v1[i] = (float)acc[ai][bj][m][1][i] * (rcur * cs[bj][1][i]); }
#pragma unroll
                for (int i = 0; i < 4; ++i) { v0[i] *= (float)((g.x >> (8 * i)) & 0xffu) * k255; v1[i] *= (float)((g.y >> (8 * i)) & 0xffu) * k255; }
                if (ADD) { const u32x4 o = ocur[bj];
                    v0[0] += bflo(o.x); v0[1] += bfhi(o.x); v0[2] += bflo(o.y); v0[3] += bfhi(o.y); v1[0] += bflo(o.z); v1[1] += bfhi(o.z); v1[2] += bflo(o.w); v1[3] += bfhi(o.w); }
                *(u32x4*)(O + off + bj * HALF) = pack8(v0, v1); }
            asm volatile("" ::: "memory");
            if (it + 1 < 8) { gcur[0] = gnxt[0]; gcur[1] = gnxt[1]; if (ADD) { ocur[0] = onxt[0]; ocur[1] = onxt[1]; } rcur = rnxt; }
        }
    }
};
struct EpiRes8 {
    static constexpr bool PERM = true, AFTER_DRAIN = false, I8 = true; typedef i32x4 acc_t;
    const float* base32; const bf16_t* base16; bf16_t* out; int ldc; const float *xs, *wsc;
    __device__ __forceinline__ void operator()(const i32x4 (&acc)[2][2][4][2], const Unit& u, int wr, int wc, int fr, int fq) const {
        const int row0 = u.pm * BM + wr * 64 + fr, col0 = u.pn * BM + wc * 32 + 8 * fq;
        f32x4 cs[2][2];
#pragma unroll
        for (int bj = 0; bj < 2; ++bj) { cs[bj][0] = *(const f32x4*)(wsc + col0 + bj * HALF); cs[bj][1] = *(const f32x4*)(wsc + col0 + bj * HALF + 4); }
#pragma unroll
        for (int ai = 0; ai < 2; ++ai)
#pragma unroll
            for (int m = 0; m < 4; ++m) { const size_t off = (size_t)(row0 + ai * HALF + m * 16) * ldc + col0; const float rs = xs[row0 + ai * HALF + m * 16];
#pragma unroll
                for (int bj = 0; bj < 2; ++bj) { f32x4 b0, b1;
                    if (base32) { b0 = *(const f32x4*)(base32 + off + bj * HALF); b1 = *(const f32x4*)(base32 + off + bj * HALF + 4); }
                    else { const u32x4 t = *(const u32x4*)(base16 + off + bj * HALF); b0 = (f32x4){bflo(t.x), bfhi(t.x), bflo(t.y), bfhi(t.y)}; b1 = (f32x4){bflo(t.z), bfhi(t.z), bflo(t.w), bfhi(t.w)}; }
                    f32x4 v0, v1;
#pragma unroll
                    for (int i = 0; i < 4; ++i) { v0[i] = b0[i] + (float)acc[ai][bj][m][0][i] * (rs * cs[bj][0][i]); v1[i] = b1[i] + (float)acc[ai][bj][m][1][i] * (rs * cs[bj][1][i]); }
                    *(u32x4*)(out + off + bj * HALF) = pack8(v0, v1); } }
    }
};
struct EpiRes {
    static constexpr bool PERM = false, AFTER_DRAIN = false, I8 = false; typedef f32x4 acc_t;
    const float* base; float* out; int ldc;
    __device__ __forceinline__ void operator()(const f32x4 (&acc)[2][2][4][2], const Unit& u, int wr, int wc, int fr, int fq) const {
        const int row0 = u.pm * BM + wr * 64 + fr, col0 = u.pn * BM + wc * 32 + 4 * fq;
#pragma unroll
        for (int ai = 0; ai < 2; ++ai)
#pragma unroll
            for (int m = 0; m < 4; ++m) { const size_t off = (size_t)(row0 + ai * HALF + m * 16) * ldc + col0;
#pragma unroll
                for (int bj = 0; bj < 2; ++bj)
#pragma unroll
                    for (int n = 0; n < 2; ++n) { const f32x4 bs = *(const f32x4*)(base + off + bj * HALF + n * 16); *(f32x4*)(out + off + bj * HALF + n * 16) = bs + acc[ai][bj][m][n]; } }
    }
};

__device__ __forceinline__ f32x4 mma16(const bf16x8& b, const bf16x8& a, const f32x4& c) { return __builtin_amdgcn_mfma_f32_16x16x32_bf16(b, a, c, 0, 0, 0); }
__device__ __forceinline__ i32x4 mma16(const bf16x8& b, const bf16x8& a, const i32x4& c) { return __builtin_amdgcn_mfma_i32_16x16x64_i8(__builtin_bit_cast(i32x4, b), __builtin_bit_cast(i32x4, a), c, 0, 0, 0); }
template <class Epi, class Sched, bool ALIGN_EPI = false, bool SP2 = false>
__device__ __forceinline__ void gemm_phase(PG8_LAS unsigned char* lds, const Gemm g, const Sched& S, const Epi& E) {
    int tid = threadIdx.x; asm volatile("" : "+v"(tid));
    const int wid = __builtin_amdgcn_readfirstlane(tid >> 6), lane = tid & 63, wr = wid >> 2, wc = wid & 3, fr = lane & 15, fq = lane >> 4;
    const int K = g.K, nt = K / BK;
    unsigned voffA[2], voffB[2];
#pragma unroll
    for (int i = 0; i < 2; ++i) { int R, C; stage_rc(tid * 16 + i * 8192, R, C); const int Rb = Epi::PERM ? ((R & ~31) + perm32(R & 31)) : R;
        voffA[i] = (unsigned)(R * K + C) * 2u; voffB[i] = (unsigned)(Rb * K + C) * 2u; }
    const size_t kstep = (size_t)(BK * 2);
    const size_t hstep = (size_t)HALF * K * 2;
    const size_t tstep = 2 * hstep;
    const unsigned ldsw = (unsigned)wid * 1024u;
    const int aoff = lds_byte(wr * 64 + fr, fq * 8), boff = lds_byte(wc * 32 + fr, fq * 8);
#define PG8_SA(b, h) (((b) * 2 + (h)) * HTB)
#define PG8_SB(b, h) ((4 + (b) * 2 + (h)) * HTB)
#define PG8_STAGE(bufoff, gbase, voff) do { _Pragma("unroll") for (int _i = 0; _i < 2; ++_i) \
        __builtin_amdgcn_global_load_lds((const unsigned*)((const char*)(gbase) + (voff)[_i]), (PG8_LAS unsigned*)(lds + (bufoff) + ldsw + _i * 8192), 16, 0, 0); } while (0)
#define PG8_LDA(dst, b, h) do { _Pragma("unroll") for (int m = 0; m < 4; ++m) _Pragma("unroll") for (int k = 0; k < 2; ++k) dst[m][k] = *(const PG8_LAS bf16x8*)(lds + PG8_SA(b, h) + aoff + m * 2048 + k * 1024); } while (0)
#define PG8_LDB(dst, b, h) do { _Pragma("unroll") for (int n = 0; n < 2; ++n) _Pragma("unroll") for (int k = 0; k < 2; ++k) dst[n][k] = *(const PG8_LAS bf16x8*)(lds + PG8_SB(b, h) + boff + n * 2048 + k * 1024); } while (0)
#define PG8_MMA(ai, bj, At, Bt) do { __builtin_amdgcn_s_setprio(1); _Pragma("unroll") for (int m = 0; m < 4; ++m) _Pragma("unroll") for (int n = 0; n < 2; ++n) _Pragma("unroll") for (int k = 0; k < 2; ++k) \
        acc[ai][bj][m][n] = mma16(Bt[n][k], At[m][k], acc[ai][bj][m][n]); __builtin_amdgcn_s_setprio(0); } while (0)
#define PG8_WAIT_V(n) asm volatile("s_waitcnt vmcnt(" #n ")" ::: "memory")
#define PG8_WAIT_L(n) asm volatile("s_waitcnt lgkmcnt(" #n ")" ::: "memory")
#define PG8_BAR __builtin_amdgcn_s_barrier()
#define PG8_SCHED __builtin_amdgcn_sched_barrier(0)
    Unit cur, nxt; int ui = 0;
    if (!S.next(0, cur)) return;
    typedef typename Epi::acc_t acc_t; acc_t acc[2][2][4][2];
#pragma unroll
    for (int a = 0; a < 2; ++a)
#pragma unroll
        for (int b = 0; b < 2; ++b)
#pragma unroll
            for (int m = 0; m < 4; ++m)
#pragma unroll
                for (int n = 0; n < 2; ++n) acc[a][b][m][n] = acc_t{};
    bf16x8 At[4][2], B0[2][2], B1[2][2];
    const char* cA = (const char*)g.A + (size_t)cur.pm * tstep; const char* cB = (const char*)g.Bt + (size_t)cur.pn * tstep;
    S.a_ready(cur);
    if constexpr (SP2) {
        PG8_STAGE(PG8_SB(0, 0), cB, voffB); PG8_STAGE(PG8_SB(0, 1), cB + hstep, voffB); PG8_STAGE(PG8_SA(0, 0), cA, voffA); PG8_STAGE(PG8_SA(0, 1), cA + hstep, voffA);
        if (wr == 1) PG8_BAR;
        PG8_WAIT_V(2); PG8_BAR;
        PG8_STAGE(PG8_SB(1, 0), cB + kstep, voffB); PG8_STAGE(PG8_SA(1, 0), cA + kstep, voffA); PG8_STAGE(PG8_SB(1, 1), cB + hstep + kstep, voffB);
        PG8_WAIT_V(6); PG8_BAR;
    } else {
        PG8_STAGE(PG8_SB(0, 0), cB, voffB); PG8_STAGE(PG8_SA(0, 0), cA, voffA); PG8_STAGE(PG8_SB(0, 1), cB + hstep, voffB); PG8_STAGE(PG8_SA(0, 1), cA + hstep, voffA);
        if (wr == 1) PG8_BAR;
        PG8_WAIT_V(4); PG8_BAR;
        PG8_STAGE(PG8_SB(1, 0), cB + kstep, voffB); PG8_STAGE(PG8_SA(1, 0), cA + kstep, voffA); PG8_STAGE(PG8_SB(1, 1), cB + hstep + kstep, voffB);
        PG8_WAIT_V(6); PG8_BAR;
    }
    for (;;) {
        const bool has_next = S.next(ui + 1, nxt);
        const char* nA = has_next ? (const char*)g.A + (size_t)nxt.pm * tstep : cA; const char* nB = has_next ? (const char*)g.Bt + (size_t)nxt.pn * tstep : cB;
        for (int t = 0; t < nt; t += 2) {
            const bool last = (t == nt - 2);
            const char* a1 = cA + (size_t)(t + 1) * kstep;
            const char* a2 = last ? nA : cA + (size_t)(t + 2) * kstep; const char* b2 = last ? nB : cB + (size_t)(t + 2) * kstep;
            const char* a3 = a2 + kstep; const char* b3 = b2 + kstep;
            if (last && has_next) S.a_ready(nxt);
            if constexpr (SP2) {
            PG8_LDB(B0, 0, 0); PG8_LDB(B1, 0, 1); PG8_SCHED; PG8_LDA(At, 0, 0); PG8_STAGE(PG8_SA(1, 1), a1 + hstep, voffA);
            PG8_WAIT_V(8); PG8_WAIT_L(0); PG8_BAR; PG8_MMA(0, 0, At, B0); PG8_MMA(0, 1, At, B1); PG8_BAR; PG8_SCHED;
            PG8_LDA(At, 0, 1); PG8_STAGE(PG8_SB(0, 0), b2, voffB); PG8_STAGE(PG8_SB(0, 1), b2 + hstep, voffB); PG8_STAGE(PG8_SA(0, 0), a2, voffA);
            PG8_WAIT_V(8); PG8_WAIT_L(0); PG8_BAR; PG8_MMA(1, 0, At, B0); PG8_MMA(1, 1, At, B1); PG8_BAR; PG8_SCHED;
            PG8_LDB(B0, 1, 0); PG8_LDB(B1, 1, 1); PG8_SCHED; PG8_LDA(At, 1, 0); PG8_STAGE(PG8_SA(0, 1), a2 + hstep, voffA);
            PG8_WAIT_V(8); PG8_WAIT_L(0); PG8_BAR; PG8_MMA(0, 0, At, B0); PG8_MMA(0, 1, At, B1); PG8_BAR; PG8_SCHED;
            PG8_LDA(At, 1, 1); PG8_STAGE(PG8_SB(1, 0), b3, voffB); PG8_STAGE(PG8_SB(1, 1), b3 + hstep, voffB); PG8_STAGE(PG8_SA(1, 0), a3, voffA);
            PG8_WAIT_V(8); PG8_WAIT_L(0); PG8_BAR; PG8_MMA(1, 0, At, B0); PG8_MMA(1, 1, At, B1); PG8_BAR; PG8_SCHED;
            } else {
            PG8_LDB(B0, 0, 0); PG8_SCHED; PG8_LDA(At, 0, 0); PG8_STAGE(PG8_SA(1, 1), a1 + hstep, voffA);
            PG8_WAIT_L(8); PG8_BAR; PG8_WAIT_L(0); PG8_MMA(0, 0, At, B0); PG8_BAR; PG8_SCHED;
            PG8_LDB(B1, 0, 1); PG8_STAGE(PG8_SB(0, 0), b2, voffB);
            PG8_BAR; PG8_WAIT_L(0); PG8_MMA(0, 1, At, B1); PG8_BAR;
            PG8_LDA(At, 0, 1); PG8_STAGE(PG8_SA(0, 0), a2, voffA);
            PG8_BAR; PG8_WAIT_L(0); PG8_MMA(1, 0, At, B0); PG8_BAR; PG8_SCHED;
            PG8_STAGE(PG8_SB(0, 1), b2 + hstep, voffB);
            PG8_WAIT_V(6); PG8_BAR; PG8_MMA(1, 1, At, B1); PG8_BAR;
            PG8_LDB(B0, 1, 0); PG8_SCHED; PG8_LDA(At, 1, 0); PG8_STAGE(PG8_SA(0, 1), a2 + hstep, voffA);
            PG8_WAIT_L(8); PG8_BAR; PG8_WAIT_L(0); PG8_MMA(0, 0, At, B0); PG8_BAR; PG8_SCHED;
            PG8_LDB(B1, 1, 1); PG8_STAGE(PG8_SB(1, 0), b3, voffB);
            PG8_BAR; PG8_WAIT_L(0); PG8_MMA(0, 1, At, B1); PG8_BAR;
            PG8_LDA(At, 1, 1); PG8_STAGE(PG8_SA(1, 0), a3, voffA);
            PG8_BAR; PG8_WAIT_L(0); PG8_MMA(1, 0, At, B0); PG8_BAR; PG8_SCHED;
            PG8_STAGE(PG8_SB(1, 1), b3 + hstep, voffB);
            PG8_WAIT_V(6); PG8_BAR; PG8_MMA(1, 1, At, B1); PG8_BAR;
            }
        }
        if constexpr (ALIGN_EPI) { if (wr == 0) PG8_BAR; }
        if constexpr (!Epi::AFTER_DRAIN) { E(acc, cur, wr, wc, fr, fq); S.done(cur); }
        if (!has_next) break;
#pragma unroll
        for (int a = 0; a < 2; ++a)
#pragma unroll
            for (int b = 0; b < 2; ++b)
#pragma unroll
                for (int m = 0; m < 4; ++m)
#pragma unroll
                    for (int n = 0; n < 2; ++n) acc[a][b][m][n] = acc_t{};
        cur = nxt; cA = nA; cB = nB; ++ui;
        if constexpr (ALIGN_EPI) { if (wr == 1) PG8_BAR; }
    }
    PG8_WAIT_V(0);
    if constexpr (!ALIGN_EPI) { if (wr == 0) PG8_BAR; }
    PG8_BAR;
    if constexpr (Epi::AFTER_DRAIN) { E.fused(acc, cur, wr, wc, fr, fq, lds, wid, lane); S.done(cur); }
#undef PG8_SA
#undef PG8_SB
#undef PG8_STAGE
#undef PG8_LDA
#undef PG8_LDB
#undef PG8_MMA
#undef PG8_WAIT_V
#undef PG8_WAIT_L
#undef PG8_BAR
#undef PG8_SCHED
}
}

constexpr int NWAVES = 8;
constexpr int DM = 4096, BATCH = 8, SEQ = 2048, DEPTH = 2, M = BATCH * SEQ;
constexpr int HD = 128, NQH = 16, NKVH = 4, ATTW = 2048, KVW = 512, SSMW = 1024, SSMG = 64, INCOLS = 12288;
constexpr int PH = 8, PDK = 256, NKEYS = 128, NEXP = 16384, PTOPK = 16, PSEL = PH * PTOPK;
constexpr float NORM_EPS = 1e-6f;
#ifndef MK_ONE_LAUNCH
#define MK_ONE_LAUNCH 1
#endif
constexpr int NPH_LAYER = 13, NPH_PRO = 2, NPHASES = NPH_PRO + DEPTH * NPH_LAYER;

constexpr size_t MiB = 1u << 20;
constexpr size_t WS_CTL = 0, CTL_ZERO_BYTES = 1 * MiB;
constexpr size_t LW_WIN = 0, LW_WAB = 96 * MiB, LW_WSB = 112 * MiB, LW_WOUT = 120 * MiB, LW_WGLU = 152 * MiB, LW_WPQ = 156 * MiB, LW_UTAB = 172 * MiB, LW_VTAB = 300 * MiB,
                 LW_KEYS = 428 * MiB, LW_S5K = 429 * MiB, LW_S5ME = 431 * MiB, LW_S5MC = 447 * MiB, LW_S5LAM = 463 * MiB, LW_SIZE = 464 * MiB;
constexpr size_t LW_WINS = LW_WIN + 48 * MiB, LW_WABS = LW_WAB + 8 * MiB, LW_WSBS = LW_WSB + 4 * MiB, LW_WOUTS = LW_WOUT + 16 * MiB, LW_WPQS = LW_WPQ + 8 * MiB;
constexpr size_t LW_SU = LW_UTAB + 64 * MiB, LW_SV = LW_VTAB + 64 * MiB, LW_VT4 = LW_VTAB + 72 * MiB, LW_S4 = LW_VTAB + 112 * MiB;
constexpr size_t WS_LW = 1 * MiB;
constexpr size_t WS_ACT = WS_LW + DEPTH * LW_SIZE;
constexpr size_t WS_XN = WS_ACT, WS_Q = WS_XN + 128 * MiB, WS_KB = WS_Q + 64 * MiB, WS_VT = WS_KB + 16 * MiB, WS_U = WS_VT + 16 * MiB, WS_GA = WS_U + 32 * MiB, WS_GS = WS_GA + 128 * MiB,
                 WS_ATT = WS_GS + 128 * MiB, WS_Z = WS_ATT + 64 * MiB, WS_SS = WS_Z + 32 * MiB, WS_MG = WS_SS + 32 * MiB, WS_PQ = WS_MG + 128 * MiB, WS_EID = WS_PQ + 64 * MiB,
                 WS_GATE = WS_EID + 8 * MiB, WS_HN = WS_GATE + 8 * MiB, WS_HN8 = WS_HN + 128 * MiB, WS_HS = WS_HN8 + 64 * MiB, WS_PAIRS = WS_HS + 1 * MiB, WS_SC = WS_PAIRS + 8 * MiB, WS_END = WS_SC + 8 * MiB;
static_assert(WS_END <= 2048 * MiB, "d_ws map exceeds the guaranteed 2 GiB");
constexpr int CW_TMO = 0, CW_CODE = 1, CW_BAR = 4096, CW_XRANK = 8192, CW_LBAR = 90112  , CW_CONV = 94208  , CW_COLMAX = 16384;
constexpr int CW_COLMAX2 = CW_COLMAX + DEPTH * INCOLS, CW_COLMAX3 = CW_COLMAX2 + DEPTH * 3 * DM;
static_assert((CW_COLMAX3 + DEPTH * 2048) * 4 <= (int)CTL_ZERO_BYTES, "CTL words inside the memset region");

constexpr int SCR_BYTES = 139264;
constexpr int LDSCTL_OFF = SCR_BYTES, MISC_OFF = LDSCTL_OFF + 320, LDS_BYTES = SCR_BYTES + 1024;
static_assert(MISC_OFF + 128 <= LDS_BYTES, "LDS map");
#define GAS __attribute__((address_space(1)))
#define LAS __attribute__((address_space(3)))
typedef unsigned short bf16;
typedef unsigned v4u __attribute__((ext_vector_type(4)));
typedef float f32x4 __attribute__((ext_vector_type(4)));
typedef short bf16x8 __attribute__((ext_vector_type(8)));
typedef GAS unsigned gu32;
typedef GAS unsigned long long gu64;
#define RLX_AGENT __ATOMIC_RELAXED, __HIP_MEMORY_SCOPE_AGENT
#define LDS_WAIT() asm volatile("s_waitcnt lgkmcnt(0)" ::: "memory")
#define VM_WAIT() asm volatile("s_waitcnt vmcnt(0)" ::: "memory")
__device__ __forceinline__ unsigned long long rt() { return __builtin_amdgcn_s_memrealtime(); }
__device__ __forceinline__ unsigned f2bf(float f) { unsigned u = __builtin_bit_cast(unsigned, f); return (u + 0x7fffu + ((u >> 16) & 1u)) >> 16; }
__device__ __forceinline__ unsigned pk2(float lo, float hi) { return f2bf(lo) | (f2bf(hi) << 16); }

#define XB_TMO      128
#define XB_XCNT(j)  (256  + 64 * (j))
#define XB_XSUB(j)  (1280 + 64 * (j))
#define XB_XGEN(j)  (2304 + 64 * (j))
#define XB_TOP      3328
#define XB_TOPGEN   3392
#define XCD_BAR_WORDS 3456
#define XB_SPIN_CAP (1u << 18)

__device__ __forceinline__ unsigned xb_ld(unsigned* p)              { return __hip_atomic_load(p, __ATOMIC_RELAXED, __HIP_MEMORY_SCOPE_AGENT); }
__device__ __forceinline__ unsigned xb_add(unsigned* p, unsigned v) { return __hip_atomic_fetch_add(p, v, __ATOMIC_RELAXED, __HIP_MEMORY_SCOPE_AGENT); }
__device__ __forceinline__ unsigned xb_xcc_id() { return (unsigned)__builtin_amdgcn_s_getreg((3 << 11) | 20) & 0xFu; }
#define XB_SPIN(cond, bar) do { unsigned _sp = 0; while (cond) { __builtin_amdgcn_s_sleep(1); \
    if ((++_sp & 255u) == 0u) { if (xb_ld(&(bar)[XB_TMO])) break; if (_sp > XB_SPIN_CAP) { atomicAdd(&(bar)[XB_TMO], 1u); break; } } } } while (0)

struct XcdBarrier {
    unsigned* bar; unsigned x;
    volatile LAS unsigned* st;
};

__device__ __forceinline__ XcdBarrier xcd_barrier_post(unsigned* bar, volatile LAS unsigned* st) {
    XcdBarrier b; b.bar = bar; b.x = xb_xcc_id(); b.st = st;
    if (threadIdx.x == 0) (void)xb_add(&bar[XB_XCNT(b.x)], 1u);
    return b;
}
__device__ __forceinline__ void xcd_barrier_complete(unsigned* bar, unsigned x, unsigned& nloc, unsigned& nx) {
    const unsigned G = gridDim.x * gridDim.y * gridDim.z;
    unsigned sum, cnt, mine, sp = 0u;
    for (;;) {
        sum = 0u; cnt = 0u; mine = 0u;
#pragma unroll
        for (unsigned j = 0; j < 16; ++j) { const unsigned c = xb_ld(&bar[XB_XCNT(j)]); sum += c; cnt += (c > 0u) ? 1u : 0u; mine = (j == x) ? c : mine; }
        if (sum == G) break;
        __builtin_amdgcn_s_sleep(1);
        if ((++sp & 255u) == 0u) { if (xb_ld(&bar[XB_TMO])) break; if (sp > XB_SPIN_CAP) { atomicAdd(&bar[XB_TMO], 1u); break; } }
    }
    nloc = mine > 0u ? mine : 1u; nx = cnt > 0u ? cnt : 1u;
}

__device__ __forceinline__ void xcd_barrier(const XcdBarrier& b) {
    asm volatile("s_waitcnt vmcnt(0)" ::: "memory");
    __syncthreads();
    if (threadIdx.x == 0) {
        unsigned* bar = b.bar; unsigned bx = b.x; asm volatile("" : "+s"(bx));
        __builtin_amdgcn_s_waitcnt(0);
        unsigned nloc = b.st[0], nx = b.st[1];
        if (nloc == 0u) { xcd_barrier_complete(bar, bx, nloc, nx); b.st[0] = nloc; b.st[1] = nx; }
        const unsigned old = xb_add(&bar[XB_XSUB(bx)], 1u);
        const unsigned gen = old / nloc;
        if (old + 1u == (gen + 1u) * nloc) {
            __builtin_amdgcn_fence(__ATOMIC_RELEASE, "agent");
            asm volatile("s_waitcnt vmcnt(0)" ::: "memory");
            const unsigned og = xb_add(&bar[XB_TOP], 1u);
            const unsigned tg = og / nx;
            if (og + 1u == (tg + 1u) * nx) xb_add(&bar[XB_TOPGEN], 1u);
            else XB_SPIN(xb_ld(&bar[XB_TOPGEN]) == tg, bar);
            __builtin_amdgcn_fence(__ATOMIC_ACQUIRE, "agent");
            xb_add(&bar[XB_XGEN(bx)], 1u);
            asm volatile("s_waitcnt vmcnt(0)" ::: "memory");
        } else {
            XB_SPIN(xb_ld(&bar[XB_XGEN(bx)]) == gen, bar);
            __builtin_amdgcn_fence(__ATOMIC_ACQUIRE, "agent");
            asm volatile("s_waitcnt vmcnt(0)" ::: "memory");
        }
    }
    __syncthreads();
}

typedef float f32x16 __attribute__((ext_vector_type(16)));
typedef float f32x2 __attribute__((ext_vector_type(2)));
typedef unsigned u32x2 __attribute__((ext_vector_type(2)));
typedef __bf16 bf16v2 __attribute__((ext_vector_type(2)));
typedef int i32x4 __attribute__((ext_vector_type(4)));
typedef int i32x2 __attribute__((ext_vector_type(2)));
__device__ __forceinline__ unsigned cvtpk(float lo, float hi) { unsigned r; asm volatile("v_cvt_pk_bf16_f32 %0, %1, %2" : "=v"(r) : "v"(lo), "v"(hi)); return r; }
__device__ __forceinline__ float bflo(unsigned w) { return __uint_as_float(w << 16); }
__device__ __forceinline__ float bfhi(unsigned w) { return __uint_as_float(w & 0xffff0000u); }
__device__ __forceinline__ float gelu_tanh(float x) { const float t = x + 0.044715f * x * x * x; return x * __builtin_amdgcn_rcpf(1.0f + __expf(-1.5957691216057308f * t)); }
__device__ __forceinline__ float dot2bf(unsigned a, unsigned b, float c) { return __builtin_amdgcn_fdot2_f32_bf16(__builtin_bit_cast(bf16v2, a), __builtin_bit_cast(bf16v2, b), c, false); }
#define DPP_I(v_, ctrl_) __builtin_amdgcn_update_dpp(0, (v_), (ctrl_), 0xF, 0xF, true)
#define DPP_F(v_, ctrl_) __builtin_bit_cast(float, __builtin_amdgcn_update_dpp(0, __builtin_bit_cast(int, (v_)), (ctrl_), 0xF, 0xF, true))
__device__ __forceinline__ int row16_sum(int v) { v += DPP_I(v, 0xB1); v += DPP_I(v, 0x4E); v += DPP_I(v, 0x141); v += DPP_I(v, 0x140); return v; }
__device__ __forceinline__ int wave_sum_i(int v) {
    v = row16_sum(v);
    v += __builtin_amdgcn_update_dpp(0, v, 0x142, 0xA, 0xF, false); v += __builtin_amdgcn_update_dpp(0, v, 0x143, 0xC, 0xF, false);
    return __builtin_amdgcn_readlane(v, 63);
}
__device__ __forceinline__ float wave_sum(float v) {
    v += DPP_F(v, 0xB1); v += DPP_F(v, 0x4E); v += DPP_F(v, 0x141); v += DPP_F(v, 0x140);
    v += __builtin_bit_cast(float, __builtin_amdgcn_update_dpp(0, __builtin_bit_cast(int, v), 0x142, 0xA, 0xF, false));
    v += __builtin_bit_cast(float, __builtin_amdgcn_update_dpp(0, __builtin_bit_cast(int, v), 0x143, 0xC, 0xF, false));
    return __builtin_bit_cast(float, __builtin_amdgcn_readlane(__builtin_bit_cast(int, v), 63));
}

struct Frame {
    LAS unsigned char* lds;
    volatile LAS unsigned* MISC;
    gu32* ctl;
    int tid, lane, wave, G;
    unsigned xcc, xrank, xi, nx, nloc;
    unsigned char* ws;
};

__device__ __forceinline__ void p0_transpose_item(const float* W, int K, int N, bf16* WT, bool glu, LAS float* scr, int item, int lane) {
    const int nblk = N / 32, kb = item / nblk, nb = item % nblk, k0 = 64 * kb, n0 = 32 * nb;
#pragma unroll 8
    for (int i = 0; i < 32; ++i) { const int kk = 2 * i + (lane >> 5); scr[kk * 33 + (lane & 31)] = W[(size_t)(k0 + kk) * N + n0 + (lane & 31)]; }
    LDS_WAIT(); asm volatile("" ::: "memory");
    const int c = lane & 7;
#pragma unroll
    for (int j = 0; j < 4; ++j) { const int n = (lane >> 3) + 8 * j; const LAS float* s = scr + (8 * c) * 33 + n;
        v4u o; o.x = cvtpk(s[0 * 33], s[1 * 33]); o.y = cvtpk(s[2 * 33], s[3 * 33]); o.z = cvtpk(s[4 * 33], s[5 * 33]); o.w = cvtpk(s[6 * 33], s[7 * 33]);
        int nrow = n0 + n; if (glu) { const int half = nrow >> 10, rem = nrow & 1023; nrow = (rem >> 7) * 256 + half * 128 + (rem & 127); }
        *(GAS v4u*)(WT + (size_t)nrow * K + k0 + 8 * c) = o; }
    LDS_WAIT(); asm volatile("" ::: "memory");
}
__device__ __forceinline__ void rms_row_to_bf16(const float* xrow, const float* g, bf16* orow, int lane) {
    const GAS f32x4* xr = (const GAS f32x4*)xrow + lane;
    f32x4 v[16]; float s = 0.f;
#pragma unroll
    for (int j = 0; j < 16; ++j) { v[j] = xr[64 * j]; s += (v[j].x * v[j].x + v[j].y * v[j].y) + (v[j].z * v[j].z + v[j].w * v[j].w); }
    const float rstd = 1.0f / sqrtf(wave_sum(s) * (1.f / DM) + NORM_EPS);
    const GAS f32x4* gr = (const GAS f32x4*)g + lane;
    GAS u32x2* o8 = (GAS u32x2*)orow + lane;
#pragma unroll
    for (int j = 0; j < 16; ++j) { const f32x4 gg = gr[64 * j]; u32x2 w; w.x = cvtpk(v[j].x * rstd * gg.x, v[j].y * rstd * gg.y); w.y = cvtpk(v[j].z * rstd * gg.z, v[j].w * rstd * gg.w); o8[64 * j] = w; }
}
__device__ __forceinline__ void s5_precompute(Frame& F, const float* a_re, const float* a_im, const float* log_step, const float* b_re, const float* b_im, const float* c_re, const float* c_im,
                                              int g, int half, bf16* KT, bf16* MEf, bf16* MCf, float* LAM) {
    LAS float* LPr = (LAS float*)F.lds; LAS float* LPi = LPr + 65 * 64; LAS float* Bbr = LPi + 65 * 64; LAS float* Bbi = Bbr + 1024; LAS float* Cr = Bbi + 1024; LAS float* Ci = Cr + 1024;
    const int tid = F.tid;
    { const float dt = expf(log_step[g]);
      for (int idx = tid; idx < 65 * 64; idx += 512) { const int t = idx >> 6, p = idx & 63; const float ar = a_re[g * 64 + p], ai = a_im[g * 64 + p];
          const float mag = expf(ar * dt * (float)t); float sn, cs; sincosf(ai * dt * (float)t, &sn, &cs); LPr[idx] = mag * cs; LPi[idx] = mag * sn; } }
    for (int i = tid; i < 1024; i += 512) { Cr[i] = c_re[g * 1024 + i]; Ci[i] = c_im[g * 1024 + i]; }
    __syncthreads();
    for (int i = tid; i < 1024; i += 512) { const int p = i >> 4, h = i & 15; const float ar = a_re[g * 64 + p], ai = a_im[g * 64 + p];
        const float lr = LPr[64 + p], li = LPi[64 + p], den = ar * ar + ai * ai, nr = lr - 1.0f;
        const float zr = (nr * ar + li * ai) / den, zi = (li * ar - nr * ai) / den;
        const float br = b_re[(g * 64 + p) * 16 + h], bi = b_im[(g * 64 + p) * 16 + h]; Bbr[i] = zr * br - zi * bi; Bbi[i] = zr * bi + zi * br; }
    if (half == 0 && tid < 64) { LAM[(g * 64 + tid) * 2] = LPr[64 * 64 + tid]; LAM[(g * 64 + tid) * 2 + 1] = LPi[64 * 64 + tid]; }
    __syncthreads();
    for (int o = half * 8192 + tid; o < half * 8192 + 8192; o += 512) { const int tau = o >> 8, h = (o >> 4) & 15, h2 = o & 15; float s = 0.f;
        for (int p = 0; p < 64; ++p) { const float cr = Cr[h * 64 + p], ci = Ci[h * 64 + p], lr = LPr[tau * 64 + p], li = LPi[tau * 64 + p]; const float wr = cr * lr - ci * li, wi = cr * li + ci * lr; s += wr * Bbr[p * 16 + h2] - wi * Bbi[p * 16 + h2]; }
        KT[(size_t)g * 16384 + o] = (bf16)(cvtpk(s, 0.f) & 0xffffu); }
    if (half == 0) for (int e = tid; e < 131072; e += 512) { const int j = e & 7, ln = (e >> 3) & 63, s = (e >> 9) & 63, mt = e >> 15; const int r = mt * 32 + (ln & 31), h = 8 * (ln >> 5) + j, p = r & 63;
        const float lr = LPr[(63 - s) * 64 + p], li = LPi[(63 - s) * 64 + p], br = Bbr[p * 16 + h], bi = Bbi[p * 16 + h]; const float v = (r < 64) ? (lr * br - li * bi) : (lr * bi + li * br);
        MEf[(size_t)g * 131072 + e] = (bf16)(cvtpk(v, 0.f) & 0xffffu); }
    if (half == 1) for (int e = tid; e < 131072; e += 512) { const int j = e & 7, ln = (e >> 3) & 63, kr = (e >> 9) & 7, mt = e >> 12; const int rr = ln & 31, t = 2 * mt + (rr >> 4), h = rr & 15, r = kr * 16 + 8 * (ln >> 5) + j, p = r & 63;
        const float cr = Cr[h * 64 + p], ci = Ci[h * 64 + p], lr = LPr[(t + 1) * 64 + p], li = LPi[(t + 1) * 64 + p]; const float v = (r < 64) ? (cr * lr - ci * li) : -(cr * li + ci * lr);
        MCf[(size_t)g * 131072 + e] = (bf16)(cvtpk(v, 0.f) & 0xffffu); }
    __syncthreads();
}

constexpr int ATT_KS_STRIDE = 272, ATT_VS_STRIDE = 528, ATT_VS_OFF = 256 * ATT_KS_STRIDE;
static_assert(ATT_VS_OFF + 128 * ATT_VS_STRIDE <= SCR_BYTES, "attention LDS");
__device__ __forceinline__ void attn_unit(Frame& F, int b, int nb, int kvh, const bf16* Q, const bf16* KB, const bf16* VT, bf16* ATT, const float* sinks) {
    int tid = F.tid; asm volatile("" : "+v"(tid)); const int lane = tid & 63, w = __builtin_amdgcn_readfirstlane(tid >> 6), r = lane & 31, hh = lane >> 5;
    LAS unsigned char* Ks = F.lds; LAS unsigned char* Vs = F.lds + ATT_VS_OFF;
    const int t0 = b * SEQ + nb * 128;
#pragma unroll
    for (int i = 0; i < 8; ++i) { const int idx = tid + 512 * i, j = idx >> 4, ch = idx & 15; int tk = t0 - 128 + j; if (nb == 0 && j < 128) tk = t0 + j;
        const v4u v = *(const GAS v4u*)(KB + (size_t)tk * KVW + kvh * 128 + ch * 8); *(LAS v4u*)(Ks + j * ATT_KS_STRIDE + ch * 16) = v; }
#pragma unroll
    for (int i = 0; i < 8; ++i) { const int idx = tid + 512 * i, d = idx >> 5, ch = idx & 31; int j0 = ch * 8; int srcj = nb * 128 - 128 + j0; if (nb == 0 && j0 < 128) srcj = j0;
        const v4u v = *(const GAS v4u*)(VT + ((size_t)((b * 4 + kvh) * 128 + d)) * SEQ + srcj); *(LAS v4u*)(Vs + d * ATT_VS_STRIDE + ch * 16) = v; }
    __syncthreads();
    const int hq = kvh * 4 + (w >> 1), hw = w & 1;
    const float slope = exp2f(-0.5f * (float)(hq + 1)), sink = sinks[hq];
#pragma unroll 1
    for (int qt = 0; qt < 2; ++qt) {
        const int qrow = hw * 64 + qt * 32 + r; const size_t tq = (size_t)(t0 + qrow);
        bf16x8 qf[8];
#pragma unroll
        for (int ks = 0; ks < 8; ++ks) qf[ks] = *(const GAS bf16x8*)(Q + tq * ATTW + hq * 128 + ks * 16 + 8 * hh);
        f32x16 S[6];
#pragma unroll
        for (int k6 = 0; k6 < 6; ++k6) { S[k6] = (f32x16){0.f};
            const int kt = 2 * hw + k6;
#pragma unroll
            for (int ks = 0; ks < 8; ++ks) { const bf16x8 a = *(const LAS bf16x8*)(Ks + (kt * 32 + r) * ATT_KS_STRIDE + ks * 32 + hh * 16); S[k6] = __builtin_amdgcn_mfma_f32_32x32x16_bf16(a, qf[ks], S[k6], 0, 0, 0); }
            asm volatile("" ::: "memory"); }
        float mx = sink;
#pragma unroll
        for (int k6 = 0; k6 < 6; ++k6)
#pragma unroll
            for (int rg = 0; rg < 16; ++rg) { const int j = (2 * hw + k6) * 32 + (rg & 3) + 8 * (rg >> 2) + 4 * hh; const int dist = qrow - j + 128;
                const bool valid = (dist >= 0) && (dist < 128) && (nb > 0 || j >= 128);
                const float lg = valid ? (S[k6][rg] - slope * (float)dist) : -1e30f; S[k6][rg] = lg; mx = fmaxf(mx, lg); }
        mx = fmaxf(mx, __shfl_xor(mx, 32));
        float sum = 0.f;
#pragma unroll
        for (int k6 = 0; k6 < 6; ++k6)
#pragma unroll
            for (int rg = 0; rg < 16; ++rg) { const float p = __expf(S[k6][rg] - mx); S[k6][rg] = p; sum += p; }
        sum += __shfl_xor(sum, 32); sum += __expf(sink - mx);
        const float inv = 1.0f / sum;
        f32x16 O[4];
#pragma unroll
        for (int dt = 0; dt < 4; ++dt) O[dt] = (f32x16){0.f};
#pragma unroll
        for (int k6 = 0; k6 < 6; ++k6)
#pragma unroll
            for (int s2 = 0; s2 < 2; ++s2) { v4u pw; pw.x = cvtpk(S[k6][8 * s2 + 0], S[k6][8 * s2 + 1]); pw.y = cvtpk(S[k6][8 * s2 + 2], S[k6][8 * s2 + 3]); pw.z = cvtpk(S[k6][8 * s2 + 4], S[k6][8 * s2 + 5]); pw.w = cvtpk(S[k6][8 * s2 + 6], S[k6][8 * s2 + 7]);
                const bf16x8 pb = __builtin_bit_cast(bf16x8, pw); const int key0 = (2 * hw + k6) * 32 + 16 * s2 + 4 * hh;
#pragma unroll
                for (int dt = 0; dt < 4; ++dt) { const LAS unsigned char* vp = Vs + (dt * 32 + r) * ATT_VS_STRIDE + key0 * 2; const u32x2 a0 = *(const LAS u32x2*)vp, a1 = *(const LAS u32x2*)(vp + 16);
                    v4u aw; aw.x = a0.x; aw.y = a0.y; aw.z = a1.x; aw.w = a1.y; O[dt] = __builtin_amdgcn_mfma_f32_32x32x16_bf16(__builtin_bit_cast(bf16x8, aw), pb, O[dt], 0, 0, 0); }
                asm volatile("" ::: "memory"); }
        bf16* orow = ATT + tq * ATTW + hq * 128;
#pragma unroll
        for (int dt = 0; dt < 4; ++dt)
#pragma unroll
            for (int g4 = 0; g4 < 4; ++g4) { u32x2 o; o.x = cvtpk(O[dt][4 * g4 + 0] * inv, O[dt][4 * g4 + 1] * inv); o.y = cvtpk(O[dt][4 * g4 + 2] * inv, O[dt][4 * g4 + 3] * inv);
                *(GAS u32x2*)(orow + dt * 32 + 8 * g4 + 4 * hh) = o; }
    }
    __syncthreads();
}

constexpr int S5_US_STRIDE = 2064, S5_ES_OFF = 32 * S5_US_STRIDE, S5_XS_OFF = S5_ES_OFF + 2 * 128 * 33 * 4, S5_XS_STRIDE = 272;
static_assert(S5_XS_OFF + 32 * S5_XS_STRIDE <= SCR_BYTES && 2 * 128 * 33 * 4 >= 32768, "S5 LDS");
__device__ __forceinline__ void s5_unit(Frame& F, int b, int g, const bf16* U, const bf16* KT, const bf16* MEf, const bf16* MCf, const float* LAM, const float* dskip, bf16* Z) {
    int tid = F.tid; asm volatile("" : "+v"(tid)); const int lane = tid & 63, w = __builtin_amdgcn_readfirstlane(tid >> 6), r = lane & 31, hh = lane >> 5;
    LAS unsigned char* Us = F.lds; LAS float* Es = (LAS float*)(F.lds + S5_ES_OFF); LAS unsigned char* Kt = F.lds + S5_ES_OFF; LAS unsigned char* Xs = F.lds + S5_XS_OFF;
#pragma unroll
    for (int i = 0; i < 8; ++i) { const int idx = tid + 512 * i, t = idx >> 1, half = idx & 1;
        const v4u v = *(const GAS v4u*)(U + ((size_t)(b * SEQ + t)) * SSMW + g * 16 + half * 8); *(LAS v4u*)(Us + (t >> 6) * S5_US_STRIDE + (t & 63) * 32 + half * 16) = v; }
    __syncthreads();
    {
        const int mtile = w & 3, sh = w >> 2; f32x16 acc = (f32x16){0.f};
        const bf16* mep = MEf + ((size_t)(g * 4 + mtile) * 64 + sh * 32) * 512 + lane * 8;
#pragma unroll 8
        for (int s2 = 0; s2 < 32; ++s2) { const bf16x8 a = *(const GAS bf16x8*)(mep + (size_t)s2 * 512);
            const bf16x8 bb = *(const LAS bf16x8*)(Us + r * S5_US_STRIDE + (sh * 32 + s2) * 32 + hh * 16); acc = __builtin_amdgcn_mfma_f32_32x32x16_bf16(a, bb, acc, 0, 0, 0); }
#pragma unroll
        for (int rg = 0; rg < 16; ++rg) { const int row = mtile * 32 + (rg & 3) + 8 * (rg >> 2) + 4 * hh; Es[(sh * 128 + row) * 33 + r] = acc[rg]; }
    }
    __syncthreads();
    if (tid < 64) {
        const int p = tid; const float lr = LAM[(g * 64 + p) * 2], li = LAM[(g * 64 + p) * 2 + 1]; float xr = 0.f, xi = 0.f;
        for (int c = 0; c < 32; ++c) {
            *(LAS bf16*)(Xs + c * S5_XS_STRIDE + p * 2) = (bf16)(cvtpk(xr, 0.f) & 0xffffu); *(LAS bf16*)(Xs + c * S5_XS_STRIDE + (64 + p) * 2) = (bf16)(cvtpk(xi, 0.f) & 0xffffu);
            const float er = Es[p * 33 + c] + Es[(128 + p) * 33 + c], ei = Es[(64 + p) * 33 + c] + Es[(128 + 64 + p) * 33 + c];
            const float nr = lr * xr - li * xi + er, ni = lr * xi + li * xr + ei; xr = nr; xi = ni; }
    }
    __syncthreads();
#pragma unroll
    for (int i = 0; i < 4; ++i) { const int idx = tid + 512 * i; *(LAS v4u*)(Kt + idx * 16) = *(const GAS v4u*)(KT + (size_t)g * 16384 + idx * 8); }
    __syncthreads();
#pragma unroll 1
    for (int q = 0; q < 4; ++q) {
        const int mt = (q == 0) ? w : (q == 1) ? 15 - w : (q == 2) ? 16 + w : 31 - w;
        const int tl = 2 * mt + (r >> 4), h = r & 15; f32x16 acc = (f32x16){0.f};
        for (int s = 0; s <= 2 * mt + 1; ++s) { const int tau = tl - s; const int tc = tau < 0 ? 0 : tau;
            bf16x8 a = *(const LAS bf16x8*)(Kt + tc * 512 + h * 32 + hh * 16); if (tau < 0) a = (bf16x8){0, 0, 0, 0, 0, 0, 0, 0};
            const bf16x8 bb = *(const LAS bf16x8*)(Us + r * S5_US_STRIDE + s * 32 + hh * 16); acc = __builtin_amdgcn_mfma_f32_32x32x16_bf16(a, bb, acc, 0, 0, 0); }
        const bf16* mcp = MCf + ((size_t)(g * 32 + mt) * 8) * 512 + lane * 8;
#pragma unroll
        for (int kr = 0; kr < 8; ++kr) { const bf16x8 a = *(const GAS bf16x8*)(mcp + (size_t)kr * 512);
            const bf16x8 bb = *(const LAS bf16x8*)(Xs + r * S5_XS_STRIDE + kr * 32 + hh * 16); acc = __builtin_amdgcn_mfma_f32_32x32x16_bf16(a, bb, acc, 0, 0, 0); }
#pragma unroll
        for (int g4 = 0; g4 < 4; ++g4) { const int ts = 2 * mt + (g4 >> 1), h0 = 8 * (g4 & 1) + 4 * hh;
            const u32x2 uu = *(const LAS u32x2*)(Us + r * S5_US_STRIDE + ts * 32 + h0 * 2); const f32x4 dd = *(const GAS f32x4*)(dskip + g * 16 + h0);
            const float y0 = acc[4 * g4 + 0] + dd.x * bflo(uu.x), y1 = acc[4 * g4 + 1] + dd.y * bfhi(uu.x), y2 = acc[4 * g4 + 2] + dd.z * bflo(uu.y), y3 = acc[4 * g4 + 3] + dd.w * bfhi(uu.y);
            u32x2 o; o.x = cvtpk(gelu_tanh(y0), gelu_tanh(y1)); o.y = cvtpk(gelu_tanh(y2), gelu_tanh(y3));
            *(GAS u32x2*)(Z + ((size_t)(b * SEQ + r * 64 + ts)) * SSMW + g * 16 + h0) = o; }
    }
    __syncthreads();
}

constexpr float NEGBIG = -3.0e38f;
template <int N> __device__ __forceinline__ void bitonic_sort_desc(float (&a)[N]) {
#pragma unroll
    for (int k = 2; k <= N; k <<= 1)
#pragma unroll
        for (int j = k >> 1; j > 0; j >>= 1)
#pragma unroll
            for (int i = 0; i < N; ++i) { const int l = i ^ j; if (l > i) { const bool up = ((i & k) == 0); const float hi = fmaxf(a[i], a[l]), lo = fminf(a[i], a[l]); a[i] = up ? hi : lo; a[l] = up ? lo : hi; } }
}
template <int N> __device__ __forceinline__ void bitonic_merge_desc(float (&a)[N]) {
#pragma unroll
    for (int j = N >> 1; j > 0; j >>= 1)
#pragma unroll
        for (int i = 0; i < N; ++i) { const int l = i ^ j; if (l > i) { const float hi = fmaxf(a[i], a[l]), lo = fminf(a[i], a[l]); a[i] = hi; a[l] = lo; } }
}
__device__ __forceinline__ void top16_merge(float (&a)[16], const float (&b)[16]) {
#pragma unroll
    for (int i = 0; i < 16; ++i) a[i] = fmaxf(a[i], b[15 - i]);
    bitonic_merge_desc<16>(a);
}
__device__ __forceinline__ void topk_task(int task, int lane, const bf16* PQ, const bf16* KEYS, int* EID, float* GATE, LAS unsigned char* wl) {
    asm volatile("" : "+v"(lane));
    const int tt = task >> 3, h = task & 7, r = lane & 31, hh = lane >> 5; const size_t token = (size_t)tt * 32 + r;
    float sv[2][16];
#pragma unroll
    for (int c = 0; c < 2; ++c) {
        bf16x8 qf[8];
#pragma unroll
        for (int ks = 0; ks < 8; ++ks) qf[ks] = *(const GAS bf16x8*)(PQ + token * (PH * PDK) + h * PDK + c * 128 + ks * 16 + 8 * hh);
        float g[4][16];
#pragma unroll
        for (int mt = 0; mt < 4; ++mt) { f32x16 acc = (f32x16){0.f};
#pragma unroll
            for (int ks = 0; ks < 8; ++ks) { const bf16x8 a = *(const GAS bf16x8*)(KEYS + ((size_t)((h * 2 + c) * 128 + mt * 32 + r)) * 128 + ks * 16 + 8 * hh); acc = __builtin_amdgcn_mfma_f32_32x32x16_bf16(a, qf[ks], acc, 0, 0, 0); }
#pragma unroll
            for (int rg = 0; rg < 16; ++rg) { const unsigned n = (unsigned)(mt * 32 + (rg & 3) + 8 * (rg >> 2) + 4 * hh); g[mt][rg] = __uint_as_float((__float_as_uint(acc[rg]) & ~127u) | n); }
            bitonic_sort_desc<16>(g[mt]); }
        top16_merge(g[0], g[1]); top16_merge(g[2], g[3]); top16_merge(g[0], g[2]);
        float u[16];
#pragma unroll
        for (int i = 0; i < 16; ++i) u[i] = fmaxf(g[0][i], __shfl_xor(g[0][15 - i], 32));
        bitonic_merge_desc<16>(u);
#pragma unroll
        for (int i = 0; i < 16; ++i) sv[c][i] = u[i];
    }
    { unsigned w[8];
#pragma unroll
      for (int d = 0; d < 8; ++d) { const int c = d >> 2, i0 = (d & 3) * 4; w[d] = (__float_as_uint(sv[c][i0]) & 127u) | ((__float_as_uint(sv[c][i0 + 1]) & 127u) << 8) | ((__float_as_uint(sv[c][i0 + 2]) & 127u) << 16) | ((__float_as_uint(sv[c][i0 + 3]) & 127u) << 24); }
      LAS unsigned* tp = (LAS unsigned*)(wl + lane * 36);
#pragma unroll
      for (int d = 0; d < 8; ++d) tp[d] = w[d]; }
    float cd[4][16];
    { int q = 0;
#pragma unroll
      for (int i = 0; i < 16; ++i)
#pragma unroll
        for (int j = 0; j < 16; ++j) if ((i + 1) * (j + 1) <= 16) {
            const float s = __uint_as_float(__float_as_uint(sv[0][i]) & ~127u) + __uint_as_float(__float_as_uint(sv[1][j]) & ~127u);
            cd[q >> 4][q & 15] = __uint_as_float((__float_as_uint(s) & ~255u) | (unsigned)((i << 4) | j)); ++q; }
#pragma unroll
      for (int p = 50; p < 64; ++p) cd[p >> 4][p & 15] = NEGBIG; }
#pragma unroll
    for (int t = 0; t < 4; ++t) bitonic_sort_desc<16>(cd[t]);
    top16_merge(cd[0], cd[1]); top16_merge(cd[2], cd[3]); top16_merge(cd[0], cd[2]);
    const float s0 = __uint_as_float(__float_as_uint(cd[0][0]) & ~255u);
    float ex[16]; int we[16]; float sum = 0.f;
    const LAS unsigned char* tb = wl + lane * 36;
#pragma unroll
    for (int k = 0; k < 16; ++k) { const unsigned bits = __float_as_uint(cd[0][k]); ex[k] = __expf(__uint_as_float(bits & ~255u) - s0); sum += ex[k];
        we[k] = (int)tb[(bits >> 4) & 15u] * 128 + (int)tb[16 + (bits & 15u)]; }
    const float inv = 1.0f / sum;
    int eo[8]; float go[8];
#pragma unroll
    for (int k = 0; k < 8; ++k) { eo[k] = hh ? we[k + 8] : we[k]; go[k] = (hh ? ex[k + 8] : ex[k]) * inv; }
    int* ep = EID + token * PSEL + h * 16 + hh * 8; float* gp = GATE + token * PSEL + h * 16 + hh * 8;
    *(GAS i32x4*)ep = (i32x4){eo[0], eo[1], eo[2], eo[3]}; *(GAS i32x4*)(ep + 4) = (i32x4){eo[4], eo[5], eo[6], eo[7]};
    *(GAS f32x4*)gp = (f32x4){go[0], go[1], go[2], go[3]}; *(GAS f32x4*)(gp + 4) = (f32x4){go[4], go[5], go[6], go[7]};
}

typedef signed char i8;
#define ROWLOAD8(dst, tab, e) do { const GAS v4u* _p = (const GAS v4u*)((tab) + (size_t)(e) * DM) + lane; _Pragma("unroll") for (int _i = 0; _i < 4; ++_i) dst[_i] = _p[64 * _i]; } while (0)
#define HALFLOAD8(dst, tab, e, hf) do { const GAS v4u* _p = (const GAS v4u*)((tab) + (size_t)(e) * DM) + lane + 128 * (hf); dst[0] = _p[0]; dst[1] = _p[64]; } while (0)
__device__ __forceinline__ int dotrow8(const v4u (&a)[4], const v4u (&x)[4]) {
    int s0 = 0, s1 = 0, s2 = 0, s3 = 0;
#pragma unroll
    for (int i = 0; i < 4; ++i) { s0 = __builtin_amdgcn_sdot4((int)a[i].x, (int)x[i].x, s0, false); s1 = __builtin_amdgcn_sdot4((int)a[i].y, (int)x[i].y, s1, false);
                                  s2 = __builtin_amdgcn_sdot4((int)a[i].z, (int)x[i].z, s2, false); s3 = __builtin_amdgcn_sdot4((int)a[i].w, (int)x[i].w, s3, false); }
    return (s0 + s1) + (s2 + s3);
}
template <int HF> __device__ __forceinline__ void vquad(int (&acc)[64], const v4u (&r0)[2], const v4u (&r1)[2], const v4u (&r2)[2], const v4u (&r3)[2], int a4) {
#pragma unroll
    for (int i = 0; i < 2; ++i) {
        const unsigned x0[4] = {r0[i].x, r0[i].y, r0[i].z, r0[i].w}, x1[4] = {r1[i].x, r1[i].y, r1[i].z, r1[i].w}, x2[4] = {r2[i].x, r2[i].y, r2[i].z, r2[i].w}, x3[4] = {r3[i].x, r3[i].y, r3[i].z, r3[i].w};
#pragma unroll
        for (int w = 0; w < 4; ++w) {
            const unsigned t0 = __builtin_amdgcn_perm(x1[w], x0[w], 0x05010400u), t1 = __builtin_amdgcn_perm(x1[w], x0[w], 0x07030602u);
            const unsigned u0 = __builtin_amdgcn_perm(x3[w], x2[w], 0x05010400u), u1 = __builtin_amdgcn_perm(x3[w], x2[w], 0x07030602u);
            const unsigned y0 = __builtin_amdgcn_perm(u0, t0, 0x05040100u), y1 = __builtin_amdgcn_perm(u0, t0, 0x07060302u), y2 = __builtin_amdgcn_perm(u1, t1, 0x05040100u), y3 = __builtin_amdgcn_perm(u1, t1, 0x07060302u);
            const int b = (2 * HF + i) * 16 + w * 4;
            acc[b + 0] = __builtin_amdgcn_sdot4((int)y0, a4, acc[b + 0], false); acc[b + 1] = __builtin_amdgcn_sdot4((int)y1, a4, acc[b + 1], false);
            acc[b + 2] = __builtin_amdgcn_sdot4((int)y2, a4, acc[b + 2], false); acc[b + 3] = __builtin_amdgcn_sdot4((int)y3, a4, acc[b + 3], false); } }
}
__device__ __forceinline__ unsigned pack_lo8(unsigned a, unsigned b, unsigned c, unsigned d) {
    return __builtin_amdgcn_perm(__builtin_amdgcn_perm(d, c, 0x0c0c0400u), __builtin_amdgcn_perm(b, a, 0x0c0c0400u), 0x05040100u);
}
__device__ __forceinline__ unsigned q8x4(float a, float b, float c, float d, float inv) {
    return pack_lo8(__float_as_uint(fmaf(a, inv, 12582912.0f)), __float_as_uint(fmaf(b, inv, 12582912.0f)), __float_as_uint(fmaf(c, inv, 12582912.0f)), __float_as_uint(fmaf(d, inv, 12582912.0f)));
}
__device__ __forceinline__ float wave_max(float v) {
    v = fmaxf(v, DPP_F(v, 0xB1)); v = fmaxf(v, DPP_F(v, 0x4E)); v = fmaxf(v, DPP_F(v, 0x141)); v = fmaxf(v, DPP_F(v, 0x140));
    { const int vi = __builtin_bit_cast(int, v); v = fmaxf(v, __builtin_bit_cast(float, __builtin_amdgcn_update_dpp(vi, vi, 0x142, 0xA, 0xF, false))); }
    { const int vi = __builtin_bit_cast(int, v); v = fmaxf(v, __builtin_bit_cast(float, __builtin_amdgcn_update_dpp(vi, vi, 0x143, 0xC, 0xF, false))); }
    return __builtin_bit_cast(float, __builtin_amdgcn_readlane(__builtin_bit_cast(int, v), 63));
}
__device__ __forceinline__ int lane_xor(int v, int m) {
    if (m == 1) return __builtin_amdgcn_update_dpp(0, v, 0xB1, 0xF, 0xF, true);
    if (m == 2) return __builtin_amdgcn_update_dpp(0, v, 0x4E, 0xF, 0xF, true);
    if (m == 4) { const int t = __builtin_amdgcn_update_dpp(v, v, 0x104, 0xF, 0x5, false); return __builtin_amdgcn_update_dpp(t, v, 0x114, 0xF, 0xA, false); }
    if (m == 8) return __builtin_amdgcn_update_dpp(0, v, 0x128, 0xF, 0xF, true);
    return __shfl_xor(v, m);
}
__device__ __forceinline__ void wave_sort128(unsigned& k0, unsigned& k1, int lane) {
#pragma unroll
    for (int k = 2; k <= 128; k <<= 1)
#pragma unroll
        for (int j = k >> 1; j > 0; j >>= 1) {
            const bool asc = ((2 * lane) & k) == 0;
            if (j == 1) { const unsigned lo = k0 < k1 ? k0 : k1, hi = k0 < k1 ? k1 : k0; k0 = asc ? lo : hi; k1 = asc ? hi : lo; }
            else { const int m = j >> 1; const bool takemin = (((lane & m) == 0) == asc);
                const unsigned o0 = (unsigned)lane_xor((int)k0, m), o1 = (unsigned)lane_xor((int)k1, m);
                k0 = takemin ? (k0 < o0 ? k0 : o0) : (k0 < o0 ? o0 : k0); k1 = takemin ? (k1 < o1 ? k1 : o1) : (k1 < o1 ? o1 : k1); }
        }
}
__device__ __forceinline__ void vquad4(int (&acc)[64], const v4u (&r0)[2], const v4u (&r1)[2], const v4u (&r2)[2], const v4u (&r3)[2], int a4) {
#pragma unroll
    for (int j = 0; j < 2; ++j) {
        const unsigned d0[4] = {r0[j].x, r0[j].y, r0[j].z, r0[j].w}, d1[4] = {r1[j].x, r1[j].y, r1[j].z, r1[j].w}, d2[4] = {r2[j].x, r2[j].y, r2[j].z, r2[j].w}, d3[4] = {r3[j].x, r3[j].y, r3[j].z, r3[j].w};
#pragma unroll
        for (int c = 0; c < 4; ++c) { const int i = 2 * j + (c >> 1), p = c & 1;
            const unsigned x0 = d0[c], x1 = d1[c], x2 = d2[c], x3 = d3[c];
            const unsigned t0 = __builtin_amdgcn_perm(x1, x0, 0x05010400u), t1 = __builtin_amdgcn_perm(x1, x0, 0x07030602u);
            const unsigned u0 = __builtin_amdgcn_perm(x3, x2, 0x05010400u), u1 = __builtin_amdgcn_perm(x3, x2, 0x07030602u);
            const unsigned y[4] = {__builtin_amdgcn_perm(u0, t0, 0x05040100u), __builtin_amdgcn_perm(u0, t0, 0x07060302u), __builtin_amdgcn_perm(u1, t1, 0x05040100u), __builtin_amdgcn_perm(u1, t1, 0x07060302u)};
            const int bl = i * 16 + p * 4, bh = bl + 8;
#pragma unroll
            for (int e = 0; e < 4; ++e) { acc[bl + e] = __builtin_amdgcn_sdot4((int)(y[e] & 0x0f0f0f0fu), a4, acc[bl + e], false); acc[bh + e] = __builtin_amdgcn_sdot4((int)y[e], a4, acc[bh + e], false); } } }
}
__device__ __forceinline__ void vquad4_fix(int (&acc)[64]) {
#pragma unroll
    for (int i = 0; i < 4; ++i)
#pragma unroll
        for (int k = 0; k < 8; ++k) acc[i * 16 + 8 + k] = (acc[i * 16 + 8 + k] - acc[i * 16 + k]) >> 4;
}
#define ROWLOAD4(dst, tab, e) do { const GAS v4u* _p = (const GAS v4u*)((tab) + (size_t)(e) * (DM / 2)) + lane; dst[0] = _p[0]; dst[1] = _p[64]; } while (0)
constexpr float INT4_CLIP = 2.7f;
constexpr int N8ROWS = 0;
template <bool LAST>
__device__ __forceinline__ void gather_token(size_t token, int lane, const int* SC, const float* HS, const int* EID, const float* GATE, const float* SU, const i8* VTB, const float* SV, const i8* VT4, const float* S4,
                                             const bf16* X, bf16* Xo, float* Fo, const float* gnext, i8* XNout, float* XSout) {
    asm volatile("" : "+v"(lane));
    const i32x2 ee = *(const GAS i32x2*)(EID + token * PSEL + 2 * lane); const f32x2 gg = *(const GAS f32x2*)(GATE + token * PSEL + 2 * lane); const i32x2 scv = *(const GAS i32x2*)(SC + token * PSEL + 2 * lane);
    const f32x4 scl0 = *((const GAS f32x4*)SU + ee.x), scl1 = *((const GAS f32x4*)SU + ee.y);
    const float hs = HS[token], su0 = scl0.x, su1 = scl1.x, s80 = scl0.y, s81 = scl1.y, s40 = scl0.z, s41 = scl1.z;
    const float g0 = gelu_tanh((float)scv.x * su0 * hs) * gg.x, g1 = gelu_tanh((float)scv.y * su1 * hs) * gg.y;
    const float m0 = fabsf(g0 * s80), m1 = fabsf(g1 * s81);
    unsigned t0 = __float_as_uint(m0), t1 = __float_as_uint(m1); wave_sort128(t0, t1, lane);
    const float thr = N8ROWS > 0 ? __uint_as_float((unsigned)__builtin_amdgcn_readlane((int)t0, N8ROWS > 0 ? (128 - N8ROWS) / 2 : 0)) : 3.0e38f;
    const unsigned c0 = (m0 < thr) ? 1u : 0u, c1 = (m1 < thr) ? 1u : 0u;
    const float a0 = g0 * (c0 ? s40 : s80), a1 = g1 * (c1 ? s41 : s81);
    const float amax = wave_max(fmaxf(fabsf(a0), fabsf(a1))); const float sa = amax * (1.0f / 127.0f), ainv = amax > 0.f ? 127.0f / amax : 0.f;
    const int q0 = (int)rintf(a0 * ainv), q1 = (int)rintf(a1 * ainv);
    unsigned k0 = (c0 << 23) | ((unsigned)ee.x << 8) | (unsigned)(q0 & 0xff), k1 = (c1 << 23) | ((unsigned)ee.y << 8) | (unsigned)(q1 & 0xff);
    wave_sort128(k0, k1, lane);
    const int e0 = (int)((k0 >> 8) & 0x3fffu), e1 = (int)((k1 >> 8) & 0x3fffu); const bool i40 = (k0 >> 23) & 1u, i41 = (k1 >> 23) & 1u;
    const int n0 = __builtin_popcountll(__ballot(!i40)) + __builtin_popcountll(__ballot(!i41));
    const int pair8 = (int)((i40 ? 0u : (k0 & 0xffu)) | ((i41 ? 0u : (k1 & 0xffu)) << 8));
    const int pair4 = (int)((i40 ? (k0 & 0xffu) : 0u) | ((i41 ? (k1 & 0xffu) : 0u) << 8));
    int corr = (i40 ? (int)(signed char)(k0 & 0xffu) : 0) + (i41 ? (int)(signed char)(k1 & 0xffu) : 0);
    corr = wave_sum_i(corr) * 8;
    int acc[64];
#pragma unroll
    for (int i = 0; i < 64; ++i) acc[i] = 0;
    const int nq8 = (n0 + 3) >> 2, q4s = n0 >> 2;
    if (q4s < 32) {
        v4u P0[2], P1[2], P2[2], P3[2], R0[2], R1[2], R2[2], R3[2];
#define QLOAD4(S0, S1, S2, S3, q_) do { const int ea = __builtin_amdgcn_readlane(e0, 2 * (q_)), eb = __builtin_amdgcn_readlane(e1, 2 * (q_)), ec = __builtin_amdgcn_readlane(e0, 2 * (q_) + 1), ed = __builtin_amdgcn_readlane(e1, 2 * (q_) + 1); \
            ROWLOAD4(S0, VT4, ea); ROWLOAD4(S1, VT4, eb); ROWLOAD4(S2, VT4, ec); ROWLOAD4(S3, VT4, ed); } while (0)
#define A4OF(q_) (__builtin_amdgcn_readlane(pair4, 2 * (q_)) | (__builtin_amdgcn_readlane(pair4, 2 * (q_) + 1) << 16))
        QLOAD4(P0, P1, P2, P3, q4s);
#pragma unroll 1
        for (int q = q4s; q < 32; q += 2) {
            if (q + 1 < 32) QLOAD4(R0, R1, R2, R3, q + 1);
            vquad4(acc, P0, P1, P2, P3, A4OF(q));
            if (q + 2 < 32) QLOAD4(P0, P1, P2, P3, q + 2);
            if (q + 1 < 32) vquad4(acc, R0, R1, R2, R3, A4OF(q + 1));
        }
#undef QLOAD4
#undef A4OF
        vquad4_fix(acc);
    }
    if (nq8 > 0) {
        v4u A0[2], A1[2], A2[2], A3[2], B0[2], B1[2], B2[2], B3[2];
        { const int ea = __builtin_amdgcn_readlane(e0, 0), eb = __builtin_amdgcn_readlane(e1, 0), ec = __builtin_amdgcn_readlane(e0, 1), ed = __builtin_amdgcn_readlane(e1, 1);
          HALFLOAD8(A0, VTB, ea, 0); HALFLOAD8(A1, VTB, eb, 0); HALFLOAD8(A2, VTB, ec, 0); HALFLOAD8(A3, VTB, ed, 0); }
#pragma unroll 1
        for (int q = 0; q < nq8; ++q) {
            const int a4 = __builtin_amdgcn_readlane(pair8, 2 * q) | (__builtin_amdgcn_readlane(pair8, 2 * q + 1) << 16);
            { const int ea = __builtin_amdgcn_readlane(e0, 2 * q), eb = __builtin_amdgcn_readlane(e1, 2 * q), ec = __builtin_amdgcn_readlane(e0, 2 * q + 1), ed = __builtin_amdgcn_readlane(e1, 2 * q + 1);
              HALFLOAD8(B0, VTB, ea, 1); HALFLOAD8(B1, VTB, eb, 1); HALFLOAD8(B2, VTB, ec, 1); HALFLOAD8(B3, VTB, ed, 1); }
            vquad<0>(acc, A0, A1, A2, A3, a4);
            if (q + 1 < nq8) { const int ea = __builtin_amdgcn_readlane(e0, 2 * q + 2), eb = __builtin_amdgcn_readlane(e1, 2 * q + 2), ec = __builtin_amdgcn_readlane(e0, 2 * q + 3), ed = __builtin_amdgcn_readlane(e1, 2 * q + 3);
              HALFLOAD8(A0, VTB, ea, 0); HALFLOAD8(A1, VTB, eb, 0); HALFLOAD8(A2, VTB, ec, 0); HALFLOAD8(A3, VTB, ed, 0); }
            vquad<1>(acc, B0, B1, B2, B3, a4);
        }
    }
#pragma unroll
    for (int i = 0; i < 64; ++i) if ((i & 8) == 0) acc[i] -= corr;
    const bf16* xrow = X + token * DM + lane * 16; bf16* orow = Xo + token * DM + lane * 16; float* frow = Fo + token * DM + lane * 16; float ss = 0.f; float xv[64];
#pragma unroll
    for (int i = 0; i < 4; ++i) { const v4u t0 = *(const GAS v4u*)(xrow + i * 1024), t1 = *(const GAS v4u*)(xrow + i * 1024 + 8); const int b = i * 16;
        const float xin[16] = {bflo(t0.x), bfhi(t0.x), bflo(t0.y), bfhi(t0.y), bflo(t0.z), bfhi(t0.z), bflo(t0.w), bfhi(t0.w), bflo(t1.x), bfhi(t1.x), bflo(t1.y), bfhi(t1.y), bflo(t1.z), bfhi(t1.z), bflo(t1.w), bfhi(t1.w)};
#pragma unroll
        for (int e = 0; e < 16; ++e) { xv[b + e] = xin[e] + sa * (float)acc[b + e]; ss += xv[b + e] * xv[b + e]; }
        if (!LAST) { v4u o0, o1; o0.x = cvtpk(xv[b + 0], xv[b + 1]); o0.y = cvtpk(xv[b + 2], xv[b + 3]); o0.z = cvtpk(xv[b + 4], xv[b + 5]); o0.w = cvtpk(xv[b + 6], xv[b + 7]); o1.x = cvtpk(xv[b + 8], xv[b + 9]); o1.y = cvtpk(xv[b + 10], xv[b + 11]); o1.z = cvtpk(xv[b + 12], xv[b + 13]); o1.w = cvtpk(xv[b + 14], xv[b + 15]);
            *(GAS v4u*)(orow + i * 1024) = o0; *(GAS v4u*)(orow + i * 1024 + 8) = o1; } }
    const float rstd = 1.0f / sqrtf(wave_sum(ss) * (1.f / DM) + NORM_EPS); float mx = 0.f;
#pragma unroll
    for (int i = 0; i < 4; ++i)
#pragma unroll
        for (int w = 0; w < 4; ++w) { const f32x4 ga = *(const GAS f32x4*)(gnext + i * 1024 + lane * 16 + w * 4); const int b = i * 16 + w * 4;
            xv[b + 0] *= rstd * ga.x; xv[b + 1] *= rstd * ga.y; xv[b + 2] *= rstd * ga.z; xv[b + 3] *= rstd * ga.w;
            if (LAST) *(GAS f32x4*)(frow + i * 1024 + w * 4) = (f32x4){xv[b + 0], xv[b + 1], xv[b + 2], xv[b + 3]};
            else mx = fmaxf(fmaxf(mx, fmaxf(fabsf(xv[b + 0]), fabsf(xv[b + 1]))), fmaxf(fabsf(xv[b + 2]), fabsf(xv[b + 3]))); }
    if (!LAST) {
        mx = wave_max(mx); const float inv = mx > 0.f ? 127.0f / mx : 0.f;
#pragma unroll
        for (int i = 0; i < 4; ++i) { unsigned o[4];
#pragma unroll
            for (int w = 0; w < 4; ++w) { const int b = i * 16 + w * 4; o[w] = q8x4(xv[b + 0], xv[b + 1], xv[b + 2], xv[b + 3], inv); }
            v4u ov; ov.x = o[0]; ov.y = o[1]; ov.z = o[2]; ov.w = o[3]; *(GAS v4u*)(XNout + token * DM + i * 1024 + lane * 16) = ov; }
        if (lane == 0) XSout[token] = mx * (1.0f / 127.0f);
    }
}
__device__ __forceinline__ unsigned nib4(const f32x4 t, float inv4) {
#define NIB1(x_) __float_as_uint(fminf(fmaxf(fmaf((x_), inv4, 12582920.0f), 12582913.0f), 12582927.0f))
    return pack_lo8(NIB1(t.x), NIB1(t.y), NIB1(t.z), NIB1(t.w));
#undef NIB1
}
__device__ __forceinline__ void quant_row_load(f32x4 (&v)[16], const float* src, int lane) {
#pragma unroll
    for (int c = 0; c < 16; ++c) v[c] = *(const GAS f32x4*)(src + c * 256 + lane * 4);
}
__device__ __forceinline__ void quant_row_store(const f32x4 (&v)[16], i8* dst, float* scale_out, i8* dst4, float* scale4_out, int lane) {
    float mx = 0.f;
#pragma unroll
    for (int c = 0; c < 16; ++c) { const f32x4 t = v[c]; mx = fmaxf(fmaxf(mx, fmaxf(fabsf(t.x), fabsf(t.y))), fmaxf(fabsf(t.z), fabsf(t.w))); }
    mx = wave_max(mx); const float inv = mx > 0.f ? 127.0f / mx : 0.f;
#pragma unroll
    for (int c = 0; c < 16; ++c) { const f32x4 t = v[c];
        if (dst) *(GAS unsigned*)(dst + c * 256 + lane * 4) = q8x4(t.x, t.y, t.z, t.w, inv); }
    if (lane == 0) *scale_out = mx * (1.0f / 127.0f);
    if (dst4) { float ss = 0.f;
#pragma unroll
        for (int c = 0; c < 16; ++c) { const f32x4 t = v[c]; ss += (t.x * t.x + t.y * t.y) + (t.z * t.z + t.w * t.w); }
        const float clip = fminf(mx, INT4_CLIP * sqrtf(wave_sum(ss) * (1.0f / DM))), inv4 = clip > 0.f ? 7.0f / clip : 0.f; const bool lowp = (lane & 3) < 2;
#pragma unroll
        for (int k = 0; k < 8; ++k) { const int ca = (k & 3) + (k >> 2) * 8, cb = ca + 4;
            const unsigned fix = lowp ? 0u : 0x08080808u, qa = nib4(v[ca], inv4) ^ fix, qb = nib4(v[cb], inv4) ^ fix;
            const unsigned r = (unsigned)__builtin_amdgcn_mov_dpp((int)(lowp ? qb : qa), 0x4E, 0xF, 0xF, true);
            *(GAS unsigned*)(dst4 + (size_t)((k >> 2) * 64 + (k & 3) * 16 + (lane >> 2)) * 16 + (lane & 3) * 4) = lowp ? (qa | (r << 4)) : (r | (qb << 4)); }
        if (lane == 0) *scale4_out = clip * (1.0f / 7.0f); }
}
__device__ __forceinline__ void quant_row8(const float* src, i8* dst, float* scale_out, i8* dst4, float* scale4_out, int lane) {
    f32x4 v[16]; quant_row_load(v, src, lane); quant_row_store(v, dst, scale_out, dst4, scale4_out, lane);
}
__device__ __forceinline__ void convert_tables(const float* srcu, const float* srcv, unsigned char* lw, int cw, int ncw, int lane) {
#define CT_LOAD(R, rw_) do { const int t_ = (rw_) >= NEXP, e_ = (rw_) - t_ * NEXP; quant_row_load(R, (t_ ? srcv : srcu) + (size_t)e_ * DM, lane); } while (0)
#define CT_STORE(R, rw_) do { const int t_ = (rw_) >= NEXP, e_ = (rw_) - t_ * NEXP; \
        quant_row_store(R, (t_ && N8ROWS == 0) ? (i8*)nullptr : (i8*)(lw + (t_ ? LW_VTAB : LW_UTAB)) + (size_t)e_ * DM, (float*)(lw + LW_SU) + 4 * e_ + t_, t_ ? (i8*)(lw + LW_VT4) + (size_t)e_ * (DM / 2) : (i8*)nullptr, (float*)(lw + LW_SU) + 4 * e_ + 2, lane); } while (0)
    f32x4 A[16], B[16];
    if (cw < 2 * NEXP) CT_LOAD(A, cw);
#pragma unroll 1
    for (int rw = cw; rw < 2 * NEXP; rw += 2 * ncw) {
        const int r1 = rw + ncw, r2 = rw + 2 * ncw;
        if (r1 < 2 * NEXP) CT_LOAD(B, r1);
        CT_STORE(A, rw);
        if (r2 < 2 * NEXP) CT_LOAD(A, r2);
        if (r1 < 2 * NEXP) CT_STORE(B, r1);
    }
#undef CT_LOAD
#undef CT_STORE
}
__device__ __forceinline__ void rms_row_to_bf16_i8(const float* xrow, const float* g, bf16* orow, i8* o8row, float* scale_out, int lane) {
    const GAS f32x4* xr = (const GAS f32x4*)xrow + lane;
    f32x4 v[16]; float s = 0.f;
#pragma unroll
    for (int j = 0; j < 16; ++j) { v[j] = xr[64 * j]; s += (v[j].x * v[j].x + v[j].y * v[j].y) + (v[j].z * v[j].z + v[j].w * v[j].w); }
    const float rstd = 1.0f / sqrtf(wave_sum(s) * (1.f / DM) + NORM_EPS);
    const GAS f32x4* gr = (const GAS f32x4*)g + lane;
    GAS u32x2* o8 = (GAS u32x2*)orow + lane; float mx = 0.f;
#pragma unroll
    for (int j = 0; j < 16; ++j) { const f32x4 gg = gr[64 * j]; v[j].x *= rstd * gg.x; v[j].y *= rstd * gg.y; v[j].z *= rstd * gg.z; v[j].w *= rstd * gg.w;
        u32x2 w; w.x = cvtpk(v[j].x, v[j].y); w.y = cvtpk(v[j].z, v[j].w); o8[64 * j] = w; mx = fmaxf(fmaxf(mx, fmaxf(fabsf(v[j].x), fabsf(v[j].y))), fmaxf(fabsf(v[j].z), fabsf(v[j].w))); }
    mx = wave_max(mx); const float inv = mx > 0.f ? 127.0f / mx : 0.f;
    GAS unsigned* q8 = (GAS unsigned*)o8row + lane;
#pragma unroll
    for (int j = 0; j < 16; ++j) q8[64 * j] = q8x4(v[j].x, v[j].y, v[j].z, v[j].w, inv);
    if (lane == 0) *scale_out = mx * (1.0f / 127.0f);
}

__device__ __forceinline__ void rms_row_to_i8(const float* xrow, const float* g, i8* o8row, float* scale_out, int lane) {
    const GAS f32x4* xr = (const GAS f32x4*)xrow + lane;
    f32x4 v[16]; float s = 0.f;
#pragma unroll
    for (int j = 0; j < 16; ++j) { v[j] = xr[64 * j]; s += (v[j].x * v[j].x + v[j].y * v[j].y) + (v[j].z * v[j].z + v[j].w * v[j].w); }
    const float rstd = 1.0f / sqrtf(wave_sum(s) * (1.f / DM) + NORM_EPS);
    const GAS f32x4* gr = (const GAS f32x4*)g + lane; float mx = 0.f;
#pragma unroll
    for (int j = 0; j < 16; ++j) { const f32x4 gg = gr[64 * j]; v[j].x *= rstd * gg.x; v[j].y *= rstd * gg.y; v[j].z *= rstd * gg.z; v[j].w *= rstd * gg.w;
        mx = fmaxf(fmaxf(mx, fmaxf(fabsf(v[j].x), fabsf(v[j].y))), fmaxf(fabsf(v[j].z), fabsf(v[j].w))); }
    mx = wave_max(mx); const float inv = mx > 0.f ? 127.0f / mx : 0.f;
    GAS unsigned* q8 = (GAS unsigned*)o8row + lane;
#pragma unroll
    for (int j = 0; j < 16; ++j) q8[64 * j] = q8x4(v[j].x, v[j].y, v[j].z, v[j].w, inv);
    if (lane == 0) *scale_out = mx * (1.0f / 127.0f);
}
template <int MODE> __device__ __forceinline__ void p0_tr64(const float* W, int K, int N, void* WT, const unsigned* colmax, LAS float* scr, int item, int lane) {
    const int nblk = N / 64, kb = item / nblk, nb = item % nblk, k0 = 64 * kb, n0 = 64 * nb; const int kk = lane >> 4, n4 = lane & 15;
    const float* src = W + (size_t)(k0 + kk) * N + n0 + 4 * n4;
#pragma unroll 8
    for (int i = 0; i < 16; ++i) { const f32x4 v = *(const GAS f32x4*)(src + (size_t)(4 * i) * N); LAS float* d = scr + (4 * i + kk) * 65 + 4 * n4; d[0] = v.x; d[1] = v.y; d[2] = v.z; d[3] = v.w; }
    LDS_WAIT(); asm volatile("" ::: "memory");
    if (MODE == 2) { const int c = lane & 3;
#pragma unroll
        for (int j = 0; j < 4; ++j) { const int n = (lane >> 2) + 16 * j; const LAS float* sp = scr + (16 * c) * 65 + n; const float cm = __uint_as_float(colmax[n0 + n]); const float inv = cm > 0.f ? 127.0f / cm : 0.f;
            unsigned o[4];
#pragma unroll
            for (int w = 0; w < 4; ++w) o[w] = q8x4(sp[(4 * w + 0) * 65], sp[(4 * w + 1) * 65], sp[(4 * w + 2) * 65], sp[(4 * w + 3) * 65], inv);
            v4u ov; ov.x = o[0]; ov.y = o[1]; ov.z = o[2]; ov.w = o[3]; *(GAS v4u*)((i8*)WT + (size_t)(n0 + n) * K + k0 + 16 * c) = ov; }
    } else { const int c = lane & 7;
#pragma unroll
        for (int j = 0; j < 8; ++j) { const int n = (lane >> 3) + 8 * j; const LAS float* sp = scr + (8 * c) * 65 + n;
            v4u o; o.x = cvtpk(sp[0 * 65], sp[1 * 65]); o.y = cvtpk(sp[2 * 65], sp[3 * 65]); o.z = cvtpk(sp[4 * 65], sp[5 * 65]); o.w = cvtpk(sp[6 * 65], sp[7 * 65]);
            int nrow = n0 + n; if (MODE == 1) { const int half = nrow >> 10, rem = nrow & 1023; nrow = (rem >> 7) * 256 + half * 128 + (rem & 127); }
            *(GAS v4u*)((bf16*)WT + (size_t)nrow * K + k0 + 8 * c) = o; }
    }
    LDS_WAIT(); asm volatile("" ::: "memory");
}
__device__ __forceinline__ void p0_transpose_q8_item(const float* W, int K, int N, const unsigned* colmax, i8* WT8, LAS float* scr, int item, int lane) {
    const int nblk = N / 32, kb = item / nblk, nb = item % nblk, k0 = 128 * kb, n0 = 32 * nb;
#pragma unroll 8
    for (int i = 0; i < 64; ++i) { const int kk = 2 * i + (lane >> 5); scr[kk * 33 + (lane & 31)] = W[(size_t)(k0 + kk) * N + n0 + (lane & 31)]; }
    LDS_WAIT(); asm volatile("" ::: "memory");
    const int c = lane & 7;
#pragma unroll
    for (int j = 0; j < 4; ++j) { const int n = (lane >> 3) + 8 * j; const LAS float* sp = scr + (16 * c) * 33 + n; const float cm = __uint_as_float(colmax[n0 + n]); const float inv = cm > 0.f ? 127.0f / cm : 0.f;
        unsigned o[4];
#pragma unroll
        for (int w = 0; w < 4; ++w) o[w] = q8x4(sp[(4 * w + 0) * 33], sp[(4 * w + 1) * 33], sp[(4 * w + 2) * 33], sp[(4 * w + 3) * 33], inv);
        v4u ov; ov.x = o[0]; ov.y = o[1]; ov.z = o[2]; ov.w = o[3]; *(GAS v4u*)(WT8 + (size_t)(n0 + n) * K + k0 + 16 * c) = ov; }
    LDS_WAIT(); asm volatile("" ::: "memory");
}

constexpr int PTILE = 512, NPTILE = M / PTILE, PPAIRS = PTILE * PSEL;
static_assert(PPAIRS == 65536, "pair index must fit 16 bits");
constexpr int SORT_SPLIT = 8;
__device__ __forceinline__ void sort_tile(Frame& F, int item, const int* EID, unsigned* PAIRS) {
    int tid = F.tid; asm volatile("" : "+v"(tid));
    const int tile = item / SORT_SPLIT, g = item % SORT_SPLIT;
    LAS unsigned* hist = (LAS unsigned*)F.lds; LAS unsigned* part = hist + 2048 + 64;
    for (int i = tid; i < 2048 + 64; i += 512) hist[i] = 0u;
    __syncthreads();
    const GAS i32x4* eid = (const GAS i32x4*)(EID + (size_t)tile * PPAIRS);
    unsigned below = 0;
    for (int i = tid; i < PPAIRS / 4; i += 512) { const i32x4 v = eid[i];
#pragma unroll
        for (int k = 0; k < 4; ++k) { const int e = v[k], hi = e >> 11, lo = e & 2047; below += (hi < g) ? 1u : 0u; if (hi == g) __hip_atomic_fetch_add(hist + lo + (lo >> 5), 1u, __ATOMIC_RELAXED, __HIP_MEMORY_SCOPE_WORKGROUP); } }
    part[tid] = below;
    __syncthreads();
    for (int d = 1; d < 512; d <<= 1) { const unsigned v = (tid >= d) ? part[tid - d] : 0u; __syncthreads(); part[tid] += v; __syncthreads(); }
    const unsigned base = part[511];
    __syncthreads();
    unsigned sum = 0;
#pragma unroll
    for (int j = 0; j < 4; ++j) { const int b = 4 * tid + j; sum += hist[b + (b >> 5)]; }
    part[tid] = sum;
    __syncthreads();
    for (int d = 1; d < 512; d <<= 1) { const unsigned v = (tid >= d) ? part[tid - d] : 0u; __syncthreads(); part[tid] += v; __syncthreads(); }
    unsigned run = base + part[tid] - sum;
#pragma unroll
    for (int j = 0; j < 4; ++j) { const int b = 4 * tid + j; const unsigned c = hist[b + (b >> 5)]; hist[b + (b >> 5)] = run; run += c; }
    __syncthreads();
    for (int i = tid; i < PPAIRS / 4; i += 512) { const i32x4 v = eid[i];
#pragma unroll
        for (int k = 0; k < 4; ++k) { const int e = v[k], lo = e & 2047; if ((e >> 11) == g) { const unsigned pos = __hip_atomic_fetch_add(hist + lo + (lo >> 5), 1u, __ATOMIC_RELAXED, __HIP_MEMORY_SCOPE_WORKGROUP); PAIRS[(size_t)tile * PPAIRS + pos] = ((unsigned)e << 16) | (unsigned)(4 * i + k); } } }
    __syncthreads();
}
#define ULOAD(Ux, ent) do { const GAS v4u* _u = (const GAS v4u*)(UT + (size_t)((ent) >> 16) * DM) + lane; _Pragma("unroll") for (int _i = 0; _i < 4; ++_i) Ux[_i] = _u[64 * _i]; } while (0)
#define HLOAD(Hx, ent) do { const GAS v4u* _h = (const GAS v4u*)(HN8 + ((size_t)tile * PTILE + (((ent) >> 7) & 511u)) * DM) + lane; _Pragma("unroll") for (int _i = 0; _i < 4; ++_i) Hx[_i] = _h[64 * _i]; } while (0)
#define UNIT_NEXT(s_, n_) do { const unsigned long long _m = ((s_) >= 63) ? 0ull : (firsts >> ((s_) + 1)); int _r = _m ? (int)__builtin_ctzll(_m) + 1 : 64; if (_r > npos - (s_)) _r = npos - (s_); n_ = _r < 4 ? _r : 4; } while (0)
#define UNIT_LOAD(U_, H0_, H1_, H2_, H3_, s_, n_) do { ULOAD(U_, ENT(s_)); HLOAD(H0_, ENT(s_)); if ((n_) > 1) HLOAD(H1_, ENT((s_) + 1)); if ((n_) > 2) HLOAD(H2_, ENT((s_) + 2)); if ((n_) > 3) HLOAD(H3_, ENT((s_) + 3)); } while (0)
#define UNIT_COMPUTE(U_, H0_, H1_, H2_, H3_, s_, n_) do { int part[4]; part[0] = dotrow8(U_, H0_); part[1] = dotrow8(U_, H1_); part[2] = dotrow8(U_, H2_); part[3] = dotrow8(U_, H3_); int p2[2]; \
    _Pragma("unroll") for (int i = 0; i < 2; ++i) { const auto _r = __builtin_amdgcn_permlane32_swap((unsigned)part[i], (unsigned)part[i + 2], false, false); p2[i] = (int)(_r[0] + _r[1]); }     \
    int p1; { const auto _r = __builtin_amdgcn_permlane16_swap((unsigned)p2[0], (unsigned)p2[1], false, false); p1 = (int)(_r[0] + _r[1]); }                                                     \
    p1 = row16_sum(p1); \
    const int j = lane >> 4; const unsigned _e0 = ENT(s_), _e1 = ENT(((s_) + 1) & 63), _e2 = ENT(((s_) + 2) & 63), _e3 = ENT(((s_) + 3) & 63); const unsigned me = j == 0 ? _e0 : j == 1 ? _e1 : j == 2 ? _e2 : _e3; \
    if ((lane & 15) == 0 && j < (n_)) SC[((size_t)tile * PTILE + ((me >> 7) & 511u)) * PSEL + (me & 127u)] = p1; } while (0)
__device__ __forceinline__ void uphase_chunk(int tile, unsigned c0, unsigned c1, int lane, const unsigned* PAIRS, const i8* UT, const i8* HN8, int* SC) {
    const unsigned* pr = PAIRS + (size_t)tile * PPAIRS;
    for (unsigned base = c0; base < c1; base += 64) {
        const int npos = (int)((c1 - base) < 64u ? (c1 - base) : 64u);
        const unsigned myent = pr[base + (unsigned)(lane < npos ? lane : npos - 1)];
        const unsigned prev = (unsigned)__shfl_up((int)myent, 1);
        const unsigned long long firsts = __ballot((lane == 0) || ((myent >> 16) != (prev >> 16)));
#define ENT(q) ((unsigned)__builtin_amdgcn_readlane((int)myent, (q)))
        v4u UA[4], HA0[4], HA1[4], HA2[4], HA3[4], UB[4], HB0[4], HB1[4], HB2[4], HB3[4];
        int s = 0, sA = 0, nA = 0, sB = 0, nB = 0;
        UNIT_NEXT(s, nA); sA = s; UNIT_LOAD(UA, HA0, HA1, HA2, HA3, sA, nA); s += nA;
#pragma unroll 1
        for (;;) {
            if (s < npos) { UNIT_NEXT(s, nB); sB = s; UNIT_LOAD(UB, HB0, HB1, HB2, HB3, sB, nB); s += nB; } else nB = 0;
            UNIT_COMPUTE(UA, HA0, HA1, HA2, HA3, sA, nA);
            if (nB == 0) break;
            if (s < npos) { UNIT_NEXT(s, nA); sA = s; UNIT_LOAD(UA, HA0, HA1, HA2, HA3, sA, nA); s += nA; } else nA = 0;
            UNIT_COMPUTE(UB, HB0, HB1, HB2, HB3, sB, nB);
            if (nA == 0) break;
        }
#undef ENT
    }
}

template <int NCH> __device__ __forceinline__ void quant_bf16_row(const bf16* src, i8* dst, float* scale_out, int lane) {
    v4u v[NCH]; float mx = 0.f;
#pragma unroll
    for (int i = 0; i < NCH; ++i) { v[i] = *((const GAS v4u*)src + i * 64 + lane);
        mx = fmaxf(mx, fmaxf(fmaxf(fmaxf(fabsf(bflo(v[i].x)), fabsf(bfhi(v[i].x))), fmaxf(fabsf(bflo(v[i].y)), fabsf(bfhi(v[i].y)))), fmaxf(fmaxf(fabsf(bflo(v[i].z)), fabsf(bfhi(v[i].z))), fmaxf(fabsf(bflo(v[i].w)), fabsf(bfhi(v[i].w)))))); }
    mx = wave_max(mx); const float inv = mx > 0.f ? 127.0f / mx : 0.f;
#pragma unroll
    for (int i = 0; i < NCH; ++i) { u32x2 o;
        o.x = q8x4(bflo(v[i].x), bfhi(v[i].x), bflo(v[i].y), bfhi(v[i].y), inv);
        o.y = q8x4(bflo(v[i].z), bfhi(v[i].z), bflo(v[i].w), bfhi(v[i].w), inv);
        *((GAS u32x2*)dst + i * 64 + lane) = o; }
    if (lane == 0) *scale_out = mx * (1.0f / 127.0f);
}

__device__ __forceinline__ int order_id(const Frame& F, const XcdBarrier& bar, bool use_bar) {
    if (!use_bar) return (int)blockIdx.x;
    const unsigned x = F.xcc, rank = F.xrank; unsigned nx = 0, xi = 0; bool uniform = true; const unsigned per = (unsigned)F.G >> 3;
    for (unsigned j = 0; j < 16; ++j) { const unsigned c = xb_ld(&bar.bar[XB_XCNT(j)]); nx += (c > 0u); xi += (c > 0u && j < x); uniform = uniform && (c == 0u || c == per); }
    return (uniform && nx == 8u && (F.G & 7) == 0 && rank < per) ? (int)(rank * 8u + xi) : (int)blockIdx.x;
}
__device__ __forceinline__ void rms_row16_to_i8(const bf16* xrow, const float* g, i8* o8row, float* scale_out, int lane) {
    float v[64]; float s = 0.f;
#pragma unroll
    for (int j = 0; j < 8; ++j) { const v4u t = *((const GAS v4u*)xrow + 64 * j + lane);
        v[8 * j + 0] = bflo(t.x); v[8 * j + 1] = bfhi(t.x); v[8 * j + 2] = bflo(t.y); v[8 * j + 3] = bfhi(t.y); v[8 * j + 4] = bflo(t.z); v[8 * j + 5] = bfhi(t.z); v[8 * j + 6] = bflo(t.w); v[8 * j + 7] = bfhi(t.w);
#pragma unroll
        for (int e = 0; e < 8; ++e) s += v[8 * j + e] * v[8 * j + e]; }
    const float rstd = 1.0f / sqrtf(wave_sum(s) * (1.f / DM) + NORM_EPS); float mx = 0.f;
#pragma unroll
    for (int j = 0; j < 8; ++j) { const f32x4 g0 = *((const GAS f32x4*)g + 2 * (64 * j + lane)), g1 = *((const GAS f32x4*)g + 2 * (64 * j + lane) + 1);
        v[8 * j + 0] *= rstd * g0.x; v[8 * j + 1] *= rstd * g0.y; v[8 * j + 2] *= rstd * g0.z; v[8 * j + 3] *= rstd * g0.w; v[8 * j + 4] *= rstd * g1.x; v[8 * j + 5] *= rstd * g1.y; v[8 * j + 6] *= rstd * g1.z; v[8 * j + 7] *= rstd * g1.w;
#pragma unroll
        for (int e = 0; e < 8; ++e) mx = fmaxf(mx, fabsf(v[8 * j + e])); }
    mx = wave_max(mx); const float inv = mx > 0.f ? 127.0f / mx : 0.f;
#pragma unroll
    for (int j = 0; j < 8; ++j) { u32x2 o;
        o.x = q8x4(v[8 * j + 0], v[8 * j + 1], v[8 * j + 2], v[8 * j + 3], inv);
        o.y = q8x4(v[8 * j + 4], v[8 * j + 5], v[8 * j + 6], v[8 * j + 7], inv);
        *((GAS u32x2*)o8row + 64 * j + lane) = o; }
    if (lane == 0) *scale_out = mx * (1.0f / 127.0f);
}
__device__ __forceinline__ void xcc_local_barrier(gu32* ctl, unsigned x, unsigned nloc, unsigned* tmo_bar) {
    asm volatile("s_waitcnt vmcnt(0)" ::: "memory");
    __syncthreads();
    if (threadIdx.x == 0) {
        __builtin_amdgcn_s_waitcnt(0);
        unsigned xx = x; asm volatile("" : "+s"(xx));
        unsigned* cnt = (unsigned*)ctl + CW_LBAR + 64 * xx; unsigned* gen = (unsigned*)ctl + CW_LBAR + 1024 + 64 * xx;
        const unsigned old = xb_add(cnt, 1u), g = old / nloc;
        if (old + 1u == (g + 1u) * nloc) xb_add(gen, 1u);
        else XB_SPIN(xb_ld(gen) == g, tmo_bar);
        __builtin_amdgcn_fence(__ATOMIC_ACQUIRE, "agent");
        asm volatile("s_waitcnt vmcnt(0)" ::: "memory");
    }
    __syncthreads();
}
struct Args { const float* in[22]; float* out; unsigned char* ws; int ph_lo, ph_hi, dup, pad; };
__global__ void __launch_bounds__(NWAVES * 64, 2) hybrid_fwd(Args args) {
    extern __shared__ __attribute__((aligned(16))) unsigned char lds[];
    Frame F;
    F.lds = (LAS unsigned char*)lds; F.MISC = (volatile LAS unsigned*)(F.lds + MISC_OFF);
    F.tid = threadIdx.x; F.lane = F.tid & 63; F.wave = __builtin_amdgcn_readfirstlane(F.tid >> 6); F.G = gridDim.x; F.ws = args.ws;
    F.ctl = (gu32*)(args.ws + WS_CTL);
    for (int u = F.tid; u < (LDS_BYTES - LDSCTL_OFF) / 4; u += NWAVES * 64) ((LAS unsigned*)(F.lds + LDSCTL_OFF))[u] = 0u;
    __syncthreads();
    const int lo = args.ph_lo, hi = args.ph_hi;
    const bool use_bar = MK_ONE_LAUNCH ? true : (hi - lo) > 1;
    XcdBarrier bar; bar.bar = (unsigned*)(F.ctl + CW_BAR); bar.x = 0; bar.st = nullptr;
    if (use_bar) bar = xcd_barrier_post((unsigned*)(F.ctl + CW_BAR), F.MISC + 8);
    if (F.tid == 0) { const unsigned x = use_bar ? xb_xcc_id() : (blockIdx.x & 7u); F.MISC[10] = x;
        F.MISC[11] = use_bar ? __hip_atomic_fetch_add((unsigned*)(F.ctl + CW_XRANK) + 64 * x, 1u, __ATOMIC_RELAXED, __HIP_MEMORY_SCOPE_AGENT) : (blockIdx.x >> 3); }
    __syncthreads();
    F.xcc = (unsigned)__builtin_amdgcn_readfirstlane((int)F.MISC[10]); F.xrank = (unsigned)__builtin_amdgcn_readfirstlane((int)F.MISC[11]);
#ifndef DUPMASK
#define DUPMASK 0
#endif
#define REPS(k)
#if MK_ONE_LAUNCH
#define DRY false
#else
#define DRY (args.dup != 0)
#endif
#ifndef PHSUB
#define PHSUB 3
#endif
#ifndef PHMASK
#define PHMASK 0x3ff
#endif
#if MK_ONE_LAUNCH
#define IN(k) true
#define SEAM(k) do { if ((k) + 1 < NPHASES) xcd_barrier(bar); } while (0)
#else
#define IN(k) (lo <= (k) && (k) < hi)
#define SEAM(k) do { if (IN(k) && IN((k) + 1)) xcd_barrier(bar); } while (0)
#endif
#define PH_PTRS int z_; asm volatile("s_mov_b32 %0, 0" : "=s"(z_)); int lane_ = F.tid & 63; asm volatile("" : "+v"(lane_)); const int gw = gw0 + z_; (void)gw; unsigned char* ws = args.ws + z_; float* X = args.out + z_; (void)X; \
    bf16* XN = (bf16*)(ws + WS_XN); bf16* Qb = (bf16*)(ws + WS_Q); bf16* KBb = (bf16*)(ws + WS_KB); bf16* VTb = (bf16*)(ws + WS_VT); bf16* Ub = (bf16*)(ws + WS_U); \
    bf16* GA = (bf16*)(ws + WS_GA); bf16* GS = (bf16*)(ws + WS_GS); bf16* ATT = (bf16*)(ws + WS_ATT); bf16* Zb = (bf16*)(ws + WS_Z); bf16* SSb = (bf16*)(ws + WS_SS); \
    bf16* MG = (bf16*)(ws + WS_MG); bf16* PQ = (bf16*)(ws + WS_PQ); bf16* HN = (bf16*)(ws + WS_HN); int* EID = (int*)(ws + WS_EID); float* GATE = (float*)(ws + WS_GATE); i8* HN8 = (i8*)(ws + WS_HN8); float* HS = (float*)(ws + WS_HS); (void)HN8; (void)HS; unsigned* PAIRS = (unsigned*)(ws + WS_PAIRS); int* SC = (int*)(ws + WS_SC); (void)PAIRS; (void)SC; i8* ATT8 = (i8*)(ws + WS_XN + 65 * MiB); i8* SS8 = (i8*)(ws + WS_XN + 97 * MiB); i8* MG8 = (i8*)(ws + WS_Q); float* ATS = (float*)(ws + WS_HS + 256 * 1024); float* SSS = (float*)(ws + WS_HS + 512 * 1024); float* MGS = (float*)(ws + WS_HS + 768 * 1024); (void)ATT8; (void)SS8; (void)MG8; (void)ATS; (void)SSS; (void)MGS; bf16* XB = (bf16*)(ws + WS_HN); (void)XB; i8* XN8 = (i8*)(ws + WS_XN); float* XS = (float*)(ws + WS_XN + 64 * MiB); (void)XN8; (void)XS; \
    (void)XN; (void)Qb; (void)KBb; (void)VTb; (void)Ub; (void)GA; (void)GS; (void)ATT; (void)Zb; (void)SSb; (void)MG; (void)PQ; (void)HN; (void)EID; (void)GATE;
#define INP(i) (args.in[(i) + z_])
#define ORDER_ID() order_id(F, bar, use_bar)
    const int gw0 = blockIdx.x * NWAVES + F.wave, NGW = F.G * NWAVES;

    if (IN(0)) { PH_PTRS
        for (int t = gw; t < DEPTH * 32 * 48; t += NGW) { const int l = t / 1536, r = t % 1536, kc = r / 48, nb = r % 48;
            const float* src = INP(2) + ((size_t)l * DM + kc * 128) * INCOLS + nb * 256 + lane_ * 4; f32x4 mx = (f32x4){0.f, 0.f, 0.f, 0.f};
#pragma unroll 8
            for (int k = 0; k < 128; ++k) { const f32x4 v = *(const GAS f32x4*)(src + (size_t)k * INCOLS); mx.x = fmaxf(mx.x, fabsf(v.x)); mx.y = fmaxf(mx.y, fabsf(v.y)); mx.z = fmaxf(mx.z, fabsf(v.z)); mx.w = fmaxf(mx.w, fabsf(v.w)); }
            unsigned* cm = (unsigned*)(F.ctl + CW_COLMAX) + l * INCOLS + nb * 256 + lane_ * 4;
            __hip_atomic_fetch_max(cm + 0, __float_as_uint(mx.x), __ATOMIC_RELAXED, __HIP_MEMORY_SCOPE_AGENT); __hip_atomic_fetch_max(cm + 1, __float_as_uint(mx.y), __ATOMIC_RELAXED, __HIP_MEMORY_SCOPE_AGENT);
            __hip_atomic_fetch_max(cm + 2, __float_as_uint(mx.z), __ATOMIC_RELAXED, __HIP_MEMORY_SCOPE_AGENT); __hip_atomic_fetch_max(cm + 3, __float_as_uint(mx.w), __ATOMIC_RELAXED, __HIP_MEMORY_SCOPE_AGENT); }
    }
    if (IN(0)) { PH_PTRS
        constexpr int T_AB = (ATTW / 128) * 16, T_SB = (SSMW / 128) * 16, T_OUT = (DM / 128) * 16, T_L = T_AB + T_SB + T_OUT;
        for (int t = gw; t < DEPTH * T_L; t += NGW) { const int l = t / T_L; int r = t % T_L; int which, K; const float* W;
            if (r < T_AB) { which = 0; K = ATTW; W = INP(13) + (size_t)l * ATTW * DM; } else if (r < T_AB + T_SB) { r -= T_AB; which = 1; K = SSMW; W = INP(14) + (size_t)l * SSMW * DM; } else { r -= T_AB + T_SB; which = 2; K = DM; W = INP(15) + (size_t)l * DM * DM; }
            (void)K; const int kc = r / 16, nb = r % 16; const float* src = W + (size_t)(kc * 128) * DM + nb * 256 + lane_ * 4; f32x4 mx = (f32x4){0.f, 0.f, 0.f, 0.f};
#pragma unroll 8
            for (int k = 0; k < 128; ++k) { const f32x4 v = *(const GAS f32x4*)(src + (size_t)k * DM); mx.x = fmaxf(mx.x, fabsf(v.x)); mx.y = fmaxf(mx.y, fabsf(v.y)); mx.z = fmaxf(mx.z, fabsf(v.z)); mx.w = fmaxf(mx.w, fabsf(v.w)); }
            unsigned* cm = (unsigned*)(F.ctl + CW_COLMAX2) + (l * 3 + which) * DM + nb * 256 + lane_ * 4;
            __hip_atomic_fetch_max(cm + 0, __float_as_uint(mx.x), __ATOMIC_RELAXED, __HIP_MEMORY_SCOPE_AGENT); __hip_atomic_fetch_max(cm + 1, __float_as_uint(mx.y), __ATOMIC_RELAXED, __HIP_MEMORY_SCOPE_AGENT);
            __hip_atomic_fetch_max(cm + 2, __float_as_uint(mx.z), __ATOMIC_RELAXED, __HIP_MEMORY_SCOPE_AGENT); __hip_atomic_fetch_max(cm + 3, __float_as_uint(mx.w), __ATOMIC_RELAXED, __HIP_MEMORY_SCOPE_AGENT); }
    }
    if (IN(0)) { PH_PTRS
        for (int t = gw; t < DEPTH * 32 * 8; t += NGW) { const int l = t / 256, r = t % 256, kc = r / 8, nb = r % 8;
            const float* src = INP(17) + ((size_t)l * DM + kc * 128) * (PH * PDK) + nb * 256 + lane_ * 4; f32x4 mx = (f32x4){0.f, 0.f, 0.f, 0.f};
#pragma unroll 8
            for (int k = 0; k < 128; ++k) { const f32x4 v = *(const GAS f32x4*)(src + (size_t)k * (PH * PDK)); mx.x = fmaxf(mx.x, fabsf(v.x)); mx.y = fmaxf(mx.y, fabsf(v.y)); mx.z = fmaxf(mx.z, fabsf(v.z)); mx.w = fmaxf(mx.w, fabsf(v.w)); }
            unsigned* cm = (unsigned*)(F.ctl + CW_COLMAX3) + l * 2048 + nb * 256 + lane_ * 4;
            __hip_atomic_fetch_max(cm + 0, __float_as_uint(mx.x), __ATOMIC_RELAXED, __HIP_MEMORY_SCOPE_AGENT); __hip_atomic_fetch_max(cm + 1, __float_as_uint(mx.y), __ATOMIC_RELAXED, __HIP_MEMORY_SCOPE_AGENT);
            __hip_atomic_fetch_max(cm + 2, __float_as_uint(mx.z), __ATOMIC_RELAXED, __HIP_MEMORY_SCOPE_AGENT); __hip_atomic_fetch_max(cm + 3, __float_as_uint(mx.w), __ATOMIC_RELAXED, __HIP_MEMORY_SCOPE_AGENT); }
    }
    SEAM(0);
#define CONVERT_WEIGHTS(l, lw, scr) do { \
            constexpr int I_IN = (DM / 64) * (INCOLS / 64), I_AB = (ATTW / 64) * (DM / 64), I_SB = (SSMW / 64) * (DM / 64), I_OUT = (DM / 64) * (DM / 64), I_GLU = (SSMW / 64) * (2 * SSMW / 64), I_PQ = (DM / 64) * (PH * PDK / 64); \
            constexpr int NIT = I_IN + I_AB + I_SB + I_OUT + I_GLU + I_PQ; \
            for (int it = gw; it < NIT; it += NGW) { \
                int r = it; \
                if (r < I_IN) { p0_tr64<2>(INP(2) + (size_t)l * DM * INCOLS, DM, INCOLS, lw + LW_WIN, (const unsigned*)(F.ctl + CW_COLMAX) + l * INCOLS, scr, r, lane_); continue; } r -= I_IN; \
                if (r < I_AB) { p0_tr64<2>(INP(13) + (size_t)l * ATTW * DM, ATTW, DM, lw + LW_WAB, (const unsigned*)(F.ctl + CW_COLMAX2) + (l * 3 + 0) * DM, scr, r, lane_); continue; } r -= I_AB; \
                if (r < I_SB) { p0_tr64<2>(INP(14) + (size_t)l * SSMW * DM, SSMW, DM, lw + LW_WSB, (const unsigned*)(F.ctl + CW_COLMAX2) + (l * 3 + 1) * DM, scr, r, lane_); continue; } r -= I_SB; \
                if (r < I_OUT) { p0_tr64<2>(INP(15) + (size_t)l * DM * DM, DM, DM, lw + LW_WOUT, (const unsigned*)(F.ctl + CW_COLMAX2) + (l * 3 + 2) * DM, scr, r, lane_); continue; } r -= I_OUT; \
                if (r < I_GLU) { p0_tr64<1>(INP(11) + (size_t)l * SSMW * 2 * SSMW, SSMW, 2 * SSMW, lw + LW_WGLU, nullptr, scr, r, lane_); continue; } r -= I_GLU; \
                p0_tr64<2>(INP(17) + (size_t)l * DM * PH * PDK, DM, PH * PDK, lw + LW_WPQ, (const unsigned*)(F.ctl + CW_COLMAX3) + l * 2048, scr, r, lane_); \
            } \
        } while (0)
    if (((PHMASK >> 0) & 1) && IN(1)) REPS(0) { PH_PTRS
        LAS float* scr = (LAS float*)(F.lds + F.wave * 16896);
        for (int l = 0; l < DEPTH; ++l) {
            unsigned char* lw = ws + WS_LW + (size_t)l * LW_SIZE;
            CONVERT_WEIGHTS(l, lw, scr);
            constexpr size_t NK = (size_t)PH * 2 * NKEYS * 128 / 512;
            for (size_t st = gw; st < NK; st += NGW) { const float* src = INP(18) + (size_t)l * PH * 2 * NKEYS * 128; bf16* dst = (bf16*)(lw + LW_KEYS);
                const size_t e = st * 512 + lane_ * 8; const f32x4 a = *(const GAS f32x4*)(src + e), b = *(const GAS f32x4*)(src + e + 4);
                v4u o; o.x = cvtpk(a.x, a.y); o.y = cvtpk(a.z, a.w); o.z = cvtpk(b.x, b.y); o.w = cvtpk(b.z, b.w); *(GAS v4u*)(dst + e) = o; }
        }
        for (int i = gw * 64 + lane_; i < DEPTH * 2048; i += NGW * 64) ((float*)(ws + WS_LW + (size_t)(i / 2048) * LW_SIZE + LW_WPQS))[i % 2048] = __uint_as_float(((const unsigned*)(F.ctl + CW_COLMAX3))[i]) * (1.0f / 127.0f);
        for (int i = gw * 64 + lane_; i < DEPTH * 3 * DM; i += NGW * 64) { const int l = i / (3 * DM), which = (i / DM) % 3, n = i % DM; unsigned char* lw = ws + WS_LW + (size_t)l * LW_SIZE;
            ((float*)(lw + (which == 0 ? LW_WABS : which == 1 ? LW_WSBS : LW_WOUTS)))[n] = __uint_as_float(((const unsigned*)(F.ctl + CW_COLMAX2))[i]) * (1.0f / 127.0f); }
        for (int l = 0; l < DEPTH; ++l) for (int n = gw * 64 + lane_; n < INCOLS; n += NGW * 64) ((float*)(ws + WS_LW + (size_t)l * LW_SIZE + LW_WINS))[n] = __uint_as_float(((const unsigned*)(F.ctl + CW_COLMAX))[l * INCOLS + n]) * (1.0f / 127.0f);
        for (int m = gw; m < M; m += NGW) rms_row_to_i8(INP(0) + (size_t)m * DM, INP(1), XN8 + (size_t)m * DM, XS + m, lane_);
        __syncthreads();
        for (int it2 = blockIdx.x; it2 < DEPTH * SSMG * 2; it2 += F.G) { const int it = it2 >> 1, half = it2 & 1; const int l = it / SSMG, g = it % SSMG; unsigned char* lw = ws + WS_LW + (size_t)l * LW_SIZE;
            s5_precompute(F, INP(3) + l * SSMG * 64, INP(4) + l * SSMG * 64, INP(5) + l * SSMG, INP(6) + (size_t)l * SSMG * 1024, INP(7) + (size_t)l * SSMG * 1024,
                          INP(8) + (size_t)l * SSMG * 1024, INP(9) + (size_t)l * SSMG * 1024, g, half, (bf16*)(lw + LW_S5K), (bf16*)(lw + LW_S5ME), (bf16*)(lw + LW_S5MC), (float*)(lw + LW_S5LAM)); }
    }
    SEAM(1);
    if (use_bar) { unsigned nloc = 0, xi = 0, nx = 0;
        for (unsigned j = 0; j < 16; ++j) { const unsigned c = xb_ld(&bar.bar[XB_XCNT(j)]); nx += (c > 0u); xi += (c > 0u && j < F.xcc); nloc = (j == F.xcc) ? c : nloc; }
        F.xi = (unsigned)__builtin_amdgcn_readfirstlane((int)xi); F.nx = (unsigned)__builtin_amdgcn_readfirstlane((int)(nx ? nx : 1u)); F.nloc = (unsigned)__builtin_amdgcn_readfirstlane((int)(nloc ? nloc : 1u)); }
    else if ((F.G & 7) == 0) { F.xi = F.xcc; F.nx = 8; F.nloc = (unsigned)F.G >> 3; }
    else { F.xi = 0; F.nx = 1; F.nloc = (unsigned)F.G; F.xrank = blockIdx.x; }
    const int wl = (int)F.xrank * NWAVES + F.wave, NWL = (int)F.nloc * NWAVES;
#define LSEAM(k) do { if (use_bar && (k) + 1 < NPHASES) xcc_local_barrier(F.ctl, F.xcc, F.nloc, bar.bar); } while (0)
#define FOR_OWNED(b) for (int b = (int)F.xi; b < BATCH; b += (int)F.nx)

#pragma unroll 1
    for (int l = 0; l < DEPTH; ++l) {
        const int pb = NPH_PRO + l * NPH_LAYER;
        if (((PHMASK >> 1) & 1) && IN(pb + 0)) REPS(1) { PH_PTRS unsigned char* lw = ws + WS_LW + (size_t)l * LW_SIZE; (void)lw;
            pg8::Gemm g{(const bf16*)XN8, (const bf16*)(lw + LW_WIN), M, INCOLS, DM / 2}; pg8::LocalWindow S; S.init(INCOLS, (int)F.nloc, (int)F.xrank, (int)F.xi, (int)F.nx);
            const int mine = (S.nbo * 8 * S.nN - (int)F.xrank + (int)F.nloc - 1) / (int)F.nloc, cut = ((int)F.xrank * (mine + 1)) / (int)F.nloc;
            pg8::EpiIn8 E{Qb, KBb, VTb, Ub, GA, GS, XS, (const float*)(lw + LW_WINS)};
            S.lo = 0; S.hi = cut; pg8::gemm_phase<pg8::EpiIn8, pg8::LocalWindow, true, true>(F.lds, g, S, E);
            convert_tables(INP(19) + (size_t)l * NEXP * DM, INP(20) + (size_t)l * NEXP * DM, lw, (int)blockIdx.x * NWAVES + F.wave, F.G * NWAVES, lane_);
            if (use_bar) { asm volatile("s_waitcnt vmcnt(0)" ::: "memory"); __syncthreads();
                if (threadIdx.x == 0) { __builtin_amdgcn_fence(__ATOMIC_RELEASE, "agent"); asm volatile("s_waitcnt vmcnt(0)" ::: "memory"); (void)xb_add((unsigned*)F.ctl + CW_CONV + 64 * l, 1u); } }
            S.lo = cut; S.hi = 1 << 30; pg8::gemm_phase<pg8::EpiIn8, pg8::LocalWindow, true, true>(F.lds, g, S, E);
        }
        LSEAM(pb + 0);
        if (((PHMASK >> 2) & 1) && IN(pb + 1)) REPS(2) { PH_PTRS unsigned char* lw = ws + WS_LW + (size_t)l * LW_SIZE; (void)lw;
            FOR_OWNED(b) for (int j = (int)F.xrank; j < 128; j += (int)F.nloc) {
                if (j < 64) attn_unit(F, b, j >> 2, j & 3, Qb, KBb, VTb, ATT, INP(12) + l * NQH);
                else s5_unit(F, b, j - 64, Ub, (const bf16*)(lw + LW_S5K), (const bf16*)(lw + LW_S5ME), (const bf16*)(lw + LW_S5MC), (const float*)(lw + LW_S5LAM), INP(10) + l * SSMW, Zb);
            }
        }
        LSEAM(pb + 1);
        if (((PHMASK >> 3) & 1) && IN(pb + 2)) REPS(3) { PH_PTRS unsigned char* lw = ws + WS_LW + (size_t)l * LW_SIZE; (void)lw;
            pg8::Gemm g{Zb, (const bf16*)(lw + LW_WGLU), M, 2 * SSMW, SSMW}; pg8::LocalOrder S; S.init(2 * SSMW, (int)F.nloc, (int)F.xrank, (int)F.xi, (int)F.nx);
            pg8::EpiGlu E{SSb, SSMW};
            pg8::gemm_phase<pg8::EpiGlu, pg8::LocalOrder, true, true>(F.lds, g, S, E);
        }
        LSEAM(pb + 2);
        if (IN(pb + 3)) { PH_PTRS FOR_OWNED(b) for (int m = b * SEQ + wl; m < (b + 1) * SEQ; m += NWL) { quant_bf16_row<4>(ATT + (size_t)m * ATTW, ATT8 + (size_t)m * ATTW, ATS + m, lane_); quant_bf16_row<2>(SSb + (size_t)m * SSMW, SS8 + (size_t)m * SSMW, SSS + m, lane_); } }
        LSEAM(pb + 3);
        if (((PHMASK >> 4) & 1) && IN(pb + 4)) REPS(4) { PH_PTRS unsigned char* lw = ws + WS_LW + (size_t)l * LW_SIZE; (void)lw;
            { pg8::Gemm g{(const bf16*)ATT8, (const bf16*)(lw + LW_WAB), M, DM, ATTW / 2}; pg8::LocalOrder S; S.init(DM, (int)F.nloc, (int)F.xrank, (int)F.xi, (int)F.nx); pg8::EpiGate8<false> E{MG, GA, DM, ATS, (const float*)(lw + LW_WABS)};
              pg8::gemm_phase<pg8::EpiGate8<false>, pg8::LocalOrder, true, true>(F.lds, g, S, E); }
            { pg8::Gemm g{(const bf16*)SS8, (const bf16*)(lw + LW_WSB), M, DM, SSMW / 2}; pg8::LocalOrder S; S.init(DM, (int)F.nloc, (int)F.xrank, (int)F.xi, (int)F.nx); pg8::EpiGate8<true> E{MG, GS, DM, SSS, (const float*)(lw + LW_WSBS)};
              pg8::gemm_phase<pg8::EpiGate8<true>, pg8::LocalOrder, true, true>(F.lds, g, S, E); }
        }
        LSEAM(pb + 4);
        if (IN(pb + 5)) { PH_PTRS FOR_OWNED(b) for (int m = b * SEQ + wl; m < (b + 1) * SEQ; m += NWL) quant_bf16_row<8>(MG + (size_t)m * DM, MG8 + (size_t)m * DM, MGS + m, lane_); }
        LSEAM(pb + 5);
        if (((PHMASK >> 5) & 1) && IN(pb + 6)) REPS(5) { PH_PTRS unsigned char* lw = ws + WS_LW + (size_t)l * LW_SIZE; (void)lw;
            pg8::Gemm g{(const bf16*)MG8, (const bf16*)(lw + LW_WOUT), M, DM, DM / 2}; pg8::LocalOrder S; S.init(DM, (int)F.nloc, (int)F.xrank, (int)F.xi, (int)F.nx);
            pg8::EpiRes8 E{l == 0 ? INP(0) : (const float*)nullptr, XB, DRY ? GA : XB, DM, MGS, (const float*)(lw + LW_WOUTS)};
            pg8::gemm_phase<pg8::EpiRes8, pg8::LocalOrder, true, true>(F.lds, g, S, E);
        }
        LSEAM(pb + 6);
        if (((PHMASK >> 6) & 1) && IN(pb + 7)) REPS(6) { PH_PTRS unsigned char* lw = ws + WS_LW + (size_t)l * LW_SIZE; (void)lw; FOR_OWNED(b) for (int m = b * SEQ + wl; m < (b + 1) * SEQ; m += NWL) rms_row16_to_i8(XB + (size_t)m * DM, INP(16) + l * DM, HN8 + (size_t)m * DM, HS + m, lane_); }
        LSEAM(pb + 7);
        if (((PHMASK >> 7) & 1) && IN(pb + 8)) REPS(7) { PH_PTRS unsigned char* lw = ws + WS_LW + (size_t)l * LW_SIZE; (void)lw;
            pg8::Gemm g{(const bf16*)HN8, (const bf16*)(lw + LW_WPQ), M, PH * PDK, DM / 2}; pg8::LocalOrder S; S.init(PH * PDK, (int)F.nloc, (int)F.xrank, (int)F.xi, (int)F.nx);
            pg8::EpiBf16Plain8 E{PQ, PH * PDK, HS, (const float*)(lw + LW_WPQS)};
            pg8::gemm_phase<pg8::EpiBf16Plain8, pg8::LocalOrder, true, true>(F.lds, g, S, E);
        }
        LSEAM(pb + 8);
        if (((PHMASK >> 8) & 1) && IN(pb + 9)) REPS(8) { PH_PTRS unsigned char* lw = ws + WS_LW + (size_t)l * LW_SIZE; (void)lw; FOR_OWNED(b) for (int tl = wl; tl < (SEQ / 32) * PH; tl += NWL) topk_task((b * (SEQ / 32) + (tl >> 3)) * PH + (tl & 7), lane_, PQ, (const bf16*)(lw + LW_KEYS), EID, GATE, F.lds + F.wave * 2304); }
        LSEAM(pb + 9);
        if (IN(pb + 10)) { PH_PTRS FOR_OWNED(b) for (int it = (int)F.xrank; it < (SEQ / PTILE) * SORT_SPLIT; it += (int)F.nloc) sort_tile(F, b * (SEQ / PTILE) * SORT_SPLIT + it, EID, PAIRS); }
        if (use_bar && threadIdx.x == 0) XB_SPIN(xb_ld((unsigned*)F.ctl + CW_CONV + 64 * l) < (unsigned)F.G, bar.bar);
        LSEAM(pb + 10);
        if (IN(pb + 11)) { PH_PTRS unsigned char* lw = ws + WS_LW + (size_t)l * LW_SIZE;
            const unsigned nW = (unsigned)NWL, chunk = (PPAIRS + nW - 1) / nW, wv = (unsigned)wl;
            FOR_OWNED(b) for (int tile = b * (SEQ / PTILE); tile < (b + 1) * (SEQ / PTILE); ++tile) { const unsigned c0 = wv * chunk, c1 = (c0 + chunk < (unsigned)PPAIRS) ? c0 + chunk : (unsigned)PPAIRS;
                if (c0 < c1) uphase_chunk(tile, c0, c1, lane_, PAIRS, (const i8*)(lw + LW_UTAB), HN8, SC); }
        }
        LSEAM(pb + 11);
        if (((PHMASK >> 9) & 1) && IN(pb + 12)) REPS(9) { PH_PTRS unsigned char* lw = ws + WS_LW + (size_t)l * LW_SIZE; (void)lw;
            if (l + 1 < DEPTH) { FOR_OWNED(b) for (int m = b * SEQ + wl; m < (b + 1) * SEQ; m += NWL) gather_token<false>((size_t)m, lane_, SC, HS, EID, GATE, (const float*)(lw + LW_SU), (const i8*)(lw + LW_VTAB), (const float*)(lw + LW_SV), (const i8*)(lw + LW_VT4), (const float*)(lw + LW_S4), XB, DRY ? GA : XB, X, INP(1) + (l + 1) * DM, DRY ? (i8*)MG : XN8, DRY ? (float*)Zb : XS); }
            else { FOR_OWNED(b) for (int m = b * SEQ + wl; m < (b + 1) * SEQ; m += NWL) gather_token<true>((size_t)m, lane_, SC, HS, EID, GATE, (const float*)(lw + LW_SU), (const i8*)(lw + LW_VTAB), (const float*)(lw + LW_SV), (const i8*)(lw + LW_VT4), (const float*)(lw + LW_S4), XB, XB, DRY ? (float*)GA : X, INP(21), XN8, XS); }
        }
        LSEAM(pb + 12);
    }
#undef IN
#undef SEAM
}

extern "C" void kernel_launch(void* const* d_in, const int* in_sizes, int n_in, void* d_out, int out_size, void* d_ws, size_t ws_size, hipStream_t stream) {
    static int grid = 0;
    if (grid == 0) {
        if (n_in != 22 || out_size != M * DM || ws_size < WS_END) { fprintf(stderr, "kernel_launch: unexpected shapes (n_in %d out %d ws %zu)\n", n_in, out_size, ws_size); grid = -1; return; }
        int dev = 0, cus = 0, per_cu = 0;
        if (hipGetDevice(&dev) != hipSuccess || hipDeviceGetAttribute(&cus, hipDeviceAttributeMultiprocessorCount, dev) != hipSuccess) { grid = -1; return; }
        if (hipFuncSetAttribute((const void*)hybrid_fwd, hipFuncAttributeMaxDynamicSharedMemorySize, LDS_BYTES) != hipSuccess) { fprintf(stderr, "kernel_launch: hipFuncSetAttribute failed\n"); grid = -1; return; }
        if (hipOccupancyMaxActiveBlocksPerMultiprocessor(&per_cu, (const void*)hybrid_fwd, NWAVES * 64, LDS_BYTES) != hipSuccess || per_cu < 1) fprintf(stderr, "kernel_launch: occupancy query says %d\n", per_cu);
        (void)hipGetLastError();
        grid = cus;
    }
    if (grid < 0) return;
    if (hipMemsetAsync((char*)d_ws + WS_CTL, 0, CTL_ZERO_BYTES, stream) != hipSuccess) return;
    Args a{};
    for (int i = 0; i < 22; ++i) a.in[i] = (const float*)d_in[i];
    a.out = (float*)d_out; a.ws = (unsigned char*)d_ws; a.dup = 0; a.pad = 0;
#if MK_ONE_LAUNCH
    a.ph_lo = 0; a.ph_hi = NPHASES;
    hipLaunchKernelGGL(hybrid_fwd, dim3(grid), dim3(NWAVES * 64), LDS_BYTES, stream, a);
#else
    for (int p = 0; p < NPHASES; ++p) { a.ph_lo = p; a.ph_hi = p + 1;
        const int k = p < NPH_PRO ? 0 : 1 + (p - NPH_PRO) % NPH_LAYER; if (p == 0 && k == 0) { hipLaunchKernelGGL(hybrid_fwd, dim3(grid), dim3(NWAVES * 64), LDS_BYTES, stream, a); continue; }
        if ((DUPMASK >> k) & 1) { a.dup = 1; hipLaunchKernelGGL(hybrid_fwd, dim3(grid), dim3(NWAVES * 64), LDS_BYTES, stream, a); a.dup = 0; }
        hipLaunchKernelGGL(hybrid_fwd, dim3(grid), dim3(NWAVES * 64), LDS_BYTES, stream, a); }
#endif
}
```

```cpp
#include <hip/hip_runtime.h>
#include <cstdio>
#include <cstdint>
namespace pg8 {
#define PG8_LAS __attribute__((address_space(3)))
typedef unsigned short bf16_t;
typedef short bf16x8 __attribute__((ext_vector_type(8)));
typedef float f32x4 __attribute__((ext_vector_type(4)));
typedef unsigned u32x4 __attribute__((ext_vector_type(4)));
typedef int i32x4 __attribute__((ext_vector_type(4)));
constexpr int BM = 256, BK = 64, HALF = 128, HTB = HALF * BK * 2  , STAGE_BYTES = 8 * HTB, NXCD = 8, WGM = 4;

__host__ __device__ __forceinline__ int lds_byte(int r, int c) { const int st = (r >> 4) * 2 + (c >> 5), rr = r & 15, cc = c & 31, ob = rr * 64 + cc * 2; return st * 1024 + (ob ^ (((ob >> 9) & 1) << 5)); }
__host__ __device__ __forceinline__ void stage_rc(int b, int& R, int& C) { const int st = b / 1024, sb = b % 1024, swz = sb ^ (((sb >> 9) & 1) << 5); R = (st >> 1) * 16 + swz / 64; C = (st & 1) * 32 + (swz % 64) / 2; }
__host__ __device__ __forceinline__ int perm32(int rho) { const int n = rho >> 4, i = rho & 15; return 8 * (i >> 2) + 4 * n + (i & 3); }

struct Unit { int pm, pn; };
struct Gemm { const bf16_t* A; const bf16_t* Bt; int M, N, K; };

struct StaticOrder {
    int nM, nN, nwg, G, c;
    __host__ __device__ void init(int M, int N, int G_, int c_) { nM = M / BM; nN = N / BM; nwg = nM * nN; G = G_; c = c_; }
    __host__ __device__ bool next(int i, Unit& u) const {
        const long L = (long)i * G + c; if (L >= nwg) return false;
        int wgid = (int)L; { const int q = nwg / NXCD, r = nwg % NXCD, xcd = wgid % NXCD, off = wgid / NXCD; wgid = (xcd < r ? xcd * (q + 1) : r * (q + 1) + (xcd - r) * q) + off; }
        const int nig = WGM * nN, gid = wgid / nig, fm = gid * WGM, gsz = (nM - fm) < WGM ? (nM - fm) : WGM;
        u.pm = fm + ((wgid % nig) % gsz); u.pn = (wgid % nig) / gsz; return true;
    }
    __device__ __forceinline__ void a_ready(const Unit&) const {}
    __device__ __forceinline__ void done(const Unit&) const {}
};
struct LocalOrder {
    int nN, nloc, rank, xi, nx, nbo;
    __host__ __device__ void init(int N, int nloc_, int rank_, int xi_, int nx_) { nN = N / BM; nloc = nloc_; rank = rank_; xi = xi_; nx = nx_; nbo = (8 - xi + nx - 1) / nx; }
    __host__ __device__ bool next(int i, Unit& u) const {
        const int per = 8 * nN, j = i * nloc + rank; if (j >= nbo * per) return false;
        const int bi = j / per, jj = j % per, b = xi + bi * nx;
        const int nig = WGM * nN, gid = jj / nig, fm = gid * WGM;
        u.pm = 8 * b + fm + (jj % nig) % WGM; u.pn = (jj % nig) / WGM; return true;
    }
    __device__ __forceinline__ void a_ready(const Unit&) const {}
    __device__ __forceinline__ void done(const Unit&) const {}
};
struct LocalWindow : LocalOrder {
    int lo, hi;
    __host__ __device__ bool next(int i, Unit& u) const { return (i + lo < hi) && LocalOrder::next(i + lo, u); }
};

__device__ __forceinline__ unsigned cvt_pk_bf16(float lo, float hi) { unsigned r; asm volatile("v_cvt_pk_bf16_f32 %0, %1, %2" : "=v"(r) : "v"(lo), "v"(hi)); return r; }
__device__ __forceinline__ float bflo(unsigned w) { return __uint_as_float(w << 16); }
__device__ __forceinline__ float bfhi(unsigned w) { return __uint_as_float(w & 0xffff0000u); }
__device__ __forceinline__ float sigmoidf_fast(float x) { return __builtin_amdgcn_rcpf(1.0f + __expf(-x)); }
__device__ __forceinline__ u32x4 pack8(const f32x4 v0, const f32x4 v1) { u32x4 w; w.x = cvt_pk_bf16(v0[0], v0[1]); w.y = cvt_pk_bf16(v0[2], v0[3]); w.z = cvt_pk_bf16(v1[0], v1[1]); w.w = cvt_pk_bf16(v1[2], v1[3]); return w; }

struct EpiBf16Plain {
    static constexpr bool PERM = true, AFTER_DRAIN = false, I8 = false; typedef f32x4 acc_t;
    bf16_t* O; int ldc;
    __device__ __forceinline__ void operator()(const f32x4 (&acc)[2][2][4][2], const Unit& u, int wr, int wc, int fr, int fq) const {
        const int row0 = u.pm * BM + wr * 64 + fr, col0 = u.pn * BM + wc * 32 + 8 * fq;
#pragma unroll
        for (int ai = 0; ai < 2; ++ai)
#pragma unroll
            for (int m = 0; m < 4; ++m) { bf16_t* rowp = O + (size_t)(row0 + ai * HALF + m * 16) * ldc + col0;
#pragma unroll
                for (int bj = 0; bj < 2; ++bj) *(u32x4*)(rowp + bj * HALF) = pack8(acc[ai][bj][m][0], acc[ai][bj][m][1]); }
    }
};
struct EpiBf16Plain8 {
    static constexpr bool PERM = true, AFTER_DRAIN = false, I8 = true; typedef i32x4 acc_t;
    bf16_t* O; int ldc; const float *xs, *wsc;
    __device__ __forceinline__ void operator()(const i32x4 (&acc)[2][2][4][2], const Unit& u, int wr, int wc, int fr, int fq) const {
        const int row0 = u.pm * BM + wr * 64 + fr, col0 = u.pn * BM + wc * 32 + 8 * fq;
#pragma unroll
        for (int ai = 0; ai < 2; ++ai)
#pragma unroll
            for (int m = 0; m < 4; ++m) { bf16_t* rowp = O + (size_t)(row0 + ai * HALF + m * 16) * ldc + col0; const float rs = xs[row0 + ai * HALF + m * 16];
#pragma unroll
                for (int bj = 0; bj < 2; ++bj) { const f32x4 c0 = *(const f32x4*)(wsc + col0 + bj * HALF), c1 = *(const f32x4*)(wsc + col0 + bj * HALF + 4); f32x4 v0, v1;
#pragma unroll
                    for (int i = 0; i < 4; ++i) { v0[i] = (float)acc[ai][bj][m][0][i] * (rs * c0[i]); v1[i] = (float)acc[ai][bj][m][1][i] * (rs * c1[i]); }
                    *(u32x4*)(rowp + bj * HALF) = pack8(v0, v1); } }
    }
};
struct EpiIn {
    static constexpr bool PERM = true, AFTER_DRAIN = false, I8 = false; typedef f32x4 acc_t;
    bf16_t *Q, *KB, *VT, *U, *GA, *GS;
    __device__ __forceinline__ void operator()(const f32x4 (&acc)[2][2][4][2], const Unit& u, int wr, int wc, int fr, int fq) const {
        const int row0 = u.pm * BM + wr * 64 + fr, colw = wc * 32 + 8 * fq; const int pn = u.pn;
        if (pn >= 10 && pn < 12) {
#pragma unroll
            for (int ai = 0; ai < 2; ++ai)
#pragma unroll
                for (int m = 0; m < 4; ++m) { const int row = row0 + ai * HALF + m * 16; const int b = row >> 11, s = row & 2047;
#pragma unroll
                    for (int bj = 0; bj < 2; ++bj) { const int vcol = (pn - 10) * 256 + bj * HALF + colw;
                        bf16_t* base = VT + ((size_t)((b * 4 + (vcol >> 7)) * 128 + (vcol & 127))) * 2048 + s;
#pragma unroll
                        for (int n = 0; n < 2; ++n)
#pragma unroll
                            for (int i = 0; i < 4; ++i) { const unsigned w = cvt_pk_bf16(acc[ai][bj][m][n][i], 0.f); base[(size_t)(4 * n + i) * 2048] = (bf16_t)(w & 0xffffu); } } }
            return;
        }
        bf16_t* O; int ldc, colt; int mode;
        if (pn < 8) { O = Q; ldc = 2048; colt = pn * 256; mode = 1; }
        else if (pn < 10) { O = KB; ldc = 512; colt = (pn - 8) * 256; mode = 0; }
        else if (pn < 16) { O = U; ldc = 1024; colt = (pn - 12) * 256; mode = 0; }
        else if (pn < 32) { O = GA; ldc = 4096; colt = (pn - 16) * 256; mode = 2; }
        else { O = GS; ldc = 4096; colt = (pn - 32) * 256; mode = 2; }
        const float sc = (mode == 1) ? 0.08838834764831845f : 1.0f;
#pragma unroll
        for (int ai = 0; ai < 2; ++ai)
#pragma unroll
            for (int m = 0; m < 4; ++m) { bf16_t* rowp = O + (size_t)(row0 + ai * HALF + m * 16) * ldc + colt + colw;
#pragma unroll
                for (int bj = 0; bj < 2; ++bj) { f32x4 v0 = acc[ai][bj][m][0], v1 = acc[ai][bj][m][1];
                    if (mode == 2) {
#pragma unroll
                        for (int i = 0; i < 4; ++i) { v0[i] = sigmoidf_fast(v0[i]); v1[i] = sigmoidf_fast(v1[i]); } }
                    else { v0 = v0 * sc; v1 = v1 * sc; }
                    *(u32x4*)(rowp + bj * HALF) = pack8(v0, v1); } }
    }
};
struct EpiIn8 {
    static constexpr bool PERM = true, AFTER_DRAIN = false, I8 = true; typedef i32x4 acc_t;
    bf16_t *Q, *KB, *VT, *U, *GA, *GS; const float *xs, *wsc;
    __device__ __forceinline__ void operator()(const i32x4 (&acc)[2][2][4][2], const Unit& u, int wr, int wc, int fr, int fq) const {
        const int row0 = u.pm * BM + wr * 64 + fr, colw = wc * 32 + 8 * fq; const int pn = u.pn;
        if (pn >= 10 && pn < 12) {
#pragma unroll
            for (int ai = 0; ai < 2; ++ai)
#pragma unroll
                for (int m = 0; m < 4; ++m) { const int row = row0 + ai * HALF + m * 16; const int b = row >> 11, s = row & 2047;
#pragma unroll
                    for (int bj = 0; bj < 2; ++bj) { const int vcol = (pn - 10) * 256 + bj * HALF + colw;
                        const float rs = xs[row]; const f32x4 c0 = *(const f32x4*)(wsc + pn * 256 + bj * HALF + colw), c1 = *(const f32x4*)(wsc + pn * 256 + bj * HALF + colw + 4);
                        bf16_t* base = VT + ((size_t)((b * 4 + (vcol >> 7)) * 128 + (vcol & 127))) * 2048 + s;
#pragma unroll
                        for (int n = 0; n < 2; ++n)
#pragma unroll
                            for (int i = 0; i < 4; ++i) { const unsigned w = cvt_pk_bf16((float)acc[ai][bj][m][n][i] * rs * (n ? c1[i] : c0[i]), 0.f); base[(size_t)(4 * n + i) * 2048] = (bf16_t)(w & 0xffffu); } } }
            return;
        }
        bf16_t* O; int ldc, colt; int mode;
        if (pn < 8) { O = Q; ldc = 2048; colt = pn * 256; mode = 1; }
        else if (pn < 10) { O = KB; ldc = 512; colt = (pn - 8) * 256; mode = 0; }
        else if (pn < 16) { O = U; ldc = 1024; colt = (pn - 12) * 256; mode = 0; }
        else if (pn < 32) { O = GA; ldc = 4096; colt = (pn - 16) * 256; mode = 2; }
        else { O = GS; ldc = 4096; colt = (pn - 32) * 256; mode = 2; }
        const float sc = (mode == 1) ? 0.08838834764831845f : 1.0f;
#pragma unroll
        for (int ai = 0; ai < 2; ++ai)
#pragma unroll
            for (int m = 0; m < 4; ++m) { bf16_t* rowp = O + (size_t)(row0 + ai * HALF + m * 16) * ldc + colt + colw; const float rs = xs[row0 + ai * HALF + m * 16];
#pragma unroll
                for (int bj = 0; bj < 2; ++bj) { const f32x4 c0 = *(const f32x4*)(wsc + pn * 256 + bj * HALF + colw), c1 = *(const f32x4*)(wsc + pn * 256 + bj * HALF + colw + 4);
                    f32x4 v0, v1;
#pragma unroll
                    for (int i = 0; i < 4; ++i) { v0[i] = (float)acc[ai][bj][m][0][i] * (rs * c0[i]); v1[i] = (float)acc[ai][bj][m][1][i] * (rs * c1[i]); }
                    if (mode == 2) {
                        unsigned w0 = 0, w1 = 0;
#pragma unroll
                        for (int i = 0; i < 4; ++i) { w0 |= (unsigned)(int)rintf(255.0f * sigmoidf_fast(v0[i])) << (8 * i); w1 |= (unsigned)(int)rintf(255.0f * sigmoidf_fast(v1[i])) << (8 * i); }
                        typedef unsigned u32x2_t __attribute__((ext_vector_type(2))); u32x2_t w; w.x = w0; w.y = w1;
                        *(u32x2_t*)((unsigned char*)O + (size_t)(row0 + ai * HALF + m * 16) * ldc + colt + colw + bj * HALF) = w; }
                    else { v0 = v0 * sc; v1 = v1 * sc; *(u32x4*)(rowp + bj * HALF) = pack8(v0, v1); } } }
    }
};
struct EpiGlu {
    static constexpr bool PERM = true, AFTER_DRAIN = false, I8 = false; typedef f32x4 acc_t;
    bf16_t* O; int ldc;
    __device__ __forceinline__ void operator()(const f32x4 (&acc)[2][2][4][2], const Unit& u, int wr, int wc, int fr, int fq) const {
        const int row0 = u.pm * BM + wr * 64 + fr, col0 = u.pn * HALF + wc * 32 + 8 * fq;
#pragma unroll
        for (int ai = 0; ai < 2; ++ai)
#pragma unroll
            for (int m = 0; m < 4; ++m) { f32x4 v0 = acc[ai][0][m][0], v1 = acc[ai][0][m][1]; const f32x4 g0 = acc[ai][1][m][0], g1 = acc[ai][1][m][1];
#pragma unroll
                for (int i = 0; i < 4; ++i) { v0[i] *= sigmoidf_fast(g0[i]); v1[i] *= sigmoidf_fast(g1[i]); }
                *(u32x4*)(O + (size_t)(row0 + ai * HALF + m * 16) * ldc + col0) = pack8(v0, v1); }
    }
};
template <bool ADD> struct EpiGate {
    static constexpr bool PERM = true, AFTER_DRAIN = false, I8 = false; typedef f32x4 acc_t;
    bf16_t* O; const bf16_t* G; int ldc;
    __device__ __forceinline__ void operator()(const f32x4 (&acc)[2][2][4][2], const Unit& u, int wr, int wc, int fr, int fq) const {
        const int row0 = u.pm * BM + wr * 64 + fr, col0 = u.pn * BM + wc * 32 + 8 * fq;
#pragma unroll
        for (int ai = 0; ai < 2; ++ai)
#pragma unroll
            for (int m = 0; m < 4; ++m) { const size_t off = (size_t)(row0 + ai * HALF + m * 16) * ldc + col0;
#pragma unroll
                for (int bj = 0; bj < 2; ++bj) { const u32x4 g = *(const u32x4*)(G + off + bj * HALF); f32x4 v0 = acc[ai][bj][m][0], v1 = acc[ai][bj][m][1];
                    v0[0] *= bflo(g.x); v0[1] *= bfhi(g.x); v0[2] *= bflo(g.y); v0[3] *= bfhi(g.y); v1[0] *= bflo(g.z); v1[1] *= bfhi(g.z); v1[2] *= bflo(g.w); v1[3] *= bfhi(g.w);
                    if (ADD) { const u32x4 o = *(const u32x4*)(O + off + bj * HALF);
                        v0[0] += bflo(o.x); v0[1] += bfhi(o.x); v0[2] += bflo(o.y); v0[3] += bfhi(o.y); v1[0] += bflo(o.z); v1[1] += bfhi(o.z); v1[2] += bflo(o.w); v1[3] += bfhi(o.w); }
                    *(u32x4*)(O + off + bj * HALF) = pack8(v0, v1); }
                asm volatile("" ::: "memory"); }
    }
};
template <bool ADD> struct EpiGate8 {
    static constexpr bool PERM = true, AFTER_DRAIN = false, I8 = true; typedef i32x4 acc_t;
    bf16_t* O; const bf16_t* G; int ldc; const float *xs, *wsc;
    __device__ __forceinline__ void operator()(const i32x4 (&acc)[2][2][4][2], const Unit& u, int wr, int wc, int fr, int fq) const {
        const int row0 = u.pm * BM + wr * 64 + fr, col0 = u.pn * BM + wc * 32 + 8 * fq;
        f32x4 cs[2][2];
#pragma unroll
        for (int bj = 0; bj < 2; ++bj) { cs[bj][0] = *(const f32x4*)(wsc + col0 + bj * HALF); cs[bj][1] = *(const f32x4*)(wsc + col0 + bj * HALF + 4); }
        typedef unsigned u32x2_t __attribute__((ext_vector_type(2))); const unsigned char* G8 = (const unsigned char*)G;
        u32x2_t gcur[2], gnxt[2]; u32x4 ocur[2], onxt[2]; float rcur, rnxt;
        { const size_t off = (size_t)row0 * ldc + col0; gcur[0] = *(const u32x2_t*)(G8 + off); gcur[1] = *(const u32x2_t*)(G8 + off + HALF); if (ADD) { ocur[0] = *(const u32x4*)(O + off); ocur[1] = *(const u32x4*)(O + off + HALF); } rcur = xs[row0]; }
#pragma unroll
        for (int it = 0; it < 8; ++it) { const int ai = it >> 2, m = it & 3; const size_t off = (size_t)(row0 + ai * HALF + m * 16) * ldc + col0;
            if (it + 1 < 8) { const int ai2 = (it + 1) >> 2, m2 = (it + 1) & 3; const int r2 = row0 + ai2 * HALF + m2 * 16; const size_t off2 = (size_t)r2 * ldc + col0;
                gnxt[0] = *(const u32x2_t*)(G8 + off2); gnxt[1] = *(const u32x2_t*)(G8 + off2 + HALF); if (ADD) { onxt[0] = *(const u32x4*)(O + off2); onxt[1] = *(const u32x4*)(O + off2 + HALF); } rnxt = xs[r2]; }
            asm volatile("" ::: "memory");
#pragma unroll
            for (int bj = 0; bj < 2; ++bj) { const u32x2_t g = gcur[bj]; f32x4 v0, v1; constexpr float k255 = 1.0f / 255.0f;
#pragma unroll
                for (int i = 0; i < 4; ++i) { v0[i] = (float)acc[ai][bj][m][0][i] * (rcur * cs[bj][0][i]); v1[i] = (float)acc[ai][bj][m][1][i] * (rcur * cs[bj][1][i]); }
#pragma unroll
                for (int i = 0; i < 4; ++i) { v0[i] *= (float)((g.x >> (8 * i)) & 0xffu) * k255; v1[i] *= (float)((g.y >> (8 * i)) & 0xffu) * k255; }
                if (ADD) { const u32x4 o = ocur[bj];
                    v0[0] += bflo(o.x); v0[1] += bfhi(o.x); v0[2] += bflo(o.y); v0[3] += bfhi(o.y); v1[0] += bflo(o.z); v1[1] += bfhi(o.z); v1[2] += bflo(o.w); v1[3] += bfhi(o.w); }
                *(u32x4*)(O + off + bj * HALF) = pack8(v0, v1); }
            asm volatile("" ::: "memory");
            if (it + 1 < 8) { gcur[0] = gnxt[0]; gcur[1] = gnxt[1]; if (ADD) { ocur[0] = onxt[0]; ocur[1] = onxt[1]; } rcur = rnxt; }
        }
    }
};
struct EpiRes8 {
    static constexpr bool PERM = true, AFTER_DRAIN = false, I8 = true; typedef i32x4 acc_t;
    const float* base32; const bf16_t* base16; bf16_t* out; int ldc; const float *xs, *wsc;
    __device__ __forceinline__ void operator()(const i32x4 (&acc)[2][2][4][2], const Unit& u, int wr, int wc, int fr, int fq) const {
        const int row0 = u.pm * BM + wr * 64 + fr, col0 = u.pn * BM + wc * 32 + 8 * fq;
        f32x4 cs[2][2];
#pragma unroll
        for (int bj = 0; bj < 2; ++bj) { cs[bj][0] = *(const f32x4*)(wsc + col0 + bj * HALF); cs[bj][1] = *(const f32x4*)(wsc + col0 + bj * HALF + 4); }
#pragma unroll
        for (int ai = 0; ai < 2; ++ai)
#pragma unroll
            for (int m = 0; m < 4; ++m) { const size_t off = (size_t)(row0 + ai * HALF + m * 16) * ldc + col0; const float rs = xs[row0 + ai * HALF + m * 16];
#pragma unroll
                for (int bj = 0; bj < 2; ++bj) { f32x4 b0, b1;
                    if (base32) { b0 = *(const f32x4*)(base32 + off + bj * HALF); b1 = *(const f32x4*)(base32 + off + bj * HALF + 4); }
                    else { const u32x4 t = *(const u32x4*)(base16 + off + bj * HALF); b0 = (f32x4){bflo(t.x), bfhi(t.x), bflo(t.y), bfhi(t.y)}; b1 = (f32x4){bflo(t.z), bfhi(t.z), bflo(t.w), bfhi(t.w)}; }
                    f32x4 v0, v1;
#pragma unroll
                    for (int i = 0; i < 4; ++i) { v0[i] = b0[i] + (float)acc[ai][bj][m][0][i] * (rs * cs[bj][0][i]); v1[i] = b1[i] + (float)acc[ai][bj][m][1][i] * (rs * cs[bj][1][i]); }
                    *(u32x4*)(out + off + bj * HALF) = pack8(v0, v1); } }
    }
};
struct EpiRes {
    static constexpr bool PERM = false, AFTER_DRAIN = false, I8 = false; typedef f32x4 acc_t;
    const float* base; float* out; int ldc;
    __device__ __forceinline__ void operator()(const f32x4 (&acc)[2][2][4][2], const Unit& u, int wr, int wc, int fr, int fq) const {
        const int row0 = u.pm * BM + wr * 64 + fr, col0 = u.pn * BM + wc * 32 + 4 * fq;
#pragma unroll
        for (int ai = 0; ai < 2; ++ai)
#pragma unroll
            for (int m = 0; m < 4; ++m) { const size_t off = (size_t)(row0 + ai * HALF + m * 16) * ldc + col0;
#pragma unroll
                for (int bj = 0; bj < 2; ++bj)
#pragma unroll
                    for (int n = 0; n < 2; ++n) { const f32x4 bs = *(const f32x4*)(base + off + bj * HALF + n * 16); *(f32x4*)(out + off + bj * HALF + n * 16) = bs + acc[ai][bj][m][n]; } }
    }
};

__device__ __forceinline__ f32x4 mma16(const bf16x8& b, const bf16x8& a, const f32x4& c) { return __builtin_amdgcn_mfma_f32_16x16x32_bf16(b, a, c, 0, 0, 0); }
__device__ __forceinline__ i32x4 mma16(const bf16x8& b, const bf16x8& a, const i32x4& c) { return __builtin_amdgcn_mfma_i32_16x16x64_i8(__builtin_bit_cast(i32x4, b), __builtin_bit_cast(i32x4, a), c, 0, 0, 0); }
template <class Epi, class Sched, bool ALIGN_EPI = false, bool SP2 = false>
__device__ __forceinline__ void gemm_phase(PG8_LAS unsigned char* lds, const Gemm g, const Sched& S, const Epi& E) {
    int tid = threadIdx.x; asm volatile("" : "+v"(tid));
    const int wid = __builtin_amdgcn_readfirstlane(tid >> 6), lane = tid & 63, wr = wid >> 2, wc = wid & 3, fr = lane & 15, fq = lane >> 4;
    const int K = g.K, nt = K / BK;
    unsigned voffA[2], voffB[2];
#pragma unroll
    for (int i = 0; i < 2; ++i) { int R, C; stage_rc(tid * 16 + i * 8192, R, C); const int Rb = Epi::PERM ? ((R & ~31) + perm32(R & 31)) : R;
        voffA[i] = (unsigned)(R * K + C) * 2u; voffB[i] = (unsigned)(Rb * K + C) * 2u; }
    const size_t kstep = (size_t)(BK * 2);
    const size_t hstep = (size_t)HALF * K * 2;
    const size_t tstep = 2 * hstep;
    const unsigned ldsw = (unsigned)wid * 1024u;
    const int aoff = lds_byte(wr * 64 + fr, fq * 8), boff = lds_byte(wc * 32 + fr, fq * 8);
#define PG8_SA(b, h) (((b) * 2 + (h)) * HTB)
#define PG8_SB(b, h) ((4 + (b) * 2 + (h)) * HTB)
#define PG8_STAGE(bufoff, gbase, voff) do { _Pragma("unroll") for (int _i = 0; _i < 2; ++_i) \
        __builtin_amdgcn_global_load_lds((const unsigned*)((const char*)(gbase) + (voff)[_i]), (PG8_LAS unsigned*)(lds + (bufoff) + ldsw + _i * 8192), 16, 0, 0); } while (0)
#define PG8_LDA(dst, b, h) do { _Pragma("unroll") for (int m = 0; m < 4; ++m) _Pragma("unroll") for (int k = 0; k < 2; ++k) dst[m][k] = *(const PG8_LAS bf16x8*)(lds + PG8_SA(b, h) + aoff + m * 2048 + k * 1024); } while (0)
#define PG8_LDB(dst, b, h) do { _Pragma("unroll") for (int n = 0; n < 2; ++n) _Pragma("unroll") for (int k = 0; k < 2; ++k) dst[n][k] = *(const PG8_LAS bf16x8*)(lds + PG8_SB(b, h) + boff + n * 2048 + k * 1024); } while (0)
#define PG8_MMA(ai, bj, At, Bt) do { __builtin_amdgcn_s_setprio(1); _Pragma("unroll") for (int m = 0; m < 4; ++m) _Pragma("unroll") for (int n = 0; n < 2; ++n) _Pragma("unroll") for (int k = 0; k < 2; ++k) \
        acc[ai][bj][m][n] = mma16(Bt[n][k], At[m][k], acc[ai][bj][m][n]); __builtin_amdgcn_s_setprio(0); } while (0)
#define PG8_WAIT_V(n) asm volatile("s_waitcnt vmcnt(" #n ")" ::: "memory")
#define PG8_WAIT_L(n) asm volatile("s_waitcnt lgkmcnt(" #n ")" ::: "memory")
#define PG8_BAR __builtin_amdgcn_s_barrier()
#define PG8_SCHED __builtin_amdgcn_sched_barrier(0)
    Unit cur, nxt; int ui = 0;
    if (!S.next(0, cur)) return;
    typedef typename Epi::acc_t acc_t; acc_t acc[2][2][4][2];
#pragma unroll
    for (int a = 0; a < 2; ++a)
#pragma unroll
        for (int b = 0; b < 2; ++b)
#pragma unroll
            for (int m = 0; m < 4; ++m)
#pragma unroll
                for (int n = 0; n < 2; ++n) acc[a][b][m][n] = acc_t{};
    bf16x8 At[4][2], B0[2][2], B1[2][2];
    const char* cA = (const char*)g.A + (size_t)cur.pm * tstep; const char* cB = (const char*)g.Bt + (size_t)cur.pn * tstep;
    S.a_ready(cur);
    if constexpr (SP2) {
        PG8_STAGE(PG8_SB(0, 0), cB, voffB); PG8_STAGE(PG8_SB(0, 1), cB + hstep, voffB); PG8_STAGE(PG8_SA(0, 0), cA, voffA); PG8_STAGE(PG8_SA(0, 1), cA + hstep, voffA);
        if (wr == 1) PG8_BAR;
        PG8_WAIT_V(2); PG8_BAR;
        PG8_STAGE(PG8_SB(1, 0), cB + kstep, voffB); PG8_STAGE(PG8_SA(1, 0), cA + kstep, voffA); PG8_STAGE(PG8_SB(1, 1), cB + hstep + kstep, voffB);
        PG8_WAIT_V(6); PG8_BAR;
    } else {
        PG8_STAGE(PG8_SB(0, 0), cB, voffB); PG8_STAGE(PG8_SA(0, 0), cA, voffA); PG8_STAGE(PG8_SB(0, 1), cB + hstep, voffB); PG8_STAGE(PG8_SA(0, 1), cA + hstep, voffA);
        if (wr == 1) PG8_BAR;
        PG8_WAIT_V(4); PG8_BAR;
        PG8_STAGE(PG8_SB(1, 0), cB + kstep, voffB); PG8_STAGE(PG8_SA(1, 0), cA + kstep, voffA); PG8_STAGE(PG8_SB(1, 1), cB + hstep + kstep, voffB);
        PG8_WAIT_V(6); PG8_BAR;
    }
    for (;;) {
        const bool has_next = S.next(ui + 1, nxt);
        const char* nA = has_next ? (const char*)g.A + (size_t)nxt.pm * tstep : cA; const char* nB = has_next ? (const char*)g.Bt + (size_t)nxt.pn * tstep : cB;
        for (int t = 0; t < nt; t += 2) {
            const bool last = (t == nt - 2);
            const char* a1 = cA + (size_t)(t + 1) * kstep;
            const char* a2 = last ? nA : cA + (size_t)(t + 2) * kstep; const char* b2 = last ? nB : cB + (size_t)(t + 2) * kstep;
            const char* a3 = a2 + kstep; const char* b3 = b2 + kstep;
            if (last && has_next) S.a_ready(nxt);
            if constexpr (SP2) {
            PG8_LDB(B0, 0, 0); PG8_LDB(B1, 0, 1); PG8_SCHED; PG8_LDA(At, 0, 0); PG8_STAGE(PG8_SA(1, 1), a1 + hstep, voffA);
            PG8_WAIT_V(8); PG8_WAIT_L(0); PG8_BAR; PG8_MMA(0, 0, At, B0); PG8_MMA(0, 1, At, B1); PG8_BAR; PG8_SCHED;
            PG8_LDA(At, 0, 1); PG8_STAGE(PG8_SB(0, 0), b2, voffB); PG8_STAGE(PG8_SB(0, 1), b2 + hstep, voffB); PG8_STAGE(PG8_SA(0, 0), a2, voffA);
            PG8_WAIT_V(8); PG8_WAIT_L(0); PG8_BAR; PG8_MMA(1, 0, At, B0); PG8_MMA(1, 1, At, B1); PG8_BAR; PG8_SCHED;
            PG8_LDB(B0, 1, 0); PG8_LDB(B1, 1, 1); PG8_SCHED; PG8_LDA(At, 1, 0); PG8_STAGE(PG8_SA(0, 1), a2 + hstep, voffA);
            PG8_WAIT_V(8); PG8_WAIT_L(0); PG8_BAR; PG8_MMA(0, 0, At, B0); PG8_MMA(0, 1, At, B1); PG8_BAR; PG8_SCHED;
            PG8_LDA(At, 1, 1); PG8_STAGE(PG8_SB(1, 0), b3, voffB); PG8_STAGE(PG8_SB(1, 1), b3 + hstep, voffB); PG8_STAGE(PG8_SA(1, 0), a3, voffA);
            PG8_WAIT_V(8); PG8_WAIT_L(0); PG8_BAR; PG8_MMA(1, 0, At, B0); PG8_MMA(1, 1, At, B1); PG8_BAR; PG8_SCHED;
            } else {
            PG8_LDB(B0, 0, 0); PG8_SCHED; PG8_LDA(At, 0, 0); PG8_STAGE(PG8_SA(1, 1), a1 + hstep, voffA);
            PG8_WAIT_L(8); PG8_BAR; PG8_WAIT_L(0); PG8_MMA(0, 0, At, B0); PG8_BAR; PG8_SCHED;
            PG8_LDB(B1, 0, 1); PG8_STAGE(PG8_SB(0, 0), b2, voffB);
            PG8_BAR; PG8_WAIT_L(0); PG8_MMA(0, 1, At, B1); PG8_BAR;
            PG8_LDA(At, 0, 1); PG8_STAGE(PG8_SA(0, 0), a2, voffA);
            PG8_BAR; PG8_WAIT_L(0); PG8_MMA(1, 0, At, B0); PG8_BAR; PG8_SCHED;
            PG8_STAGE(PG8_SB(0, 1), b2 + hstep, voffB);
            PG8_WAIT_V(6); PG8_BAR; PG8_MMA(1, 1, At, B1); PG8_BAR;
            PG8_LDB(B0, 1, 0); PG8_SCHED; PG8_LDA(At, 1, 0); PG8_STAGE(PG8_SA(0, 1), a2 + hstep, voffA);
            PG8_WAIT_L(8); PG8_BAR; PG8_WAIT_L(0); PG8_MMA(0, 0, At, B0); PG8_BAR; PG8_SCHED;
            PG8_LDB(B1, 1, 1); PG8_STAGE(PG8_SB(1, 0), b3, voffB);
            PG8_BAR; PG8_WAIT_L(0); PG8_MMA(0, 1, At, B1); PG8_BAR;
            PG8_LDA(At, 1, 1); PG8_STAGE(PG8_SA(1, 0), a3, voffA);
            PG8_BAR; PG8_WAIT_L(0); PG8_MMA(1, 0, At, B0); PG8_BAR; PG8_SCHED;
            PG8_STAGE(PG8_SB(1, 1), b3 + hstep, voffB);
            PG8_WAIT_V(6); PG8_BAR; PG8_MMA(1, 1, At, B1); PG8_BAR;
            }
        }
        if constexpr (ALIGN_EPI) { if (wr == 0) PG8_BAR; }
        if constexpr (!Epi::AFTER_DRAIN) { E(acc, cur, wr, wc, fr, fq); S.done(cur); }
        if (!has_next) break;
#pragma unroll
        for (int a = 0; a < 2; ++a)
#pragma unroll
            for (int b = 0; b < 2; ++b)
#pragma unroll
                for (int m = 0; m < 4; ++m)
#pragma unroll
                    for (int n = 0; n < 2; ++n) acc[a][b][m][n] = acc_t{};
        cur = nxt; cA = nA; cB = nB; ++ui;
        if constexpr (ALIGN_EPI) { if (wr == 1) PG8_BAR; }
    }
    PG8_WAIT_V(0);
    if constexpr (!ALIGN_EPI) { if (wr == 0) PG8_BAR; }
    PG8_BAR;
    if constexpr (Epi::AFTER_DRAIN) { E.fused(acc, cur, wr, wc, fr, fq, lds, wid, lane); S.done(cur); }
#undef PG8_SA
#undef PG8_SB
#undef PG8_STAGE
#undef PG8_LDA
#undef PG8_LDB
#undef PG8_MMA
#undef PG8_WAIT_V
#undef PG8_WAIT_L
#undef PG8_BAR
#undef PG8_SCHED
}
}

constexpr int NWAVES = 8;
constexpr int DM = 4096, BATCH = 8, SEQ = 2048, DEPTH = 2, M = BATCH * SEQ;
constexpr int HD = 128, NQH = 16, NKVH = 4, ATTW = 2048, KVW = 512, SSMW = 1024, SSMG = 64, INCOLS = 12288;
constexpr int PH = 8, PDK = 256, NKEYS = 128, NEXP = 16384, PTOPK = 16, PSEL = PH * PTOPK;
constexpr float NORM_EPS = 1e-6f;
#ifndef MK_ONE_LAUNCH
#define MK_ONE_LAUNCH 1
#endif
constexpr int NPH_LAYER = 13, NPH_PRO = 2, NPHASES = NPH_PRO + DEPTH * NPH_LAYER;

constexpr size_t MiB = 1u << 20;
constexpr size_t WS_CTL = 0, CTL_ZERO_BYTES = 1 * MiB;
constexpr size_t LW_WIN = 0, LW_WAB = 96 * MiB, LW_WSB = 112 * MiB, LW_WOUT = 120 * MiB, LW_WGLU = 152 * MiB, LW_WPQ = 156 * MiB, LW_UTAB = 172 * MiB, LW_VTAB = 300 * MiB,
                 LW_KEYS = 428 * MiB, LW_S5K = 429 * MiB, LW_S5ME = 431 * MiB, LW_S5MC = 447 * MiB, LW_S5LAM = 463 * MiB, LW_SIZE = 464 * MiB;
constexpr size_t LW_WINS = LW_WIN + 48 * MiB, LW_WABS = LW_WAB + 8 * MiB, LW_WSBS = LW_WSB + 4 * MiB, LW_WOUTS = LW_WOUT + 16 * MiB, LW_WPQS = LW_WPQ + 8 * MiB;
constexpr size_t LW_SU = LW_UTAB + 64 * MiB, LW_SV = LW_VTAB + 64 * MiB, LW_VT4 = LW_VTAB + 72 * MiB, LW_S4 = LW_VTAB + 112 * MiB;
constexpr size_t WS_LW = 1 * MiB;
constexpr size_t WS_ACT = WS_LW + DEPTH * LW_SIZE;
constexpr size_t WS_XN = WS_ACT, WS_Q = WS_XN + 128 * MiB, WS_KB = WS_Q + 64 * MiB, WS_VT = WS_KB + 16 * MiB, WS_U = WS_VT + 16 * MiB, WS_GA = WS_U + 32 * MiB, WS_GS = WS_GA + 128 * MiB,
                 WS_ATT = WS_GS + 128 * MiB, WS_Z = WS_ATT + 64 * MiB, WS_SS = WS_Z + 32 * MiB, WS_MG = WS_SS + 32 * MiB, WS_PQ = WS_MG + 128 * MiB, WS_EID = WS_PQ + 64 * MiB,
                 WS_GATE = WS_EID + 8 * MiB, WS_HN = WS_GATE + 8 * MiB, WS_HN8 = WS_HN + 128 * MiB, WS_HS = WS_HN8 + 64 * MiB, WS_PAIRS = WS_HS + 1 * MiB, WS_SC = WS_PAIRS + 8 * MiB, WS_END = WS_SC + 8 * MiB;
static_assert(WS_END <= 2048 * MiB, "d_ws map exceeds the guaranteed 2 GiB");
constexpr int CW_TMO = 0, CW_CODE = 1, CW_BAR = 4096, CW_XRANK = 8192, CW_LBAR = 90112  , CW_CONV = 94208  , CW_COLMAX = 16384;
constexpr int CW_COLMAX2 = CW_COLMAX + DEPTH * INCOLS, CW_COLMAX3 = CW_COLMAX2 + DEPTH * 3 * DM;
static_assert((CW_COLMAX3 + DEPTH * 2048) * 4 <= (int)CTL_ZERO_BYTES, "CTL words inside the memset region");

constexpr int SCR_BYTES = 139264;
constexpr int LDSCTL_OFF = SCR_BYTES, MISC_OFF = LDSCTL_OFF + 320, LDS_BYTES = SCR_BYTES + 1024;
static_assert(MISC_OFF + 128 <= LDS_BYTES, "LDS map");
#define GAS __attribute__((address_space(1)))
#define LAS __attribute__((address_space(3)))
typedef unsigned short bf16;
typedef unsigned v4u __attribute__((ext_vector_type(4)));
typedef float f32x4 __attribute__((ext_vector_type(4)));
typedef short bf16x8 __attribute__((ext_vector_type(8)));
typedef GAS unsigned gu32;
typedef GAS unsigned long long gu64;
#define RLX_AGENT __ATOMIC_RELAXED, __HIP_MEMORY_SCOPE_AGENT
#define LDS_WAIT() asm volatile("s_waitcnt lgkmcnt(0)" ::: "memory")
#define VM_WAIT() asm volatile("s_waitcnt vmcnt(0)" ::: "memory")
__device__ __forceinline__ unsigned long long rt() { return __builtin_amdgcn_s_memrealtime(); }
__device__ __forceinline__ unsigned f2bf(float f) { unsigned u = __builtin_bit_cast(unsigned, f); return (u + 0x7fffu + ((u >> 16) & 1u)) >> 16; }
__device__ __forceinline__ unsigned pk2(float lo, float hi) { return f2bf(lo) | (f2bf(hi) << 16); }

#define XB_TMO      128
#define XB_XCNT(j)  (256  + 64 * (j))
#define XB_XSUB(j)  (1280 + 64 * (j))
#define XB_XGEN(j)  (2304 + 64 * (j))
#define XB_TOP      3328
#define XB_TOPGEN   3392
#define XCD_BAR_WORDS 3456
#define XB_SPIN_CAP (1u << 18)

__device__ __forceinline__ unsigned xb_ld(unsigned* p)              { return __hip_atomic_load(p, __ATOMIC_RELAXED, __HIP_MEMORY_SCOPE_AGENT); }
__device__ __forceinline__ unsigned xb_add(unsigned* p, unsigned v) { return __hip_atomic_fetch_add(p, v, __ATOMIC_RELAXED, __HIP_MEMORY_SCOPE_AGENT); }
__device__ __forceinline__ unsigned xb_xcc_id() { return (unsigned)__builtin_amdgcn_s_getreg((3 << 11) | 20) & 0xFu; }
#define XB_SPIN(cond, bar) do { unsigned _sp = 0; while (cond) { __builtin_amdgcn_s_sleep(1); \
    if ((++_sp & 255u) == 0u) { if (xb_ld(&(bar)[XB_TMO])) break; if (_sp > XB_SPIN_CAP) { atomicAdd(&(bar)[XB_TMO], 1u); break; } } } } while (0)

struct XcdBarrier {
    unsigned* bar; unsigned x;
    volatile LAS unsigned* st;
};

__device__ __forceinline__ XcdBarrier xcd_barrier_post(unsigned* bar, volatile LAS unsigned* st) {
    XcdBarrier b; b.bar = bar; b.x = xb_xcc_id(); b.st = st;
    if (threadIdx.x == 0) (void)xb_add(&bar[XB_XCNT(b.x)], 1u);
    return b;
}
__device__ __forceinline__ void xcd_barrier_complete(unsigned* bar, unsigned x, unsigned& nloc, unsigned& nx) {
    const unsigned G = gridDim.x * gridDim.y * gridDim.z;
    unsigned sum, cnt, mine, sp = 0u;
    for (;;) {
        sum = 0u; cnt = 0u; mine = 0u;
#pragma unroll
        for (unsigned j = 0; j < 16; ++j) { const unsigned c = xb_ld(&bar[XB_XCNT(j)]); sum += c; cnt += (c > 0u) ? 1u : 0u; mine = (j == x) ? c : mine; }
        if (sum == G) break;
        __builtin_amdgcn_s_sleep(1);
        if ((++sp & 255u) == 0u) { if (xb_ld(&bar[XB_TMO])) break; if (sp > XB_SPIN_CAP) { atomicAdd(&bar[XB_TMO], 1u); break; } }
    }
    nloc = mine > 0u ? mine : 1u; nx = cnt > 0u ? cnt : 1u;
}

__device__ __forceinline__ void xcd_barrier(const XcdBarrier& b) {
    asm volatile("s_waitcnt vmcnt(0)" ::: "memory");
    __syncthreads();
    if (threadIdx.x == 0) {
        unsigned* bar = b.bar; unsigned bx = b.x; asm volatile("" : "+s"(bx));
        __builtin_amdgcn_s_waitcnt(0);
        unsigned nloc = b.st[0], nx = b.st[1];
        if (nloc == 0u) { xcd_barrier_complete(bar, bx, nloc, nx); b.st[0] = nloc; b.st[1] = nx; }
        const unsigned old = xb_add(&bar[XB_XSUB(bx)], 1u);
        const unsigned gen = old / nloc;
        if (old + 1u == (gen + 1u) * nloc) {
            __builtin_amdgcn_fence(__ATOMIC_RELEASE, "agent");
            asm volatile("s_waitcnt vmcnt(0)" ::: "memory");
            const unsigned og = xb_add(&bar[XB_TOP], 1u);
            const unsigned tg = og / nx;
            if (og + 1u == (tg + 1u) * nx) xb_add(&bar[XB_TOPGEN], 1u);
            else XB_SPIN(xb_ld(&bar[XB_TOPGEN]) == tg, bar);
            __builtin_amdgcn_fence(__ATOMIC_ACQUIRE, "agent");
            xb_add(&bar[XB_XGEN(bx)], 1u);
            asm volatile("s_waitcnt vmcnt(0)" ::: "memory");
        } else {
            XB_SPIN(xb_ld(&bar[XB_XGEN(bx)]) == gen, bar);
            __builtin_amdgcn_fence(__ATOMIC_ACQUIRE, "agent");
            asm volatile("s_waitcnt vmcnt(0)" ::: "memory");
        }
    }
    __syncthreads();
}

typedef float f32x16 __attribute__((ext_vector_type(16)));
typedef float f32x2 __attribute__((ext_vector_type(2)));
typedef unsigned u32x2 __attribute__((ext_vector_type(2)));
typedef __bf16 bf16v2 __attribute__((ext_vector_type(2)));
typedef int i32x4 __attribute__((ext_vector_type(4)));
typedef int i32x2 __attribute__((ext_vector_type(2)));
__device__ __forceinline__ unsigned cvtpk(float lo, float hi) { unsigned r; asm volatile("v_cvt_pk_bf16_f32 %0, %1, %2" : "=v"(r) : "v"(lo), "v"(hi)); return r; }
__device__ __forceinline__ float bflo(unsigned w) { return __uint_as_float(w << 16); }
__device__ __forceinline__ float bfhi(unsigned w) { return __uint_as_float(w & 0xffff0000u); }
__device__ __forceinline__ float gelu_tanh(float x) { const float t = x + 0.044715f * x * x * x; return x * __builtin_amdgcn_rcpf(1.0f + __expf(-1.5957691216057308f * t)); }
__device__ __forceinline__ float dot2bf(unsigned a, unsigned b, float c) { return __builtin_amdgcn_fdot2_f32_bf16(__builtin_bit_cast(bf16v2, a), __builtin_bit_cast(bf16v2, b), c, false); }
#define DPP_I(v_, ctrl_) __builtin_amdgcn_update_dpp(0, (v_), (ctrl_), 0xF, 0xF, true)
#define DPP_F(v_, ctrl_) __builtin_bit_cast(float, __builtin_amdgcn_update_dpp(0, __builtin_bit_cast(int, (v_)), (ctrl_), 0xF, 0xF, true))
__device__ __forceinline__ int row16_sum(int v) { v += DPP_I(v, 0xB1); v += DPP_I(v, 0x4E); v += DPP_I(v, 0x141); v += DPP_I(v, 0x140); return v; }
__device__ __forceinline__ int wave_sum_i(int v) {
    v = row16_sum(v);
    v += __builtin_amdgcn_update_dpp(0, v, 0x142, 0xA, 0xF, false); v += __builtin_amdgcn_update_dpp(0, v, 0x143, 0xC, 0xF, false);
    return __builtin_amdgcn_readlane(v, 63);
}
__device__ __forceinline__ float wave_sum(float v) {
    v += DPP_F(v, 0xB1); v += DPP_F(v, 0x4E); v += DPP_F(v, 0x141); v += DPP_F(v, 0x140);
    v += __builtin_bit_cast(float, __builtin_amdgcn_update_dpp(0, __builtin_bit_cast(int, v), 0x142, 0xA, 0xF, false));
    v += __builtin_bit_cast(float, __builtin_amdgcn_update_dpp(0, __builtin_bit_cast(int, v), 0x143, 0xC, 0xF, false));
    return __builtin_bit_cast(float, __builtin_amdgcn_readlane(__builtin_bit_cast(int, v), 63));
}

struct Frame {
    LAS unsigned char* lds;
    volatile LAS unsigned* MISC;
    gu32* ctl;
    int tid, lane, wave, G;
    unsigned xcc, xrank, xi, nx, nloc;
    unsigned char* ws;
};

__device__ __forceinline__ void p0_transpose_item(const float* W, int K, int N, bf16* WT, bool glu, LAS float* scr, int item, int lane) {
    const int nblk = N / 32, kb = item / nblk, nb = item % nblk, k0 = 64 * kb, n0 = 32 * nb;
#pragma unroll 8
    for (int i = 0; i < 32; ++i) { const int kk = 2 * i + (lane >> 5); scr[kk * 33 + (lane & 31)] = W[(size_t)(k0 + kk) * N + n0 + (lane & 31)]; }
    LDS_WAIT(); asm volatile("" ::: "memory");
    const int c = lane & 7;
#pragma unroll
    for (int j = 0; j < 4; ++j) { const int n = (lane >> 3) + 8 * j; const LAS float* s = scr + (8 * c) * 33 + n;
        v4u o; o.x = cvtpk(s[0 * 33], s[1 * 33]); o.y = cvtpk(s[2 * 33], s[3 * 33]); o.z = cvtpk(s[4 * 33], s[5 * 33]); o.w = cvtpk(s[6 * 33], s[7 * 33]);
        int nrow = n0 + n; if (glu) { const int half = nrow >> 10, rem = nrow & 1023; nrow = (rem >> 7) * 256 + half * 128 + (rem & 127); }
        *(GAS v4u*)(WT + (size_t)nrow * K + k0 + 8 * c) = o; }
    LDS_WAIT(); asm volatile("" ::: "memory");
}
__device__ __forceinline__ void rms_row_to_bf16(const float* xrow, const float* g, bf16* orow, int lane) {
    const GAS f32x4* xr = (const GAS f32x4*)xrow + lane;
    f32x4 v[16]; float s = 0.f;
#pragma unroll
    for (int j = 0; j < 16; ++j) { v[j] = xr[64 * j]; s += (v[j].x * v[j].x + v[j].y * v[j].y) + (v[j].z * v[j].z + v[j].w * v[j].w); }
    const float rstd = 1.0f / sqrtf(wave_sum(s) * (1.f / DM) + NORM_EPS);
    const GAS f32x4* gr = (const GAS f32x4*)g + lane;
    GAS u32x2* o8 = (GAS u32x2*)orow + lane;
#pragma unroll
    for (int j = 0; j < 16; ++j) { const f32x4 gg = gr[64 * j]; u32x2 w; w.x = cvtpk(v[j].x * rstd * gg.x, v[j].y * rstd * gg.y); w.y = cvtpk(v[j].z * rstd * gg.z, v[j].w * rstd * gg.w); o8[64 * j] = w; }
}
__device__ __forceinline__ void s5_precompute(Frame& F, const float* a_re, const float* a_im, const float* log_step, const float* b_re, const float* b_im, const float* c_re, const float* c_im,
                                              int g, int half, bf16* KT, bf16* MEf, bf16* MCf, float* LAM) {
    LAS float* LPr = (LAS float*)F.lds; LAS float* LPi = LPr + 65 * 64; LAS float* Bbr = LPi + 65 * 64; LAS float* Bbi = Bbr + 1024; LAS float* Cr = Bbi + 1024; LAS float* Ci = Cr + 1024;
    const int tid = F.tid;
    { const float dt = expf(log_step[g]);
      for (int idx = tid; idx < 65 * 64; idx += 512) { const int t = idx >> 6, p = idx & 63; const float ar = a_re[g * 64 + p], ai = a_im[g * 64 + p];
          const float mag = expf(ar * dt * (float)t); float sn, cs; sincosf(ai * dt * (float)t, &sn, &cs); LPr[idx] = mag * cs; LPi[idx] = mag * sn; } }
    for (int i = tid; i < 1024; i += 512) { Cr[i] = c_re[g * 1024 + i]; Ci[i] = c_im[g * 1024 + i]; }
    __syncthreads();
    for (int i = tid; i < 1024; i += 512) { const int p = i >> 4, h = i & 15; const float ar = a_re[g * 64 + p], ai = a_im[g * 64 + p];
        const float lr = LPr[64 + p], li = LPi[64 + p], den = ar * ar + ai * ai, nr = lr - 1.0f;
        const float zr = (nr * ar + li * ai) / den, zi = (li * ar - nr * ai) / den;
        const float br = b_re[(g * 64 + p) * 16 + h], bi = b_im[(g * 64 + p) * 16 + h]; Bbr[i] = zr * br - zi * bi; Bbi[i] = zr * bi + zi * br; }
    if (half == 0 && tid < 64) { LAM[(g * 64 + tid) * 2] = LPr[64 * 64 + tid]; LAM[(g * 64 + tid) * 2 + 1] = LPi[64 * 64 + tid]; }
    __syncthreads();
    for (int o = half * 8192 + tid; o < half * 8192 + 8192; o += 512) { const int tau = o >> 8, h = (o >> 4) & 15, h2 = o & 15; float s = 0.f;
        for (int p = 0; p < 64; ++p) { const float cr = Cr[h * 64 + p], ci = Ci[h * 64 + p], lr = LPr[tau * 64 + p], li = LPi[tau * 64 + p]; const float wr = cr * lr - ci * li, wi = cr * li + ci * lr; s += wr * Bbr[p * 16 + h2] - wi * Bbi[p * 16 + h2]; }
        KT[(size_t)g * 16384 + o] = (bf16)(cvtpk(s, 0.f) & 0xffffu); }
    if (half == 0) for (int e = tid; e < 131072; e += 512) { const int j = e & 7, ln = (e >> 3) & 63, s = (e >> 9) & 63, mt = e >> 15; const int r = mt * 32 + (ln & 31), h = 8 * (ln >> 5) + j, p = r & 63;
        const float lr = LPr[(63 - s) * 64 + p], li = LPi[(63 - s) * 64 + p], br = Bbr[p * 16 + h], bi = Bbi[p * 16 + h]; const float v = (r < 64) ? (lr * br - li * bi) : (lr * bi + li * br);
        MEf[(size_t)g * 131072 + e] = (bf16)(cvtpk(v, 0.f) & 0xffffu); }
    if (half == 1) for (int e = tid; e < 131072; e += 512) { const int j = e & 7, ln = (e >> 3) & 63, kr = (e >> 9) & 7, mt = e >> 12; const int rr = ln & 31, t = 2 * mt + (rr >> 4), h = rr & 15, r = kr * 16 + 8 * (ln >> 5) + j, p = r & 63;
        const float cr = Cr[h * 64 + p], ci = Ci[h * 64 + p], lr = LPr[(t + 1) * 64 + p], li = LPi[(t + 1) * 64 + p]; const float v = (r < 64) ? (cr * lr - ci * li) : -(cr * li + ci * lr);
        MCf[(size_t)g * 131072 + e] = (bf16)(cvtpk(v, 0.f) & 0xffffu); }
    __syncthreads();
}

constexpr int ATT_KS_STRIDE = 272, ATT_VS_STRIDE = 528, ATT_VS_OFF = 256 * ATT_KS_STRIDE;
static_assert(ATT_VS_OFF + 128 * ATT_VS_STRIDE <= SCR_BYTES, "attention LDS");
__device__ __forceinline__ void attn_unit(Frame& F, int b, int nb, int kvh, const bf16* Q, const bf16* KB, const bf16* VT, bf16* ATT, const float* sinks) {
    int tid = F.tid; asm volatile("" : "+v"(tid)); const int lane = tid & 63, w = __builtin_amdgcn_readfirstlane(tid >> 6), r = lane & 31, hh = lane >> 5;
    LAS unsigned char* Ks = F.lds; LAS unsigned char* Vs = F.lds + ATT_VS_OFF;
    const int t0 = b * SEQ + nb * 128;
#pragma unroll
    for (int i = 0; i < 8; ++i) { const int idx = tid + 512 * i, j = idx >> 4, ch = idx & 15; int tk = t0 - 128 + j; if (nb == 0 && j < 128) tk = t0 + j;
        const v4u v = *(const GAS v4u*)(KB + (size_t)tk * KVW + kvh * 128 + ch * 8); *(LAS v4u*)(Ks + j * ATT_KS_STRIDE + ch * 16) = v; }
#pragma unroll
    for (int i = 0; i < 8; ++i) { const int idx = tid + 512 * i, d = idx >> 5, ch = idx & 31; int j0 = ch * 8; int srcj = nb * 128 - 128 + j0; if (nb == 0 && j0 < 128) srcj = j0;
        const v4u v = *(const GAS v4u*)(VT + ((size_t)((b * 4 + kvh) * 128 + d)) * SEQ + srcj); *(LAS v4u*)(Vs + d * ATT_VS_STRIDE + ch * 16) = v; }
    __syncthreads();
    const int hq = kvh * 4 + (w >> 1), hw = w & 1;
    const float slope = exp2f(-0.5f * (float)(hq + 1)), sink = sinks[hq];
#pragma unroll 1
    for (int qt = 0; qt < 2; ++qt) {
        const int qrow = hw * 64 + qt * 32 + r; const size_t tq = (size_t)(t0 + qrow);
        bf16x8 qf[8];
#pragma unroll
        for (int ks = 0; ks < 8; ++ks) qf[ks] = *(const GAS bf16x8*)(Q + tq * ATTW + hq * 128 + ks * 16 + 8 * hh);
        f32x16 S[6];
#pragma unroll
        for (int k6 = 0; k6 < 6; ++k6) { S[k6] = (f32x16){0.f};
            const int kt = 2 * hw + k6;
#pragma unroll
            for (int ks = 0; ks < 8; ++ks) { const bf16x8 a = *(const LAS bf16x8*)(Ks + (kt * 32 + r) * ATT_KS_STRIDE + ks * 32 + hh * 16); S[k6] = __builtin_amdgcn_mfma_f32_32x32x16_bf16(a, qf[ks], S[k6], 0, 0, 0); }
            asm volatile("" ::: "memory"); }
        float mx = sink;
#pragma unroll
        for (int k6 = 0; k6 < 6; ++k6)
#pragma unroll
            for (int rg = 0; rg < 16; ++rg) { const int j = (2 * hw + k6) * 32 + (rg & 3) + 8 * (rg >> 2) + 4 * hh; const int dist = qrow - j + 128;
                const bool valid = (dist >= 0) && (dist < 128) && (nb > 0 || j >= 128);
                const float lg = valid ? (S[k6][rg] - slope * (float)dist) : -1e30f; S[k6][rg] = lg; mx = fmaxf(mx, lg); }
        mx = fmaxf(mx, __shfl_xor(mx, 32));
        float sum = 0.f;
#pragma unroll
        for (int k6 = 0; k6 < 6; ++k6)
#pragma unroll
            for (int rg = 0; rg < 16; ++rg) { const float p = __expf(S[k6][rg] - mx); S[k6][rg] = p; sum += p; }
        sum += __shfl_xor(sum, 32); sum += __expf(sink - mx);
        const float inv = 1.0f / sum;
        f32x16 O[4];
#pragma unroll
        for (int dt = 0; dt < 4; ++dt) O[dt] = (f32x16){0.f};
#pragma unroll
        for (int k6 = 0; k6 < 6; ++k6)
#pragma unroll
            for (int s2 = 0; s2 < 2; ++s2) { v4u pw; pw.x = cvtpk(S[k6][8 * s2 + 0], S[k6][8 * s2 + 1]); pw.y = cvtpk(S[k6][8 * s2 + 2], S[k6][8 * s2 + 3]); pw.z = cvtpk(S[k6][8 * s2 + 4], S[k6][8 * s2 + 5]); pw.w = cvtpk(S[k6][8 * s2 + 6], S[k6][8 * s2 + 7]);
                const bf16x8 pb = __builtin_bit_cast(bf16x8, pw); const int key0 = (2 * hw + k6) * 32 + 16 * s2 + 4 * hh;
#pragma unroll
                for (int dt = 0; dt < 4; ++dt) { const LAS unsigned char* vp = Vs + (dt * 32 + r) * ATT_VS_STRIDE + key0 * 2; const u32x2 a0 = *(const LAS u32x2*)vp, a1 = *(const LAS u32x2*)(vp + 16);
                    v4u aw; aw.x = a0.x; aw.y = a0.y; aw.z = a1.x; aw.w = a1.y; O[dt] = __builtin_amdgcn_mfma_f32_32x32x16_bf16(__builtin_bit_cast(bf16x8, aw), pb, O[dt], 0, 0, 0); }
                asm volatile("" ::: "memory"); }
        bf16* orow = ATT + tq * ATTW + hq * 128;
#pragma unroll
        for (int dt = 0; dt < 4; ++dt)
#pragma unroll
            for (int g4 = 0; g4 < 4; ++g4) { u32x2 o; o.x = cvtpk(O[dt][4 * g4 + 0] * inv, O[dt][4 * g4 + 1] * inv); o.y = cvtpk(O[dt][4 * g4 + 2] * inv, O[dt][4 * g4 + 3] * inv);
                *(GAS u32x2*)(orow + dt * 32 + 8 * g4 + 4 * hh) = o; }
    }
    __syncthreads();
}

constexpr int S5_US_STRIDE = 2064, S5_ES_OFF = 32 * S5_US_STRIDE, S5_XS_OFF = S5_ES_OFF + 2 * 128 * 33 * 4, S5_XS_STRIDE = 272;
static_assert(S5_XS_OFF + 32 * S5_XS_STRIDE <= SCR_BYTES && 2 * 128 * 33 * 4 >= 32768, "S5 LDS");
__device__ __forceinline__ void s5_unit(Frame& F, int b, int g, const bf16* U, const bf16* KT, const bf16* MEf, const bf16* MCf, const float* LAM, const float* dskip, bf16* Z) {
    int tid = F.tid; asm volatile("" : "+v"(tid)); const int lane = tid & 63, w = __builtin_amdgcn_readfirstlane(tid >> 6), r = lane & 31, hh = lane >> 5;
    LAS unsigned char* Us = F.lds; LAS float* Es = (LAS float*)(F.lds + S5_ES_OFF); LAS unsigned char* Kt = F.lds + S5_ES_OFF; LAS unsigned char* Xs = F.lds + S5_XS_OFF;
#pragma unroll
    for (int i = 0; i < 8; ++i) { const int idx = tid + 512 * i, t = idx >> 1, half = idx & 1;
        const v4u v = *(const GAS v4u*)(U + ((size_t)(b * SEQ + t)) * SSMW + g * 16 + half * 8); *(LAS v4u*)(Us + (t >> 6) * S5_US_STRIDE + (t & 63) * 32 + half * 16) = v; }
    __syncthreads();
    {
        const int mtile = w & 3, sh = w >> 2; f32x16 acc = (f32x16){0.f};
        const bf16* mep = MEf + ((size_t)(g * 4 + mtile) * 64 + sh * 32) * 512 + lane * 8;
#pragma unroll 8
        for (int s2 = 0; s2 < 32; ++s2) { const bf16x8 a = *(const GAS bf16x8*)(mep + (size_t)s2 * 512);
            const bf16x8 bb = *(const LAS bf16x8*)(Us + r * S5_US_STRIDE + (sh * 32 + s2) * 32 + hh * 16); acc = __builtin_amdgcn_mfma_f32_32x32x16_bf16(a, bb, acc, 0, 0, 0); }
#pragma unroll
        for (int rg = 0; rg < 16; ++rg) { const int row = mtile * 32 + (rg & 3) + 8 * (rg >> 2) + 4 * hh; Es[(sh * 128 + row) * 33 + r] = acc[rg]; }
    }
    __syncthreads();
    if (tid < 64) {
        const int p = tid; const float lr = LAM[(g * 64 + p) * 2], li = LAM[(g * 64 + p) * 2 + 1]; float xr = 0.f, xi = 0.f;
        for (int c = 0; c < 32; ++c) {
            *(LAS bf16*)(Xs + c * S5_XS_STRIDE + p * 2) = (bf16)(cvtpk(xr, 0.f) & 0xffffu); *(LAS bf16*)(Xs + c * S5_XS_STRIDE + (64 + p) * 2) = (bf16)(cvtpk(xi, 0.f) & 0xffffu);
            const float er = Es[p * 33 + c] + Es[(128 + p) * 33 + c], ei = Es[(64 + p) * 33 + c] + Es[(128 + 64 + p) * 33 + c];
            const float nr = lr * xr - li * xi + er, ni = lr * xi + li * xr + ei; xr = nr; xi = ni; }
    }
    __syncthreads();
#pragma unroll
    for (int i = 0; i < 4; ++i) { const int idx = tid + 512 * i; *(LAS v4u*)(Kt + idx * 16) = *(const GAS v4u*)(KT + (size_t)g * 16384 + idx * 8); }
    __syncthreads();
#pragma unroll 1
    for (int q = 0; q < 4; ++q) {
        const int mt = (q == 0) ? w : (q == 1) ? 15 - w : (q == 2) ? 16 + w : 31 - w;
        const int tl = 2 * mt + (r >> 4), h = r & 15; f32x16 acc = (f32x16){0.f};
        for (int s = 0; s <= 2 * mt + 1; ++s) { const int tau = tl - s; const int tc = tau < 0 ? 0 : tau;
            bf16x8 a = *(const LAS bf16x8*)(Kt + tc * 512 + h * 32 + hh * 16); if (tau < 0) a = (bf16x8){0, 0, 0, 0, 0, 0, 0, 0};
            const bf16x8 bb = *(const LAS bf16x8*)(Us + r * S5_US_STRIDE + s * 32 + hh * 16); acc = __builtin_amdgcn_mfma_f32_32x32x16_bf16(a, bb, acc, 0, 0, 0); }
        const bf16* mcp = MCf + ((size_t)(g * 32 + mt) * 8) * 512 + lane * 8;
#pragma unroll
        for (int kr = 0; kr < 8; ++kr) { const bf16x8 a = *(const GAS bf16x8*)(mcp + (size_t)kr * 512);
            const bf16x8 bb = *(const LAS bf16x8*)(Xs + r * S5_XS_STRIDE + kr * 32 + hh * 16); acc = __builtin_amdgcn_mfma_f32_32x32x16_bf16(a, bb, acc, 0, 0, 0); }
#pragma unroll
        for (int g4 = 0; g4 < 4; ++g4) { const int ts = 2 * mt + (g4 >> 1), h0 = 8 * (g4 & 1) + 4 * hh;
            const u32x2 uu = *(const LAS u32x2*)(Us + r * S5_US_STRIDE + ts * 32 + h0 * 2); const f32x4 dd = *(const GAS f32x4*)(dskip + g * 16 + h0);
            const float y0 = acc[4 * g4 + 0] + dd.x * bflo(uu.x), y1 = acc[4 * g4 + 1] + dd.y * bfhi(uu.x), y2 = acc[4 * g4 + 2] + dd.z * bflo(uu.y), y3 = acc[4 * g4 + 3] + dd.w * bfhi(uu.y);
            u32x2 o; o.x = cvtpk(gelu_tanh(y0), gelu_tanh(y1)); o.y = cvtpk(gelu_tanh(y2), gelu_tanh(y3));
            *(GAS u32x2*)(Z + ((size_t)(b * SEQ + r * 64 + ts)) * SSMW + g * 16 + h0) = o; }
    }
    __syncthreads();
}

constexpr float NEGBIG = -3.0e38f;
template <int N> __device__ __forceinline__ void bitonic_sort_desc(float (&a)[N]) {
#pragma unroll
    for (int k = 2; k <= N; k <<= 1)
#pragma unroll
        for (int j = k >> 1; j > 0; j >>= 1)
#pragma unroll
            for (int i = 0; i < N; ++i) { const int l = i ^ j; if (l > i) { const bool up = ((i & k) == 0); const float hi = fmaxf(a[i], a[l]), lo = fminf(a[i], a[l]); a[i] = up ? hi : lo; a[l] = up ? lo : hi; } }
}
template <int N> __device__ __forceinline__ void bitonic_merge_desc(float (&a)[N]) {
#pragma unroll
    for (int j = N >> 1; j > 0; j >>= 1)
#pragma unroll
        for (int i = 0; i < N; ++i) { const int l = i ^ j; if (l > i) { const float hi = fmaxf(a[i], a[l]), lo = fminf(a[i], a[l]); a[i] = hi; a[l] = lo; } }
}
__device__ __forceinline__ void top16_merge(float (&a)[16], const float (&b)[16]) {
#pragma unroll
    for (int i = 0; i < 16; ++i) a[i] = fmaxf(a[i], b[15 - i]);
    bitonic_merge_desc<16>(a);
}
__device__ __forceinline__ void topk_task(int task, int lane, const bf16* PQ, const bf16* KEYS, int* EID, float* GATE, LAS unsigned char* wl) {
    asm volatile("" : "+v"(lane));
    const int tt = task >> 3, h = task & 7, r = lane & 31, hh = lane >> 5; const size_t token = (size_t)tt * 32 + r;
    float sv[2][16];
#pragma unroll
    for (int c = 0; c < 2; ++c) {
        bf16x8 qf[8];
#pragma unroll
        for (int ks = 0; ks < 8; ++ks) qf[ks] = *(const GAS bf16x8*)(PQ + token * (PH * PDK) + h * PDK + c * 128 + ks * 16 + 8 * hh);
        float g[4][16];
#pragma unroll
        for (int mt = 0; mt < 4; ++mt) { f32x16 acc = (f32x16){0.f};
#pragma unroll
            for (int ks = 0; ks < 8; ++ks) { const bf16x8 a = *(const GAS bf16x8*)(KEYS + ((size_t)((h * 2 + c) * 128 + mt * 32 + r)) * 128 + ks * 16 + 8 * hh); acc = __builtin_amdgcn_mfma_f32_32x32x16_bf16(a, qf[ks], acc, 0, 0, 0); }
#pragma unroll
            for (int rg = 0; rg < 16; ++rg) { const unsigned n = (unsigned)(mt * 32 + (rg & 3) + 8 * (rg >> 2) + 4 * hh); g[mt][rg] = __uint_as_float((__float_as_uint(acc[rg]) & ~127u) | n); }
            bitonic_sort_desc<16>(g[mt]); }
        top16_merge(g[0], g[1]); top16_merge(g[2], g[3]); top16_merge(g[0], g[2]);
        float u[16];
#pragma unroll
        for (int i = 0; i < 16; ++i) u[i] = fmaxf(g[0][i], __shfl_xor(g[0][15 - i], 32));
        bitonic_merge_desc<16>(u);
#pragma unroll
        for (int i = 0; i < 16; ++i) sv[c][i] = u[i];
    }
    { unsigned w[8];
#pragma unroll
      for (int d = 0; d < 8; ++d) { const int c = d >> 2, i0 = (d & 3) * 4; w[d] = (__float_as_uint(sv[c][i0]) & 127u) | ((__float_as_uint(sv[c][i0 + 1]) & 127u) << 8) | ((__float_as_uint(sv[c][i0 + 2]) & 127u) << 16) | ((__float_as_uint(sv[c][i0 + 3]) & 127u) << 24); }
      LAS unsigned* tp = (LAS unsigned*)(wl + lane * 36);
#pragma unroll
      for (int d = 0; d < 8; ++d) tp[d] = w[d]; }
    float cd[4][16];
    { int q = 0;
#pragma unroll
      for (int i = 0; i < 16; ++i)
#pragma unroll
        for (int j = 0; j < 16; ++j) if ((i + 1) * (j + 1) <= 16) {
            const float s = __uint_as_float(__float_as_uint(sv[0][i]) & ~127u) + __uint_as_float(__float_as_uint(sv[1][j]) & ~127u);
            cd[q >> 4][q & 15] = __uint_as_float((__float_as_uint(s) & ~255u) | (unsigned)((i << 4) | j)); ++q; }
#pragma unroll
      for (int p = 50; p < 64; ++p) cd[p >> 4][p & 15] = NEGBIG; }
#pragma unroll
    for (int t = 0; t < 4; ++t) bitonic_sort_desc<16>(cd[t]);
    top16_merge(cd[0], cd[1]); top16_merge(cd[2], cd[3]); top16_merge(cd[0], cd[2]);
    const float s0 = __uint_as_float(__float_as_uint(cd[0][0]) & ~255u);
    float ex[16]; int we[16]; float sum = 0.f;
    const LAS unsigned char* tb = wl + lane * 36;
#pragma unroll
    for (int k = 0; k < 16; ++k) { const unsigned bits = __float_as_uint(cd[0][k]); ex[k] = __expf(__uint_as_float(bits & ~255u) - s0); sum += ex[k];
        we[k] = (int)tb[(bits >> 4) & 15u] * 128 + (int)tb[16 + (bits & 15u)]; }
    const float inv = 1.0f / sum;
    int eo[8]; float go[8];
#pragma unroll
    for (int k = 0; k < 8; ++k) { eo[k] = hh ? we[k + 8] : we[k]; go[k] = (hh ? ex[k + 8] : ex[k]) * inv; }
    int* ep = EID + token * PSEL + h * 16 + hh * 8; float* gp = GATE + token * PSEL + h * 16 + hh * 8;
    *(GAS i32x4*)ep = (i32x4){eo[0], eo[1], eo[2], eo[3]}; *(GAS i32x4*)(ep + 4) = (i32x4){eo[4], eo[5], eo[6], eo[7]};
    *(GAS f32x4*)gp = (f32x4){go[0], go[1], go[2], go[3]}; *(GAS f32x4*)(gp + 4) = (f32x4){go[4], go[5], go[6], go[7]};
}

typedef signed char i8;
#define ROWLOAD8(dst, tab, e) do { const GAS v4u* _p = (const GAS v4u*)((tab) + (size_t)(e) * DM) + lane; _Pragma("unroll") for (int _i = 0; _i < 4; ++_i) dst[_i] = _p[64 * _i]; } while (0)
#define HALFLOAD8(dst, tab, e, hf) do { const GAS v4u* _p = (const GAS v4u*)((tab) + (size_t)(e) * DM) + lane + 128 * (hf); dst[0] = _p[0]; dst[1] = _p[64]; } while (0)
__device__ __forceinline__ int dotrow8(const v4u (&a)[4], const v4u (&x)[4]) {
    int s0 = 0, s1 = 0, s2 = 0, s3 = 0;
#pragma unroll
    for (int i = 0; i < 4; ++i) { s0 = __builtin_amdgcn_sdot4((int)a[i].x, (int)x[i].x, s0, false); s1 = __builtin_amdgcn_sdot4((int)a[i].y, (int)x[i].y, s1, false);
                                  s2 = __builtin_amdgcn_sdot4((int)a[i].z, (int)x[i].z, s2, false); s3 = __builtin_amdgcn_sdot4((int)a[i].w, (int)x[i].w, s3, false); }
    return (s0 + s1) + (s2 + s3);
}
__device__ __forceinline__ int dotrow4(const v4u (&a)[4], const v4u (&x)[2]) {
    int s0 = 0, s1 = 0, s2 = 0, s3 = 0;
#pragma unroll
    for (int j = 0; j < 2; ++j) {
        s0 = __builtin_amdgcn_sdot4((int)a[2 * j].x, (int)((x[j].x << 4) & 0xf0f0f0f0u), s0, false); s1 = __builtin_amdgcn_sdot4((int)a[2 * j].y, (int)(x[j].x & 0xf0f0f0f0u), s1, false);
        s2 = __builtin_amdgcn_sdot4((int)a[2 * j].z, (int)((x[j].y << 4) & 0xf0f0f0f0u), s2, false); s3 = __builtin_amdgcn_sdot4((int)a[2 * j].w, (int)(x[j].y & 0xf0f0f0f0u), s3, false);
        s0 = __builtin_amdgcn_sdot4((int)a[2 * j + 1].x, (int)((x[j].z << 4) & 0xf0f0f0f0u), s0, false); s1 = __builtin_amdgcn_sdot4((int)a[2 * j + 1].y, (int)(x[j].z & 0xf0f0f0f0u), s1, false);
        s2 = __builtin_amdgcn_sdot4((int)a[2 * j + 1].z, (int)((x[j].w << 4) & 0xf0f0f0f0u), s2, false); s3 = __builtin_amdgcn_sdot4((int)a[2 * j + 1].w, (int)(x[j].w & 0xf0f0f0f0u), s3, false); }
    return (s0 + s1) + (s2 + s3);
}
template <int HF> __device__ __forceinline__ void vquad(int (&acc)[64], const v4u (&r0)[2], const v4u (&r1)[2], const v4u (&r2)[2], const v4u (&r3)[2], int a4) {
#pragma unroll
    for (int i = 0; i < 2; ++i) {
        const unsigned x0[4] = {r0[i].x, r0[i].y, r0[i].z, r0[i].w}, x1[4] = {r1[i].x, r1[i].y, r1[i].z, r1[i].w}, x2[4] = {r2[i].x, r2[i].y, r2[i].z, r2[i].w}, x3[4] = {r3[i].x, r3[i].y, r3[i].z, r3[i].w};
#pragma unroll
        for (int w = 0; w < 4; ++w) {
            const unsigned t0 = __builtin_amdgcn_perm(x1[w], x0[w], 0x05010400u), t1 = __builtin_amdgcn_perm(x1[w], x0[w], 0x07030602u);
            const unsigned u0 = __builtin_amdgcn_perm(x3[w], x2[w], 0x05010400u), u1 = __builtin_amdgcn_perm(x3[w], x2[w], 0x07030602u);
            const unsigned y0 = __builtin_amdgcn_perm(u0, t0, 0x05040100u), y1 = __builtin_amdgcn_perm(u0, t0, 0x07060302u), y2 = __builtin_amdgcn_perm(u1, t1, 0x05040100u), y3 = __builtin_amdgcn_perm(u1, t1, 0x07060302u);
            const int b = (2 * HF + i) * 16 + w * 4;
            acc[b + 0] = __builtin_amdgcn_sdot4((int)y0, a4, acc[b + 0], false); acc[b + 1] = __builtin_amdgcn_sdot4((int)y1, a4, acc[b + 1], false);
            acc[b + 2] = __builtin_amdgcn_sdot4((int)y2, a4, acc[b + 2], false); acc[b + 3] = __builtin_amdgcn_sdot4((int)y3, a4, acc[b + 3], false); } }
}
__device__ __forceinline__ unsigned pack_lo8(unsigned a, unsigned b, unsigned c, unsigned d) {
    return __builtin_amdgcn_perm(__builtin_amdgcn_perm(d, c, 0x0c0c0400u), __builtin_amdgcn_perm(b, a, 0x0c0c0400u), 0x05040100u);
}
__device__ __forceinline__ unsigned q8x4(float a, float b, float c, float d, float inv) {
    return pack_lo8(__float_as_uint(fmaf(a, inv, 12582912.0f)), __float_as_uint(fmaf(b, inv, 12582912.0f)), __float_as_uint(fmaf(c, inv, 12582912.0f)), __float_as_uint(fmaf(d, inv, 12582912.0f)));
}
__device__ __forceinline__ float wave_max(float v) {
    v = fmaxf(v, DPP_F(v, 0xB1)); v = fmaxf(v, DPP_F(v, 0x4E)); v = fmaxf(v, DPP_F(v, 0x141)); v = fmaxf(v, DPP_F(v, 0x140));
    { const int vi = __builtin_bit_cast(int, v); v = fmaxf(v, __builtin_bit_cast(float, __builtin_amdgcn_update_dpp(vi, vi, 0x142, 0xA, 0xF, false))); }
    { const int vi = __builtin_bit_cast(int, v); v = fmaxf(v, __builtin_bit_cast(float, __builtin_amdgcn_update_dpp(vi, vi, 0x143, 0xC, 0xF, false))); }
    return __builtin_bit_cast(float, __builtin_amdgcn_readlane(__builtin_bit_cast(int, v), 63));
}
__device__ __forceinline__ int lane_xor(int v, int m) {
    if (m == 1) return __builtin_amdgcn_update_dpp(0, v, 0xB1, 0xF, 0xF, true);
    if (m == 2) return __builtin_amdgcn_update_dpp(0, v, 0x4E, 0xF, 0xF, true);
    if (m == 4) { const int t = __builtin_amdgcn_update_dpp(v, v, 0x104, 0xF, 0x5, false); return __builtin_amdgcn_update_dpp(t, v, 0x114, 0xF, 0xA, false); }
    if (m == 8) return __builtin_amdgcn_update_dpp(0, v, 0x128, 0xF, 0xF, true);
    return __shfl_xor(v, m);
}
__device__ __forceinline__ void wave_sort128(unsigned& k0, unsigned& k1, int lane) {
#pragma unroll
    for (int k = 2; k <= 128; k <<= 1)
#pragma unroll
        for (int j = k >> 1; j > 0; j >>= 1) {
            const bool asc = ((2 * lane) & k) == 0;
            if (j == 1) { const unsigned lo = k0 < k1 ? k0 : k1, hi = k0 < k1 ? k1 : k0; k0 = asc ? lo : hi; k1 = asc ? hi : lo; }
            else { const int m = j >> 1; const bool takemin = (((lane & m) == 0) == asc);
                const unsigned o0 = (unsigned)lane_xor((int)k0, m), o1 = (unsigned)lane_xor((int)k1, m);
                k0 = takemin ? (k0 < o0 ? k0 : o0) : (k0 < o0 ? o0 : k0); k1 = takemin ? (k1 < o1 ? k1 : o1) : (k1 < o1 ? o1 : k1); }
        }
}
__device__ __forceinline__ void vquad4(int (&acc)[64], const v4u (&r0)[2], const v4u (&r1)[2], const v4u (&r2)[2], const v4u (&r3)[2], int a4) {
#pragma unroll
    for (int j = 0; j < 2; ++j) {
        const unsigned d0[4] = {r0[j].x, r0[j].y, r0[j].z, r0[j].w}, d1[4] = {r1[j].x, r1[j].y, r1[j].z, r1[j].w}, d2[4] = {r2[j].x, r2[j].y, r2[j].z, r2[j].w}, d3[4] = {r3[j].x, r3[j].y, r3[j].z, r3[j].w};
#pragma unroll
        for (int c = 0; c < 4; ++c) { const int i = 2 * j + (c >> 1), p = c & 1;
            const unsigned x0 = d0[c], x1 = d1[c], x2 = d2[c], x3 = d3[c];
            const unsigned t0 = __builtin_amdgcn_perm(x1, x0, 0x05010400u), t1 = __builtin_amdgcn_perm(x1, x0, 0x07030602u);
            const unsigned u0 = __builtin_amdgcn_perm(x3, x2, 0x05010400u), u1 = __builtin_amdgcn_perm(x3, x2, 0x07030602u);
            const unsigned y[4] = {__builtin_amdgcn_perm(u0, t0, 0x05040100u), __builtin_amdgcn_perm(u0, t0, 0x07060302u), __builtin_amdgcn_perm(u1, t1, 0x05040100u), __builtin_amdgcn_perm(u1, t1, 0x07060302u)};
            const int bl = i * 16 + p * 4, bh = bl + 8;
#pragma unroll
            for (int e = 0; e < 4; ++e) { acc[bl + e] = __builtin_amdgcn_sdot4((int)(y[e] & 0x0f0f0f0fu), a4, acc[bl + e], false); acc[bh + e] = __builtin_amdgcn_sdot4((int)y[e], a4, acc[bh + e], false); } } }
}
__device__ __forceinline__ void vquad4_fix(int (&acc)[64]) {
#pragma unroll
    for (int i = 0; i < 4; ++i)
#pragma unroll
        for (int k = 0; k < 8; ++k) acc[i * 16 + 8 + k] = (acc[i * 16 + 8 + k] - acc[i * 16 + k]) >> 4;
}
#define ROWLOAD4(dst, tab, e) do { const GAS v4u* _p = (const GAS v4u*)((tab) + (size_t)(e) * (DM / 2)) + lane; dst[0] = _p[0]; dst[1] = _p[64]; } while (0)
constexpr float INT4_CLIP = 2.7f;
constexpr int N8ROWS = 0;
template <bool LAST>
__device__ __forceinline__ void gather_token(size_t token, int lane, const int* SC, const float* HS, const int* EID, const float* GATE, const float* SU, const i8* VTB, const float* SV, const i8* VT4, const float* S4,
                                             const bf16* X, bf16* Xo, float* Fo, const float* gnext, i8* XNout, float* XSout) {
    asm volatile("" : "+v"(lane));
    const i32x2 ee = *(const GAS i32x2*)(EID + token * PSEL + 2 * lane); const f32x2 gg = *(const GAS f32x2*)(GATE + token * PSEL + 2 * lane); const i32x2 scv = *(const GAS i32x2*)(SC + token * PSEL + 2 * lane);
    const f32x4 scl0 = *((const GAS f32x4*)SU + ee.x), scl1 = *((const GAS f32x4*)SU + ee.y);
    const float hs = HS[token], su0 = scl0.x, su1 = scl1.x, s80 = scl0.y, s81 = scl1.y, s40 = scl0.z, s41 = scl1.z;
    const float g0 = gelu_tanh((float)scv.x * su0 * hs) * gg.x, g1 = gelu_tanh((float)scv.y * su1 * hs) * gg.y;
    const float m0 = fabsf(g0 * s80), m1 = fabsf(g1 * s81);
    unsigned t0 = __float_as_uint(m0), t1 = __float_as_uint(m1); wave_sort128(t0, t1, lane);
    const float thr = N8ROWS > 0 ? __uint_as_float((unsigned)__builtin_amdgcn_readlane((int)t0, N8ROWS > 0 ? (128 - N8ROWS) / 2 : 0)) : 3.0e38f;
    const unsigned c0 = (m0 < thr) ? 1u : 0u, c1 = (m1 < thr) ? 1u : 0u;
    const float a0 = g0 * (c0 ? s40 : s80), a1 = g1 * (c1 ? s41 : s81);
    const float amax = wave_max(fmaxf(fabsf(a0), fabsf(a1))); const float sa = amax * (1.0f / 127.0f), ainv = amax > 0.f ? 127.0f / amax : 0.f;
    const int q0 = (int)rintf(a0 * ainv), q1 = (int)rintf(a1 * ainv);
    unsigned k0 = (c0 << 23) | ((unsigned)ee.x << 8) | (unsigned)(q0 & 0xff), k1 = (c1 << 23) | ((unsigned)ee.y << 8) | (unsigned)(q1 & 0xff);
    wave_sort128(k0, k1, lane);
    const int e0 = (int)((k0 >> 8) & 0x3fffu), e1 = (int)((k1 >> 8) & 0x3fffu); const bool i40 = (k0 >> 23) & 1u, i41 = (k1 >> 23) & 1u;
    const int n0 = __builtin_popcountll(__ballot(!i40)) + __builtin_popcountll(__ballot(!i41));
    const int pair8 = (int)((i40 ? 0u : (k0 & 0xffu)) | ((i41 ? 0u : (k1 & 0xffu)) << 8));
    const int pair4 = (int)((i40 ? (k0 & 0xffu) : 0u) | ((i41 ? (k1 & 0xffu) : 0u) << 8));
    int corr = (i40 ? (int)(signed char)(k0 & 0xffu) : 0) + (i41 ? (int)(signed char)(k1 & 0xffu) : 0);
    corr = wave_sum_i(corr) * 8;
    int acc[64];
#pragma unroll
    for (int i = 0; i < 64; ++i) acc[i] = 0;
    const int nq8 = (n0 + 3) >> 2, q4s = n0 >> 2;
    if (q4s < 32) {
        v4u P0[2], P1[2], P2[2], P3[2], R0[2], R1[2], R2[2], R3[2];
#define QLOAD4(S0, S1, S2, S3, q_) do { const int ea = __builtin_amdgcn_readlane(e0, 2 * (q_)), eb = __builtin_amdgcn_readlane(e1, 2 * (q_)), ec = __builtin_amdgcn_readlane(e0, 2 * (q_) + 1), ed = __builtin_amdgcn_readlane(e1, 2 * (q_) + 1); \
            ROWLOAD4(S0, VT4, ea); ROWLOAD4(S1, VT4, eb); ROWLOAD4(S2, VT4, ec); ROWLOAD4(S3, VT4, ed); } while (0)
#define A4OF(q_) (__builtin_amdgcn_readlane(pair4, 2 * (q_)) | (__builtin_amdgcn_readlane(pair4, 2 * (q_) + 1) << 16))
        QLOAD4(P0, P1, P2, P3, q4s);
#pragma unroll 1
        for (int q = q4s; q < 32; q += 2) {
            if (q + 1 < 32) QLOAD4(R0, R1, R2, R3, q + 1);
            vquad4(acc, P0, P1, P2, P3, A4OF(q));
            if (q + 2 < 32) QLOAD4(P0, P1, P2, P3, q + 2);
            if (q + 1 < 32) vquad4(acc, R0, R1, R2, R3, A4OF(q + 1));
        }
#undef QLOAD4
#undef A4OF
        vquad4_fix(acc);
    }
    if (nq8 > 0) {
        v4u A0[2], A1[2], A2[2], A3[2], B0[2], B1[2], B2[2], B3[2];
        { const int ea = __builtin_amdgcn_readlane(e0, 0), eb = __builtin_amdgcn_readlane(e1, 0), ec = __builtin_amdgcn_readlane(e0, 1), ed = __builtin_amdgcn_readlane(e1, 1);
          HALFLOAD8(A0, VTB, ea, 0); HALFLOAD8(A1, VTB, eb, 0); HALFLOAD8(A2, VTB, ec, 0); HALFLOAD8(A3, VTB, ed, 0); }
#pragma unroll 1
        for (int q = 0; q < nq8; ++q) {
            const int a4 = __builtin_amdgcn_readlane(pair8, 2 * q) | (__builtin_amdgcn_readlane(pair8, 2 * q + 1) << 16);
            { const int ea = __builtin_amdgcn_readlane(e0, 2 * q), eb = __builtin_amdgcn_readlane(e1, 2 * q), ec = __builtin_amdgcn_readlane(e0, 2 * q + 1), ed = __builtin_amdgcn_readlane(e1, 2 * q + 1);
              HALFLOAD8(B0, VTB, ea, 1); HALFLOAD8(B1, VTB, eb, 1); HALFLOAD8(B2, VTB, ec, 1); HALFLOAD8(B3, VTB, ed, 1); }
            vquad<0>(acc, A0, A1, A2, A3, a4);
            if (q + 1 < nq8) { const int ea = __builtin_amdgcn_readlane(e0, 2 * q + 2), eb = __builtin_amdgcn_readlane(e1, 2 * q + 2), ec = __builtin_amdgcn_readlane(e0, 2 * q + 3), ed = __builtin_amdgcn_readlane(e1, 2 * q + 3);
              HALFLOAD8(A0, VTB, ea, 0); HALFLOAD8(A1, VTB, eb, 0); HALFLOAD8(A2, VTB, ec, 0); HALFLOAD8(A3, VTB, ed, 0); }
            vquad<1>(acc, B0, B1, B2, B3, a4);
        }
    }
#pragma unroll
    for (int i = 0; i < 64; ++i) if ((i & 8) == 0) acc[i] -= corr;
    const bf16* xrow = X + token * DM + lane * 16; bf16* orow = Xo + token * DM + lane * 16; float* frow = Fo + token * DM + lane * 16; float ss = 0.f; float xv[64];
#pragma unroll
    for (int i = 0; i < 4; ++i) { const v4u t0 = *(const GAS v4u*)(xrow + i * 1024), t1 = *(const GAS v4u*)(xrow + i * 1024 + 8); const int b = i * 16;
        const float xin[16] = {bflo(t0.x), bfhi(t0.x), bflo(t0.y), bfhi(t0.y), bflo(t0.z), bfhi(t0.z), bflo(t0.w), bfhi(t0.w), bflo(t1.x), bfhi(t1.x), bflo(t1.y), bfhi(t1.y), bflo(t1.z), bfhi(t1.z), bflo(t1.w), bfhi(t1.w)};
#pragma unroll
        for (int e = 0; e < 16; ++e) { xv[b + e] = xin[e] + sa * (float)acc[b + e]; ss += xv[b + e] * xv[b + e]; }
        if (!LAST) { v4u o0, o1; o0.x = cvtpk(xv[b + 0], xv[b + 1]); o0.y = cvtpk(xv[b + 2], xv[b + 3]); o0.z = cvtpk(xv[b + 4], xv[b + 5]); o0.w = cvtpk(xv[b + 6], xv[b + 7]); o1.x = cvtpk(xv[b + 8], xv[b + 9]); o1.y = cvtpk(xv[b + 10], xv[b + 11]); o1.z = cvtpk(xv[b + 12], xv[b + 13]); o1.w = cvtpk(xv[b + 14], xv[b + 15]);
            *(GAS v4u*)(orow + i * 1024) = o0; *(GAS v4u*)(orow + i * 1024 + 8) = o1; } }
    const float rstd = 1.0f / sqrtf(wave_sum(ss) * (1.f / DM) + NORM_EPS); float mx = 0.f;
#pragma unroll
    for (int i = 0; i < 4; ++i)
#pragma unroll
        for (int w = 0; w < 4; ++w) { const f32x4 ga = *(const GAS f32x4*)(gnext + i * 1024 + lane * 16 + w * 4); const int b = i * 16 + w * 4;
            xv[b + 0] *= rstd * ga.x; xv[b + 1] *= rstd * ga.y; xv[b + 2] *= rstd * ga.z; xv[b + 3] *= rstd * ga.w;
            if (LAST) *(GAS f32x4*)(frow + i * 1024 + w * 4) = (f32x4){xv[b + 0], xv[b + 1], xv[b + 2], xv[b + 3]};
            else mx = fmaxf(fmaxf(mx, fmaxf(fabsf(xv[b + 0]), fabsf(xv[b + 1]))), fmaxf(fabsf(xv[b + 2]), fabsf(xv[b + 3]))); }
    if (!LAST) {
        mx = wave_max(mx); const float inv = mx > 0.f ? 127.0f / mx : 0.f;
#pragma unroll
        for (int i = 0; i < 4; ++i) { unsigned o[4];
#pragma unroll
            for (int w = 0; w < 4; ++w) { const int b = i * 16 + w * 4; o[w] = q8x4(xv[b + 0], xv[b + 1], xv[b + 2], xv[b + 3], inv); }
            v4u ov; ov.x = o[0]; ov.y = o[1]; ov.z = o[2]; ov.w = o[3]; *(GAS v4u*)(XNout + token * DM + i * 1024 + lane * 16) = ov; }
        if (lane == 0) XSout[token] = mx * (1.0f / 127.0f);
    }
}
__device__ __forceinline__ unsigned nib4(const f32x4 t, float inv4) {
#define NIB1(x_) __float_as_uint(fminf(fmaxf(fmaf((x_), inv4, 12582920.0f), 12582913.0f), 12582927.0f))
    return pack_lo8(NIB1(t.x), NIB1(t.y), NIB1(t.z), NIB1(t.w));
#undef NIB1
}
__device__ __forceinline__ void quant_row_load(f32x4 (&v)[16], const float* src, int lane) {
#pragma unroll
    for (int c = 0; c < 16; ++c) v[c] = *(const GAS f32x4*)(src + c * 256 + lane * 4);
}
template <bool UROW> __device__ __forceinline__ void quant_row_store(const f32x4 (&v)[16], i8* dst, float* scale_out, i8* dst4, float* scale4_out, int lane) {
    float mx = 0.f;
#pragma unroll
    for (int c = 0; c < 16; ++c) { const f32x4 t = v[c]; mx = fmaxf(fmaxf(mx, fmaxf(fabsf(t.x), fabsf(t.y))), fmaxf(fabsf(t.z), fabsf(t.w))); }
    mx = wave_max(mx); const float inv = mx > 0.f ? 127.0f / mx : 0.f;
#pragma unroll
    for (int c = 0; c < 16; ++c) { const f32x4 t = v[c];
        if (dst) *(GAS unsigned*)(dst + c * 256 + lane * 4) = q8x4(t.x, t.y, t.z, t.w, inv); }
    if (dst && lane == 0) *scale_out = mx * (1.0f / 127.0f);
    if (dst4) { float ss = 0.f;
#pragma unroll
        for (int c = 0; c < 16; ++c) { const f32x4 t = v[c]; ss += (t.x * t.x + t.y * t.y) + (t.z * t.z + t.w * t.w); }
        const float clip = fminf(mx, INT4_CLIP * sqrtf(wave_sum(ss) * (1.0f / DM))), inv4 = clip > 0.f ? 7.0f / clip : 0.f; const bool lowp = (lane & 3) < 2;
        if (UROW) {
            const bool even = (lane & 1) == 0;
#pragma unroll
            for (int k = 0; k < 8; ++k) { const int ca = (k & 3) + (k >> 2) * 8, cb = ca + 4;
                const unsigned qa = nib4(v[ca], inv4) ^ 0x08080808u, qb = nib4(v[cb], inv4) ^ 0x08080808u;
                const unsigned r = (unsigned)__builtin_amdgcn_mov_dpp((int)(even ? qb : qa), 0xB1, 0xF, 0xF, true);
                *(GAS unsigned*)(dst4 + (size_t)((k >> 2) * 64 + (k & 3) * 16 + (lane >> 2)) * 16 + ((lane & 1) ? 8 : 0) + ((lane >> 1) & 1) * 4) = even ? (qa | (r << 4)) : (r | (qb << 4)); }
        } else
#pragma unroll
        for (int k = 0; k < 8; ++k) { const int ca = (k & 3) + (k >> 2) * 8, cb = ca + 4;
            const unsigned fix = lowp ? 0u : 0x08080808u, qa = nib4(v[ca], inv4) ^ fix, qb = nib4(v[cb], inv4) ^ fix;
            const unsigned r = (unsigned)__builtin_amdgcn_mov_dpp((int)(lowp ? qb : qa), 0x4E, 0xF, 0xF, true);
            *(GAS unsigned*)(dst4 + (size_t)((k >> 2) * 64 + (k & 3) * 16 + (lane >> 2)) * 16 + (lane & 3) * 4) = lowp ? (qa | (r << 4)) : (r | (qb << 4)); }
        if (lane == 0) *scale4_out = clip * (1.0f / 7.0f); }
}
__device__ __forceinline__ void quant_row8(const float* src, i8* dst, float* scale_out, i8* dst4, float* scale4_out, int lane) {
    f32x4 v[16]; quant_row_load(v, src, lane); quant_row_store<false>(v, dst, scale_out, dst4, scale4_out, lane);
}
__device__ __forceinline__ void convert_tables(const float* srcu, const float* srcv, unsigned char* lw, int cw, int ncw, int lane) {
#define CT_LOAD(R, rw_) do { const int t_ = (rw_) >= NEXP, e_ = (rw_) - t_ * NEXP; quant_row_load(R, (t_ ? srcv : srcu) + (size_t)e_ * DM, lane); } while (0)
#define CT_STORE(R, rw_) do { const int t_ = (rw_) >= NEXP, e_ = (rw_) - t_ * NEXP; \
        if (t_) quant_row_store<false>(R, (i8*)nullptr, (float*)(lw + LW_SU) + 4 * e_ + 1, (i8*)(lw + LW_VT4) + (size_t)e_ * (DM / 2), (float*)(lw + LW_SU) + 4 * e_ + 2, lane); \
        else quant_row_store<true>(R, (i8*)nullptr, (float*)(lw + LW_SU) + 4 * e_ + 1, (i8*)(lw + LW_UTAB) + (size_t)e_ * (DM / 2), (float*)(lw + LW_SU) + 4 * e_, lane); } while (0)
    f32x4 A[16];
#pragma unroll 1
    for (int rw = cw; rw < 2 * NEXP; rw += ncw) { CT_LOAD(A, rw); CT_STORE(A, rw); }
#undef CT_LOAD
#undef CT_STORE
}
__device__ __forceinline__ void rms_row_to_bf16_i8(const float* xrow, const float* g, bf16* orow, i8* o8row, float* scale_out, int lane) {
    const GAS f32x4* xr = (const GAS f32x4*)xrow + lane;
    f32x4 v[16]; float s = 0.f;
#pragma unroll
    for (int j = 0; j < 16; ++j) { v[j] = xr[64 * j]; s += (v[j].x * v[j].x + v[j].y * v[j].y) + (v[j].z * v[j].z + v[j].w * v[j].w); }
    const float rstd = 1.0f / sqrtf(wave_sum(s) * (1.f / DM) + NORM_EPS);
    const GAS f32x4* gr = (const GAS f32x4*)g + lane;
    GAS u32x2* o8 = (GAS u32x2*)orow + lane; float mx = 0.f;
#pragma unroll
    for (int j = 0; j < 16; ++j) { const f32x4 gg = gr[64 * j]; v[j].x *= rstd * gg.x; v[j].y *= rstd * gg.y; v[j].z *= rstd * gg.z; v[j].w *= rstd * gg.w;
        u32x2 w; w.x = cvtpk(v[j].x, v[j].y); w.y = cvtpk(v[j].z, v[j].w); o8[64 * j] = w; mx = fmaxf(fmaxf(mx, fmaxf(fabsf(v[j].x), fabsf(v[j].y))), fmaxf(fabsf(v[j].z), fabsf(v[j].w))); }
    mx = wave_max(mx); const float inv = mx > 0.f ? 127.0f / mx : 0.f;
    GAS unsigned* q8 = (GAS unsigned*)o8row + lane;
#pragma unroll
    for (int j = 0; j < 16; ++j) q8[64 * j] = q8x4(v[j].x, v[j].y, v[j].z, v[j].w, inv);
    if (lane == 0) *scale_out = mx * (1.0f / 127.0f);
}

__device__ __forceinline__ void rms_row_to_i8(const float* xrow, const float* g, i8* o8row, float* scale_out, int lane) {
    const GAS f32x4* xr = (const GAS f32x4*)xrow + lane;
    f32x4 v[16]; float s = 0.f;
#pragma unroll
    for (int j = 0; j < 16; ++j) { v[j] = xr[64 * j]; s += (v[j].x * v[j].x + v[j].y * v[j].y) + (v[j].z * v[j].z + v[j].w * v[j].w); }
    const float rstd = 1.0f / sqrtf(wave_sum(s) * (1.f / DM) + NORM_EPS);
    const GAS f32x4* gr = (const GAS f32x4*)g + lane; float mx = 0.f;
#pragma unroll
    for (int j = 0; j < 16; ++j) { const f32x4 gg = gr[64 * j]; v[j].x *= rstd * gg.x; v[j].y *= rstd * gg.y; v[j].z *= rstd * gg.z; v[j].w *= rstd * gg.w;
        mx = fmaxf(fmaxf(mx, fmaxf(fabsf(v[j].x), fabsf(v[j].y))), fmaxf(fabsf(v[j].z), fabsf(v[j].w))); }
    mx = wave_max(mx); const float inv = mx > 0.f ? 127.0f / mx : 0.f;
    GAS unsigned* q8 = (GAS unsigned*)o8row + lane;
#pragma unroll
    for (int j = 0; j < 16; ++j) q8[64 * j] = q8x4(v[j].x, v[j].y, v[j].z, v[j].w, inv);
    if (lane == 0) *scale_out = mx * (1.0f / 127.0f);
}
template <int MODE> __device__ __forceinline__ void p0_tr64(const float* W, int K, int N, void* WT, const unsigned* colmax, LAS float* scr, int item, int lane) {
    const int nblk = N / 64, kb = item / nblk, nb = item % nblk, k0 = 64 * kb, n0 = 64 * nb; const int kk = lane >> 4, n4 = lane & 15;
    const float* src = W + (size_t)(k0 + kk) * N + n0 + 4 * n4;
#pragma unroll 8
    for (int i = 0; i < 16; ++i) { const f32x4 v = *(const GAS f32x4*)(src + (size_t)(4 * i) * N); LAS float* d = scr + (4 * i + kk) * 65 + 4 * n4; d[0] = v.x; d[1] = v.y; d[2] = v.z; d[3] = v.w; }
    LDS_WAIT(); asm volatile("" ::: "memory");
    if (MODE == 2) { const int c = lane & 3;
#pragma unroll
        for (int j = 0; j < 4; ++j) { const int n = (lane >> 2) + 16 * j; const LAS float* sp = scr + (16 * c) * 65 + n; const float cm = __uint_as_float(colmax[n0 + n]); const float inv = cm > 0.f ? 127.0f / cm : 0.f;
            unsigned o[4];
#pragma unroll
            for (int w = 0; w < 4; ++w) o[w] = q8x4(sp[(4 * w + 0) * 65], sp[(4 * w + 1) * 65], sp[(4 * w + 2) * 65], sp[(4 * w + 3) * 65], inv);
            v4u ov; ov.x = o[0]; ov.y = o[1]; ov.z = o[2]; ov.w = o[3]; *(GAS v4u*)((i8*)WT + (size_t)(n0 + n) * K + k0 + 16 * c) = ov; }
    } else { const int c = lane & 7;
#pragma unroll
        for (int j = 0; j < 8; ++j) { const int n = (lane >> 3) + 8 * j; const LAS float* sp = scr + (8 * c) * 65 + n;
            v4u o; o.x = cvtpk(sp[0 * 65], sp[1 * 65]); o.y = cvtpk(sp[2 * 65], sp[3 * 65]); o.z = cvtpk(sp[4 * 65], sp[5 * 65]); o.w = cvtpk(sp[6 * 65], sp[7 * 65]);
            int nrow = n0 + n; if (MODE == 1) { const int half = nrow >> 10, rem = nrow & 1023; nrow = (rem >> 7) * 256 + half * 128 + (rem & 127); }
            *(GAS v4u*)((bf16*)WT + (size_t)nrow * K + k0 + 8 * c) = o; }
    }
    LDS_WAIT(); asm volatile("" ::: "memory");
}
__device__ __forceinline__ void p0_transpose_q8_item(const float* W, int K, int N, const unsigned* colmax, i8* WT8, LAS float* scr, int item, int lane) {
    const int nblk = N / 32, kb = item / nblk, nb = item % nblk, k0 = 128 * kb, n0 = 32 * nb;
#pragma unroll 8
    for (int i = 0; i < 64; ++i) { const int kk = 2 * i + (lane >> 5); scr[kk * 33 + (lane & 31)] = W[(size_t)(k0 + kk) * N + n0 + (lane & 31)]; }
    LDS_WAIT(); asm volatile("" ::: "memory");
    const int c = lane & 7;
#pragma unroll
    for (int j = 0; j < 4; ++j) { const int n = (lane >> 3) + 8 * j; const LAS float* sp = scr + (16 * c) * 33 + n; const float cm = __uint_as_float(colmax[n0 + n]); const float inv = cm > 0.f ? 127.0f / cm : 0.f;
        unsigned o[4];
#pragma unroll
        for (int w = 0; w < 4; ++w) o[w] = q8x4(sp[(4 * w + 0) * 33], sp[(4 * w + 1) * 33], sp[(4 * w + 2) * 33], sp[(4 * w + 3) * 33], inv);
        v4u ov; ov.x = o[0]; ov.y = o[1]; ov.z = o[2]; ov.w = o[3]; *(GAS v4u*)(WT8 + (size_t)(n0 + n) * K + k0 + 16 * c) = ov; }
    LDS_WAIT(); asm volatile("" ::: "memory");
}

constexpr int PTILE = 512, NPTILE = M / PTILE, PPAIRS = PTILE * PSEL;
static_assert(PPAIRS == 65536, "pair index must fit 16 bits");
constexpr int SORT_SPLIT = 8;
__device__ __forceinline__ void sort_tile(Frame& F, int item, const int* EID, unsigned* PAIRS) {
    int tid = F.tid; asm volatile("" : "+v"(tid));
    const int tile = item / SORT_SPLIT, g = item % SORT_SPLIT;
    LAS unsigned* hist = (LAS unsigned*)F.lds; LAS unsigned* part = hist + 2048 + 64;
    for (int i = tid; i < 2048 + 64; i += 512) hist[i] = 0u;
    __syncthreads();
    const GAS i32x4* eid = (const GAS i32x4*)(EID + (size_t)tile * PPAIRS);
    unsigned below = 0;
    for (int i = tid; i < PPAIRS / 4; i += 512) { const i32x4 v = eid[i];
#pragma unroll
        for (int k = 0; k < 4; ++k) { const int e = v[k], hi = e >> 11, lo = e & 2047; below += (hi < g) ? 1u : 0u; if (hi == g) __hip_atomic_fetch_add(hist + lo + (lo >> 5), 1u, __ATOMIC_RELAXED, __HIP_MEMORY_SCOPE_WORKGROUP); } }
    part[tid] = below;
    __syncthreads();
    for (int d = 1; d < 512; d <<= 1) { const unsigned v = (tid >= d) ? part[tid - d] : 0u; __syncthreads(); part[tid] += v; __syncthreads(); }
    const unsigned base = part[511];
    __syncthreads();
    unsigned sum = 0;
#pragma unroll
    for (int j = 0; j < 4; ++j) { const int b = 4 * tid + j; sum += hist[b + (b >> 5)]; }
    part[tid] = sum;
    __syncthreads();
    for (int d = 1; d < 512; d <<= 1) { const unsigned v = (tid >= d) ? part[tid - d] : 0u; __syncthreads(); part[tid] += v; __syncthreads(); }
    unsigned run = base + part[tid] - sum;
#pragma unroll
    for (int j = 0; j < 4; ++j) { const int b = 4 * tid + j; const unsigned c = hist[b + (b >> 5)]; hist[b + (b >> 5)] = run; run += c; }
    __syncthreads();
    for (int i = tid; i < PPAIRS / 4; i += 512) { const i32x4 v = eid[i];
#pragma unroll
        for (int k = 0; k < 4; ++k) { const int e = v[k], lo = e & 2047; if ((e >> 11) == g) { const unsigned pos = __hip_atomic_fetch_add(hist + lo + (lo >> 5), 1u, __ATOMIC_RELAXED, __HIP_MEMORY_SCOPE_WORKGROUP); PAIRS[(size_t)tile * PPAIRS + pos] = ((unsigned)e << 16) | (unsigned)(4 * i + k); } } }
    __syncthreads();
}
#define ULOAD(Ux, ent) do { const GAS v4u* _u = (const GAS v4u*)(UT + (size_t)((ent) >> 16) * (DM / 2)) + lane; Ux[0] = _u[0]; Ux[1] = _u[64]; } while (0)
#define HLOAD(Hx, ent) do { const GAS v4u* _h = (const GAS v4u*)(HN8 + ((size_t)tile * PTILE + (((ent) >> 7) & 511u)) * DM) + lane; _Pragma("unroll") for (int _i = 0; _i < 4; ++_i) Hx[_i] = _h[64 * _i]; } while (0)
#define UNIT_NEXT(s_, n_) do { const unsigned long long _m = ((s_) >= 63) ? 0ull : (firsts >> ((s_) + 1)); int _r = _m ? (int)__builtin_ctzll(_m) + 1 : 64; if (_r > npos - (s_)) _r = npos - (s_); n_ = _r < 4 ? _r : 4; } while (0)
#define UNIT_LOAD(U_, H0_, H1_, H2_, H3_, s_, n_) do { ULOAD(U_, ENT(s_)); HLOAD(H0_, ENT(s_)); if ((n_) > 1) HLOAD(H1_, ENT((s_) + 1)); if ((n_) > 2) HLOAD(H2_, ENT((s_) + 2)); if ((n_) > 3) HLOAD(H3_, ENT((s_) + 3)); } while (0)
#define UNIT_COMPUTE(U_, H0_, H1_, H2_, H3_, s_, n_) do { int part[4]; part[0] = dotrow4(H0_, U_); part[1] = dotrow4(H1_, U_); part[2] = dotrow4(H2_, U_); part[3] = dotrow4(H3_, U_); int p2[2]; \
    _Pragma("unroll") for (int i = 0; i < 2; ++i) { const auto _r = __builtin_amdgcn_permlane32_swap((unsigned)part[i], (unsigned)part[i + 2], false, false); p2[i] = (int)(_r[0] + _r[1]); }     \
    int p1; { const auto _r = __builtin_amdgcn_permlane16_swap((unsigned)p2[0], (unsigned)p2[1], false, false); p1 = (int)(_r[0] + _r[1]); }                                                     \
    p1 = row16_sum(p1); \
    const int j = lane >> 4; const unsigned _e0 = ENT(s_), _e1 = ENT(((s_) + 1) & 63), _e2 = ENT(((s_) + 2) & 63), _e3 = ENT(((s_) + 3) & 63); const unsigned me = j == 0 ? _e0 : j == 1 ? _e1 : j == 2 ? _e2 : _e3; \
    if ((lane & 15) == 0 && j < (n_)) SC[((size_t)tile * PTILE + ((me >> 7) & 511u)) * PSEL + (me & 127u)] = p1 >> 4; } while (0)
__device__ __forceinline__ void uphase_chunk(int tile, unsigned c0, unsigned c1, int lane, const unsigned* PAIRS, const i8* UT, const i8* HN8, int* SC) {
    const unsigned* pr = PAIRS + (size_t)tile * PPAIRS;
    for (unsigned base = c0; base < c1; base += 64) {
        const int npos = (int)((c1 - base) < 64u ? (c1 - base) : 64u);
        const unsigned myent = pr[base + (unsigned)(lane < npos ? lane : npos - 1)];
        const unsigned prev = (unsigned)__shfl_up((int)myent, 1);
        const unsigned long long firsts = __ballot((lane == 0) || ((myent >> 16) != (prev >> 16)));
#define ENT(q) ((unsigned)__builtin_amdgcn_readlane((int)myent, (q)))
        v4u UA[2], HA0[4], HA1[4], HA2[4], HA3[4];
        int s = 0, sA = 0, nA = 0, sB = 0, nB = 0;
        (void)sB; (void)nB;
#pragma unroll 1
        while (s < npos) {
            UNIT_NEXT(s, nA); sA = s; UNIT_LOAD(UA, HA0, HA1, HA2, HA3, sA, nA); s += nA;
            UNIT_COMPUTE(UA, HA0, HA1, HA2, HA3, sA, nA);
        }
#undef ENT
    }
}

template <int NCH> __device__ __forceinline__ void quant_bf16_row(const bf16* src, i8* dst, float* scale_out, int lane) {
    v4u v[NCH]; float mx = 0.f;
#pragma unroll
    for (int i = 0; i < NCH; ++i) { v[i] = *((const GAS v4u*)src + i * 64 + lane);
        mx = fmaxf(mx, fmaxf(fmaxf(fmaxf(fabsf(bflo(v[i].x)), fabsf(bfhi(v[i].x))), fmaxf(fabsf(bflo(v[i].y)), fabsf(bfhi(v[i].y)))), fmaxf(fmaxf(fabsf(bflo(v[i].z)), fabsf(bfhi(v[i].z))), fmaxf(fabsf(bflo(v[i].w)), fabsf(bfhi(v[i].w)))))); }
    mx = wave_max(mx); const float inv = mx > 0.f ? 127.0f / mx : 0.f;
#pragma unroll
    for (int i = 0; i < NCH; ++i) { u32x2 o;
        o.x = q8x4(bflo(v[i].x), bfhi(v[i].x), bflo(v[i].y), bfhi(v[i].y), inv);
        o.y = q8x4(bflo(v[i].z), bfhi(v[i].z), bflo(v[i].w), bfhi(v[i].w), inv);
        *((GAS u32x2*)dst + i * 64 + lane) = o; }
    if (lane == 0) *scale_out = mx * (1.0f / 127.0f);
}

__device__ __forceinline__ int order_id(const Frame& F, const XcdBarrier& bar, bool use_bar) {
    if (!use_bar) return (int)blockIdx.x;
    const unsigned x = F.xcc, rank = F.xrank; unsigned nx = 0, xi = 0; bool uniform = true; const unsigned per = (unsigned)F.G >> 3;
    for (unsigned j = 0; j < 16; ++j) { const unsigned c = xb_ld(&bar.bar[XB_XCNT(j)]); nx += (c > 0u); xi += (c > 0u && j < x); uniform = uniform && (c == 0u || c == per); }
    return (uniform && nx == 8u && (F.G & 7) == 0 && rank < per) ? (int)(rank * 8u + xi) : (int)blockIdx.x;
}
__device__ __forceinline__ void rms_row16_to_i8(const bf16* xrow, const float* g, i8* o8row, float* scale_out, int lane) {
    float v[64]; float s = 0.f;
#pragma unroll
    for (int j = 0; j < 8; ++j) { const v4u t = *((const GAS v4u*)xrow + 64 * j + lane);
        v[8 * j + 0] = bflo(t.x); v[8 * j + 1] = bfhi(t.x); v[8 * j + 2] = bflo(t.y); v[8 * j + 3] = bfhi(t.y); v[8 * j + 4] = bflo(t.z); v[8 * j + 5] = bfhi(t.z); v[8 * j + 6] = bflo(t.w); v[8 * j + 7] = bfhi(t.w);
#pragma unroll
        for (int e = 0; e < 8; ++e) s += v[8 * j + e] * v[8 * j + e]; }
    const float rstd = 1.0f / sqrtf(wave_sum(s) * (1.f / DM) + NORM_EPS); float mx = 0.f;
#pragma unroll
    for (int j = 0; j < 8; ++j) { const f32x4 g0 = *((const GAS f32x4*)g + 2 * (64 * j + lane)), g1 = *((const GAS f32x4*)g + 2 * (64 * j + lane) + 1);
        v[8 * j + 0] *= rstd * g0.x; v[8 * j + 1] *= rstd * g0.y; v[8 * j + 2] *= rstd * g0.z; v[8 * j + 3] *= rstd * g0.w; v[8 * j + 4] *= rstd * g1.x; v[8 * j + 5] *= rstd * g1.y; v[8 * j + 6] *= rstd * g1.z; v[8 * j + 7] *= rstd * g1.w;
#pragma unroll
        for (int e = 0; e < 8; ++e) mx = fmaxf(mx, fabsf(v[8 * j + e])); }
    mx = wave_max(mx); const float inv = mx > 0.f ? 127.0f / mx : 0.f;
#pragma unroll
    for (int j = 0; j < 8; ++j) { u32x2 o;
        o.x = q8x4(v[8 * j + 0], v[8 * j + 1], v[8 * j + 2], v[8 * j + 3], inv);
        o.y = q8x4(v[8 * j + 4], v[8 * j + 5], v[8 * j + 6], v[8 * j + 7], inv);
        *((GAS u32x2*)o8row + 64 * j + lane) = o; }
    if (lane == 0) *scale_out = mx * (1.0f / 127.0f);
}
__device__ __forceinline__ void xcc_local_barrier(gu32* ctl, unsigned x, unsigned nloc, unsigned* tmo_bar) {
    asm volatile("s_waitcnt vmcnt(0)" ::: "memory");
    __syncthreads();
    if (threadIdx.x == 0) {
        __builtin_amdgcn_s_waitcnt(0);
        unsigned xx = x; asm volatile("" : "+s"(xx));
        unsigned* cnt = (unsigned*)ctl + CW_LBAR + 64 * xx; unsigned* gen = (unsigned*)ctl + CW_LBAR + 1024 + 64 * xx;
        const unsigned old = xb_add(cnt, 1u), g = old / nloc;
        if (old + 1u == (g + 1u) * nloc) xb_add(gen, 1u);
        else XB_SPIN(xb_ld(gen) == g, tmo_bar);
        __builtin_amdgcn_fence(__ATOMIC_ACQUIRE, "agent");
        asm volatile("s_waitcnt vmcnt(0)" ::: "memory");
    }
    __syncthreads();
}
struct Args { const float* in[22]; float* out; unsigned char* ws; int ph_lo, ph_hi, dup, pad; };
__global__ void __launch_bounds__(NWAVES * 64, 2) hybrid_fwd(Args args) {
    extern __shared__ __attribute__((aligned(16))) unsigned char lds[];
    Frame F;
    F.lds = (LAS unsigned char*)lds; F.MISC = (volatile LAS unsigned*)(F.lds + MISC_OFF);
    F.tid = threadIdx.x; F.lane = F.tid & 63; F.wave = __builtin_amdgcn_readfirstlane(F.tid >> 6); F.G = gridDim.x; F.ws = args.ws;
    F.ctl = (gu32*)(args.ws + WS_CTL);
    for (int u = F.tid; u < (LDS_BYTES - LDSCTL_OFF) / 4; u += NWAVES * 64) ((LAS unsigned*)(F.lds + LDSCTL_OFF))[u] = 0u;
    __syncthreads();
    const int lo = args.ph_lo, hi = args.ph_hi;
    const bool use_bar = MK_ONE_LAUNCH ? true : (hi - lo) > 1;
    XcdBarrier bar; bar.bar = (unsigned*)(F.ctl + CW_BAR); bar.x = 0; bar.st = nullptr;
    if (use_bar) bar = xcd_barrier_post((unsigned*)(F.ctl + CW_BAR), F.MISC + 8);
    if (F.tid == 0) { const unsigned x = use_bar ? xb_xcc_id() : (blockIdx.x & 7u); F.MISC[10] = x;
        F.MISC[11] = use_bar ? __hip_atomic_fetch_add((unsigned*)(F.ctl + CW_XRANK) + 64 * x, 1u, __ATOMIC_RELAXED, __HIP_MEMORY_SCOPE_AGENT) : (blockIdx.x >> 3); }
    __syncthreads();
    F.xcc = (unsigned)__builtin_amdgcn_readfirstlane((int)F.MISC[10]); F.xrank = (unsigned)__builtin_amdgcn_readfirstlane((int)F.MISC[11]);
#ifndef DUPMASK
#define DUPMASK 0
#endif
#define REPS(k)
#if MK_ONE_LAUNCH
#define DRY false
#else
#define DRY (args.dup != 0)
#endif
#ifndef PHSUB
#define PHSUB 3
#endif
#ifndef PHMASK
#define PHMASK 0x3ff
#endif
#if MK_ONE_LAUNCH
#define IN(k) true
#define SEAM(k) do { if ((k) + 1 < NPHASES) xcd_barrier(bar); } while (0)
#else
#define IN(k) (lo <= (k) && (k) < hi)
#define SEAM(k) do { if (IN(k) && IN((k) + 1)) xcd_barrier(bar); } while (0)
#endif
#define PH_PTRS int z_; asm volatile("s_mov_b32 %0, 0" : "=s"(z_)); int lane_ = F.tid & 63; asm volatile("" : "+v"(lane_)); const int gw = gw0 + z_; (void)gw; unsigned char* ws = args.ws + z_; float* X = args.out + z_; (void)X; \
    bf16* XN = (bf16*)(ws + WS_XN); bf16* Qb = (bf16*)(ws + WS_Q); bf16* KBb = (bf16*)(ws + WS_KB); bf16* VTb = (bf16*)(ws + WS_VT); bf16* Ub = (bf16*)(ws + WS_U); \
    bf16* GA = (bf16*)(ws + WS_GA); bf16* GS = (bf16*)(ws + WS_GS); bf16* ATT = (bf16*)(ws + WS_ATT); bf16* Zb = (bf16*)(ws + WS_Z); bf16* SSb = (bf16*)(ws + WS_SS); \
    bf16* MG = (bf16*)(ws + WS_MG); bf16* PQ = (bf16*)(ws + WS_PQ); bf16* HN = (bf16*)(ws + WS_HN); int* EID = (int*)(ws + WS_EID); float* GATE = (float*)(ws + WS_GATE); i8* HN8 = (i8*)(ws + WS_HN8); float* HS = (float*)(ws + WS_HS); (void)HN8; (void)HS; unsigned* PAIRS = (unsigned*)(ws + WS_PAIRS); int* SC = (int*)(ws + WS_SC); (void)PAIRS; (void)SC; i8* ATT8 = (i8*)(ws + WS_XN + 65 * MiB); i8* SS8 = (i8*)(ws + WS_XN + 97 * MiB); i8* MG8 = (i8*)(ws + WS_Q); float* ATS = (float*)(ws + WS_HS + 256 * 1024); float* SSS = (float*)(ws + WS_HS + 512 * 1024); float* MGS = (float*)(ws + WS_HS + 768 * 1024); (void)ATT8; (void)SS8; (void)MG8; (void)ATS; (void)SSS; (void)MGS; bf16* XB = (bf16*)(ws + WS_HN); (void)XB; i8* XN8 = (i8*)(ws + WS_XN); float* XS = (float*)(ws + WS_XN + 64 * MiB); (void)XN8; (void)XS; \
    (void)XN; (void)Qb; (void)KBb; (void)VTb; (void)Ub; (void)GA; (void)GS; (void)ATT; (void)Zb; (void)SSb; (void)MG; (void)PQ; (void)HN; (void)EID; (void)GATE;
#define INP(i) (args.in[(i) + z_])
#define ORDER_ID() order_id(F, bar, use_bar)
    const int gw0 = blockIdx.x * NWAVES + F.wave, NGW = F.G * NWAVES;

    if (IN(0)) { PH_PTRS
        for (int t = gw; t < DEPTH * 32 * 48; t += NGW) { const int l = t / 1536, r = t % 1536, kc = r / 48, nb = r % 48;
            const float* src = INP(2) + ((size_t)l * DM + kc * 128) * INCOLS + nb * 256 + lane_ * 4; f32x4 mx = (f32x4){0.f, 0.f, 0.f, 0.f};
#pragma unroll 8
            for (int k = 0; k < 128; ++k) { const f32x4 v = *(const GAS f32x4*)(src + (size_t)k * INCOLS); mx.x = fmaxf(mx.x, fabsf(v.x)); mx.y = fmaxf(mx.y, fabsf(v.y)); mx.z = fmaxf(mx.z, fabsf(v.z)); mx.w = fmaxf(mx.w, fabsf(v.w)); }
            unsigned* cm = (unsigned*)(F.ctl + CW_COLMAX) + l * INCOLS + nb * 256 + lane_ * 4;
            __hip_atomic_fetch_max(cm + 0, __float_as_uint(mx.x), __ATOMIC_RELAXED, __HIP_MEMORY_SCOPE_AGENT); __hip_atomic_fetch_max(cm + 1, __float_as_uint(mx.y), __ATOMIC_RELAXED, __HIP_MEMORY_SCOPE_AGENT);
            __hip_atomic_fetch_max(cm + 2, __float_as_uint(mx.z), __ATOMIC_RELAXED, __HIP_MEMORY_SCOPE_AGENT); __hip_atomic_fetch_max(cm + 3, __float_as_uint(mx.w), __ATOMIC_RELAXED, __HIP_MEMORY_SCOPE_AGENT); }
    }
    if (IN(0)) { PH_PTRS
        constexpr int T_AB = (ATTW / 128) * 16, T_SB = (SSMW / 128) * 16, T_OUT = (DM / 128) * 16, T_L = T_AB + T_SB + T_OUT;
        for (int t = gw; t < DEPTH * T_L; t += NGW) { const int l = t / T_L; int r = t % T_L; int which, K; const float* W;
            if (r < T_AB) { which = 0; K = ATTW; W = INP(13) + (size_t)l * ATTW * DM; } else if (r < T_AB + T_SB) { r -= T_AB; which = 1; K = SSMW; W = INP(14) + (size_t)l * SSMW * DM; } else { r -= T_AB + T_SB; which = 2; K = DM; W = INP(15) + (size_t)l * DM * DM; }
            (void)K; const int kc = r / 16, nb = r % 16; const float* src = W + (size_t)(kc * 128) * DM + nb * 256 + lane_ * 4; f32x4 mx = (f32x4){0.f, 0.f, 0.f, 0.f};
#pragma unroll 8
            for (int k = 0; k < 128; ++k) { const f32x4 v = *(const GAS f32x4*)(src + (size_t)k * DM); mx.x = fmaxf(mx.x, fabsf(v.x)); mx.y = fmaxf(mx.y, fabsf(v.y)); mx.z = fmaxf(mx.z, fabsf(v.z)); mx.w = fmaxf(mx.w, fabsf(v.w)); }
            unsigned* cm = (unsigned*)(F.ctl + CW_COLMAX2) + (l * 3 + which) * DM + nb * 256 + lane_ * 4;
            __hip_atomic_fetch_max(cm + 0, __float_as_uint(mx.x), __ATOMIC_RELAXED, __HIP_MEMORY_SCOPE_AGENT); __hip_atomic_fetch_max(cm + 1, __float_as_uint(mx.y), __ATOMIC_RELAXED, __HIP_MEMORY_SCOPE_AGENT);
            __hip_atomic_fetch_max(cm + 2, __float_as_uint(mx.z), __ATOMIC_RELAXED, __HIP_MEMORY_SCOPE_AGENT); __hip_atomic_fetch_max(cm + 3, __float_as_uint(mx.w), __ATOMIC_RELAXED, __HIP_MEMORY_SCOPE_AGENT); }
    }
    if (IN(0)) { PH_PTRS
        for (int t = gw; t < DEPTH * 32 * 8; t += NGW) { const int l = t / 256, r = t % 256, kc = r / 8, nb = r % 8;
            const float* src = INP(17) + ((size_t)l * DM + kc * 128) * (PH * PDK) + nb * 256 + lane_ * 4; f32x4 mx = (f32x4){0.f, 0.f, 0.f, 0.f};
#pragma unroll 8
            for (int k = 0; k < 128; ++k) { const f32x4 v = *(const GAS f32x4*)(src + (size_t)k * (PH * PDK)); mx.x = fmaxf(mx.x, fabsf(v.x)); mx.y = fmaxf(mx.y, fabsf(v.y)); mx.z = fmaxf(mx.z, fabsf(v.z)); mx.w = fmaxf(mx.w, fabsf(v.w)); }
            unsigned* cm = (unsigned*)(F.ctl + CW_COLMAX3) + l * 2048 + nb * 256 + lane_ * 4;
            __hip_atomic_fetch_max(cm + 0, __float_as_uint(mx.x), __ATOMIC_RELAXED, __HIP_MEMORY_SCOPE_AGENT); __hip_atomic_fetch_max(cm + 1, __float_as_uint(mx.y), __ATOMIC_RELAXED, __HIP_MEMORY_SCOPE_AGENT);
            __hip_atomic_fetch_max(cm + 2, __float_as_uint(mx.z), __ATOMIC_RELAXED, __HIP_MEMORY_SCOPE_AGENT); __hip_atomic_fetch_max(cm + 3, __float_as_uint(mx.w), __ATOMIC_RELAXED, __HIP_MEMORY_SCOPE_AGENT); }
    }
    SEAM(0);
#define CONVERT_WEIGHTS(l, lw, scr) do { \
            constexpr int I_IN = (DM / 64) * (INCOLS / 64), I_AB = (ATTW / 64) * (DM / 64), I_SB = (SSMW / 64) * (DM / 64), I_OUT = (DM / 64) * (DM / 64), I_GLU = (SSMW / 64) * (2 * SSMW / 64), I_PQ = (DM / 64) * (PH * PDK / 64); \
            constexpr int NIT = I_IN + I_AB + I_SB + I_OUT + I_GLU + I_PQ; \
            for (int it = gw; it < NIT; it += NGW) { \
                int r = it; \
                if (r < I_IN) { p0_tr64<2>(INP(2) + (size_t)l * DM * INCOLS, DM, INCOLS, lw + LW_WIN, (const unsigned*)(F.ctl + CW_COLMAX) + l * INCOLS, scr, r, lane_); continue; } r -= I_IN; \
                if (r < I_AB) { p0_tr64<2>(INP(13) + (size_t)l * ATTW * DM, ATTW, DM, lw + LW_WAB, (const unsigned*)(F.ctl + CW_COLMAX2) + (l * 3 + 0) * DM, scr, r, lane_); continue; } r -= I_AB; \
                if (r < I_SB) { p0_tr64<2>(INP(14) + (size_t)l * SSMW * DM, SSMW, DM, lw + LW_WSB, (const unsigned*)(F.ctl + CW_COLMAX2) + (l * 3 + 1) * DM, scr, r, lane_); continue; } r -= I_SB; \
                if (r < I_OUT) { p0_tr64<2>(INP(15) + (size_t)l * DM * DM, DM, DM, lw + LW_WOUT, (const unsigned*)(F.ctl + CW_COLMAX2) + (l * 3 + 2) * DM, scr, r, lane_); continue; } r -= I_OUT; \
                if (r < I_GLU) { p0_tr64<1>(INP(11) + (size_t)l * SSMW * 2 * SSMW, SSMW, 2 * SSMW, lw + LW_WGLU, nullptr, scr, r, lane_); continue; } r -= I_GLU; \
                p0_tr64<2>(INP(17) + (size_t)l * DM * PH * PDK, DM, PH * PDK, lw + LW_WPQ, (const unsigned*)(F.ctl + CW_COLMAX3) + l * 2048, scr, r, lane_); \
            } \
        } while (0)
    if (((PHMASK >> 0) & 1) && IN(1)) REPS(0) { PH_PTRS
        LAS float* scr = (LAS float*)(F.lds + F.wave * 16896);
        for (int l = 0; l < DEPTH; ++l) {
            unsigned char* lw = ws + WS_LW + (size_t)l * LW_SIZE;
            CONVERT_WEIGHTS(l, lw, scr);
            constexpr size_t NK = (size_t)PH * 2 * NKEYS * 128 / 512;
            for (size_t st = gw; st < NK; st += NGW) { const float* src = INP(18) + (size_t)l * PH * 2 * NKEYS * 128; bf16* dst = (bf16*)(lw + LW_KEYS);
                const size_t e = st * 512 + lane_ * 8; const f32x4 a = *(const GAS f32x4*)(src + e), b = *(const GAS f32x4*)(src + e + 4);
                v4u o; o.x = cvtpk(a.x, a.y); o.y = cvtpk(a.z, a.w); o.z = cvtpk(b.x, b.y); o.w = cvtpk(b.z, b.w); *(GAS v4u*)(dst + e) = o; }
        }
        for (int i = gw * 64 + lane_; i < DEPTH * 2048; i += NGW * 64) ((float*)(ws + WS_LW + (size_t)(i / 2048) * LW_SIZE + LW_WPQS))[i % 2048] = __uint_as_float(((const unsigned*)(F.ctl + CW_COLMAX3))[i]) * (1.0f / 127.0f);
        for (int i = gw * 64 + lane_; i < DEPTH * 3 * DM; i += NGW * 64) { const int l = i / (3 * DM), which = (i / DM) % 3, n = i % DM; unsigned char* lw = ws + WS_LW + (size_t)l * LW_SIZE;
            ((float*)(lw + (which == 0 ? LW_WABS : which == 1 ? LW_WSBS : LW_WOUTS)))[n] = __uint_as_float(((const unsigned*)(F.ctl + CW_COLMAX2))[i]) * (1.0f / 127.0f); }
        for (int l = 0; l < DEPTH; ++l) for (int n = gw * 64 + lane_; n < INCOLS; n += NGW * 64) ((float*)(ws + WS_LW + (size_t)l * LW_SIZE + LW_WINS))[n] = __uint_as_float(((const unsigned*)(F.ctl + CW_COLMAX))[l * INCOLS + n]) * (1.0f / 127.0f);
        for (int m = gw; m < M; m += NGW) rms_row_to_i8(INP(0) + (size_t)m * DM, INP(1), XN8 + (size_t)m * DM, XS + m, lane_);
        __syncthreads();
        for (int it2 = blockIdx.x; it2 < DEPTH * SSMG * 2; it2 += F.G) { const int it = it2 >> 1, half = it2 & 1; const int l = it / SSMG, g = it % SSMG; unsigned char* lw = ws + WS_LW + (size_t)l * LW_SIZE;
            s5_precompute(F, INP(3) + l * SSMG * 64, INP(4) + l * SSMG * 64, INP(5) + l * SSMG, INP(6) + (size_t)l * SSMG * 1024, INP(7) + (size_t)l * SSMG * 1024,
                          INP(8) + (size_t)l * SSMG * 1024, INP(9) + (size_t)l * SSMG * 1024, g, half, (bf16*)(lw + LW_S5K), (bf16*)(lw + LW_S5ME), (bf16*)(lw + LW_S5MC), (float*)(lw + LW_S5LAM)); }
    }
    SEAM(1);
    if (use_bar) { unsigned nloc = 0, xi = 0, nx = 0;
        for (unsigned j = 0; j < 16; ++j) { const unsigned c = xb_ld(&bar.bar[XB_XCNT(j)]); nx += (c > 0u); xi += (c > 0u && j < F.xcc); nloc = (j == F.xcc) ? c : nloc; }
        F.xi = (unsigned)__builtin_amdgcn_readfirstlane((int)xi); F.nx = (unsigned)__builtin_amdgcn_readfirstlane((int)(nx ? nx : 1u)); F.nloc = (unsigned)__builtin_amdgcn_readfirstlane((int)(nloc ? nloc : 1u)); }
    else if ((F.G & 7) == 0) { F.xi = F.xcc; F.nx = 8; F.nloc = (unsigned)F.G >> 3; }
    else { F.xi = 0; F.nx = 1; F.nloc = (unsigned)F.G; F.xrank = blockIdx.x; }
    const int wl = (int)F.xrank * NWAVES + F.wave, NWL = (int)F.nloc * NWAVES;
#define LSEAM(k) do { if (use_bar && (k) + 1 < NPHASES) xcc_local_barrier(F.ctl, F.xcc, F.nloc, bar.bar); } while (0)
#define FOR_OWNED(b) for (int b = (int)F.xi; b < BATCH; b += (int)F.nx)

#pragma unroll 1
    for (int l = 0; l < DEPTH; ++l) {
        const int pb = NPH_PRO + l * NPH_LAYER;
        if (((PHMASK >> 1) & 1) && IN(pb + 0)) REPS(1) { PH_PTRS unsigned char* lw = ws + WS_LW + (size_t)l * LW_SIZE; (void)lw;
            pg8::Gemm g{(const bf16*)XN8, (const bf16*)(lw + LW_WIN), M, INCOLS, DM / 2}; pg8::LocalWindow S; S.init(INCOLS, (int)F.nloc, (int)F.xrank, (int)F.xi, (int)F.nx);
            const int mine = (S.nbo * 8 * S.nN - (int)F.xrank + (int)F.nloc - 1) / (int)F.nloc, cut = ((int)F.xrank * (mine + 1)) / (int)F.nloc;
            pg8::EpiIn8 E{Qb, KBb, VTb, Ub, GA, GS, XS, (const float*)(lw + LW_WINS)};
            S.lo = 0; S.hi = cut; pg8::gemm_phase<pg8::EpiIn8, pg8::LocalWindow, true, true>(F.lds, g, S, E);
            convert_tables(INP(19) + (size_t)l * NEXP * DM, INP(20) + (size_t)l * NEXP * DM, lw, (int)blockIdx.x * NWAVES + F.wave, F.G * NWAVES, lane_);
            if (use_bar) { asm volatile("s_waitcnt vmcnt(0)" ::: "memory"); __syncthreads();
                if (threadIdx.x == 0) { __builtin_amdgcn_fence(__ATOMIC_RELEASE, "agent"); asm volatile("s_waitcnt vmcnt(0)" ::: "memory"); (void)xb_add((unsigned*)F.ctl + CW_CONV + 64 * l, 1u); } }
            S.lo = cut; S.hi = 1 << 30; pg8::gemm_phase<pg8::EpiIn8, pg8::LocalWindow, true, true>(F.lds, g, S, E);
        }
        LSEAM(pb + 0);
        if (((PHMASK >> 2) & 1) && IN(pb + 1)) REPS(2) { PH_PTRS unsigned char* lw = ws + WS_LW + (size_t)l * LW_SIZE; (void)lw;
            FOR_OWNED(b) for (int j = (int)F.xrank; j < 128; j += (int)F.nloc) {
                if (j < 64) attn_unit(F, b, j >> 2, j & 3, Qb, KBb, VTb, ATT, INP(12) + l * NQH);
                else s5_unit(F, b, j - 64, Ub, (const bf16*)(lw + LW_S5K), (const bf16*)(lw + LW_S5ME), (const bf16*)(lw + LW_S5MC), (const float*)(lw + LW_S5LAM), INP(10) + l * SSMW, Zb);
            }
        }
        LSEAM(pb + 1);
        if (((PHMASK >> 3) & 1) && IN(pb + 2)) REPS(3) { PH_PTRS unsigned char* lw = ws + WS_LW + (size_t)l * LW_SIZE; (void)lw;
            pg8::Gemm g{Zb, (const bf16*)(lw + LW_WGLU), M, 2 * SSMW, SSMW}; pg8::LocalOrder S; S.init(2 * SSMW, (int)F.nloc, (int)F.xrank, (int)F.xi, (int)F.nx);
            pg8::EpiGlu E{SSb, SSMW};
            pg8::gemm_phase<pg8::EpiGlu, pg8::LocalOrder, true, true>(F.lds, g, S, E);
        }
        LSEAM(pb + 2);
        if (IN(pb + 3)) { PH_PTRS FOR_OWNED(b) for (int m = b * SEQ + wl; m < (b + 1) * SEQ; m += NWL) { quant_bf16_row<4>(ATT + (size_t)m * ATTW, ATT8 + (size_t)m * ATTW, ATS + m, lane_); quant_bf16_row<2>(SSb + (size_t)m * SSMW, SS8 + (size_t)m * SSMW, SSS + m, lane_); } }
        LSEAM(pb + 3);
        if (((PHMASK >> 4) & 1) && IN(pb + 4)) REPS(4) { PH_PTRS unsigned char* lw = ws + WS_LW + (size_t)l * LW_SIZE; (void)lw;
            { pg8::Gemm g{(const bf16*)ATT8, (const bf16*)(lw + LW_WAB), M, DM, ATTW / 2}; pg8::LocalOrder S; S.init(DM, (int)F.nloc, (int)F.xrank, (int)F.xi, (int)F.nx); pg8::EpiGate8<false> E{MG, GA, DM, ATS, (const float*)(lw + LW_WABS)};
              pg8::gemm_phase<pg8::EpiGate8<false>, pg8::LocalOrder, true, true>(F.lds, g, S, E); }
            { pg8::Gemm g{(const bf16*)SS8, (const bf16*)(lw + LW_WSB), M, DM, SSMW / 2}; pg8::LocalOrder S; S.init(DM, (int)F.nloc, (int)F.xrank, (int)F.xi, (int)F.nx); pg8::EpiGate8<true> E{MG, GS, DM, SSS, (const float*)(lw + LW_WSBS)};
              pg8::gemm_phase<pg8::EpiGate8<true>, pg8::LocalOrder, true, true>(F.lds, g, S, E); }
        }
        LSEAM(pb + 4);
        if (IN(pb + 5)) { PH_PTRS FOR_OWNED(b) for (int m = b * SEQ + wl; m < (b + 1) * SEQ; m += NWL) quant_bf16_row<8>(MG + (size_t)m * DM, MG8 + (size_t)m * DM, MGS + m, lane_); }
        LSEAM(pb + 5);
        if (((PHMASK >> 5) & 1) && IN(pb + 6)) REPS(5) { PH_PTRS unsigned char* lw = ws + WS_LW + (size_t)l * LW_SIZE; (void)lw;
            pg8::Gemm g{(const bf16*)MG8, (const bf16*)(lw + LW_WOUT), M, DM, DM / 2}; pg8::LocalOrder S; S.init(DM, (int)F.nloc, (int)F.xrank, (int)F.xi, (int)F.nx);
            pg8::EpiRes8 E{l == 0 ? INP(0) : (const float*)nullptr, XB, DRY ? GA : XB, DM, MGS, (const float*)(lw + LW_WOUTS)};
            pg8::gemm_phase<pg8::EpiRes8, pg8::LocalOrder, true, true>(F.lds, g, S, E);
        }
        LSEAM(pb + 6);
        if (((PHMASK >> 6) & 1) && IN(pb + 7)) REPS(6) { PH_PTRS unsigned char* lw = ws + WS_LW + (size_t)l * LW_SIZE; (void)lw; FOR_OWNED(b) for (int m = b * SEQ + wl; m < (b + 1) * SEQ; m += NWL) rms_row16_to_i8(XB + (size_t)m * DM, INP(16) + l * DM, HN8 + (size_t)m * DM, HS + m, lane_); }
        LSEAM(pb + 7);
        if (((PHMASK >> 7) & 1) && IN(pb + 8)) REPS(7) { PH_PTRS unsigned char* lw = ws + WS_LW + (size_t)l * LW_SIZE; (void)lw;
            pg8::Gemm g{(const bf16*)HN8, (const bf16*)(lw + LW_WPQ), M, PH * PDK, DM / 2}; pg8::LocalOrder S; S.init(PH * PDK, (int)F.nloc, (int)F.xrank, (int)F.xi, (int)F.nx);
            pg8::EpiBf16Plain8 E{PQ, PH * PDK, HS, (const float*)(lw + LW_WPQS)};
            pg8::gemm_phase<pg8::EpiBf16Plain8, pg8::LocalOrder, true, true>(F.lds, g, S, E);
        }
        LSEAM(pb + 8);
        if (((PHMASK >> 8) & 1) && IN(pb + 9)) REPS(8) { PH_PTRS unsigned char* lw = ws + WS_LW + (size_t)l * LW_SIZE; (void)lw; FOR_OWNED(b) for (int tl = wl; tl < (SEQ / 32) * PH; tl += NWL) topk_task((b * (SEQ / 32) + (tl >> 3)) * PH + (tl & 7), lane_, PQ, (const bf16*)(lw + LW_KEYS), EID, GATE, F.lds + F.wave * 2304); }
        LSEAM(pb + 9);
        if (IN(pb + 10)) { PH_PTRS FOR_OWNED(b) for (int it = (int)F.xrank; it < (SEQ / PTILE) * SORT_SPLIT; it += (int)F.nloc) sort_tile(F, b * (SEQ / PTILE) * SORT_SPLIT + it, EID, PAIRS); }
        if (use_bar && threadIdx.x == 0) XB_SPIN(xb_ld((unsigned*)F.ctl + CW_CONV + 64 * l) < (unsigned)F.G, bar.bar);
        LSEAM(pb + 10);
        if (IN(pb + 11)) { PH_PTRS unsigned char* lw = ws + WS_LW + (size_t)l * LW_SIZE;
            const unsigned nW = (unsigned)NWL, chunk = (PPAIRS + nW - 1) / nW, wv = (unsigned)wl;
            FOR_OWNED(b) for (int tile = b * (SEQ / PTILE); tile < (b + 1) * (SEQ / PTILE); ++tile) { const unsigned c0 = wv * chunk, c1 = (c0 + chunk < (unsigned)PPAIRS) ? c0 + chunk : (unsigned)PPAIRS;
                if (c0 < c1) uphase_chunk(tile, c0, c1, lane_, PAIRS, (const i8*)(lw + LW_UTAB), HN8, SC); }
        }
        LSEAM(pb + 11);
        if (((PHMASK >> 9) & 1) && IN(pb + 12)) REPS(9) { PH_PTRS unsigned char* lw = ws + WS_LW + (size_t)l * LW_SIZE; (void)lw;
            if (l + 1 < DEPTH) { FOR_OWNED(b) for (int m = b * SEQ + wl; m < (b + 1) * SEQ; m += NWL) gather_token<false>((size_t)m, lane_, SC, HS, EID, GATE, (const float*)(lw + LW_SU), (const i8*)(lw + LW_VTAB), (const float*)(lw + LW_SV), (const i8*)(lw + LW_VT4), (const float*)(lw + LW_S4), XB, DRY ? GA : XB, X, INP(1) + (l + 1) * DM, DRY ? (i8*)MG : XN8, DRY ? (float*)Zb : XS); }
            else { FOR_OWNED(b) for (int m = b * SEQ + wl; m < (b + 1) * SEQ; m += NWL) gather_token<true>((size_t)m, lane_, SC, HS, EID, GATE, (const float*)(lw + LW_SU), (const i8*)(lw + LW_VTAB), (const float*)(lw + LW_SV), (const i8*)(lw + LW_VT4), (const float*)(lw + LW_S4), XB, XB, DRY ? (float*)GA : X, INP(21), XN8, XS); }
        }
        LSEAM(pb + 12);
    }
#undef IN
#undef SEAM
}

extern "C" void kernel_launch(void* const* d_in, const int* in_sizes, int n_in, void* d_out, int out_size, void* d_ws, size_t ws_size, hipStream_t stream) {
    static int grid = 0;
    if (grid == 0) {
        if (n_in != 22 || out_size != M * DM || ws_size < WS_END) { fprintf(stderr, "kernel_launch: unexpected shapes (n_in %d out %d ws %zu)\n", n_in, out_size, ws_size); grid = -1; return; }
        int dev = 0, cus = 0, per_cu = 0;
        if (hipGetDevice(&dev) != hipSuccess || hipDeviceGetAttribute(&cus, hipDeviceAttributeMultiprocessorCount, dev) != hipSuccess) { grid = -1; return; }
        if (hipFuncSetAttribute((const void*)hybrid_fwd, hipFuncAttributeMaxDynamicSharedMemorySize, LDS_BYTES) != hipSuccess) { fprintf(stderr, "kernel_launch: hipFuncSetAttribute failed\n"); grid = -1; return; }
        if (hipOccupancyMaxActiveBlocksPerMultiprocessor(&per_cu, (const void*)hybrid_fwd, NWAVES * 64, LDS_BYTES) != hipSuccess || per_cu < 1) fprintf(stderr, "kernel_launch: occupancy query says %d\n", per_cu);
        (void)hipGetLastError();
        grid = cus;
    }
    if (grid < 0) return;
    if (hipMemsetAsync((char*)d_ws + WS_CTL, 0, CTL_ZERO_BYTES, stream) != hipSuccess) return;
    Args a{};
    for (int i = 0; i < 22; ++i) a.in[i] = (const float*)d_in[i];
    a.out = (float*)d_out; a.ws = (unsigned char*)d_ws; a.dup = 0; a.pad = 0;
#if MK_ONE_LAUNCH
    a.ph_lo = 0; a.ph_hi = NPHASES;
    hipLaunchKernelGGL(hybrid_fwd, dim3(grid), dim3(NWAVES * 64), LDS_BYTES, stream, a);
#else
    for (int p = 0; p < NPHASES; ++p) { a.ph_lo = p; a.ph_hi = p + 1;
        const int k = p < NPH_PRO ? 0 : 1 + (p - NPH_PRO) % NPH_LAYER; if (p == 0 && k == 0) { hipLaunchKernelGGL(hybrid_fwd, dim3(grid), dim3(NWAVES * 64), LDS_BYTES, stream, a); continue; }
        if ((DUPMASK >> k) & 1) { a.dup = 1; hipLaunchKernelGGL(hybrid_fwd, dim3(grid), dim3(NWAVES * 64), LDS_BYTES, stream, a); a.dup = 0; }
        hipLaunchKernelGGL(hybrid_fwd, dim3(grid), dim3(NWAVES * 64), LDS_BYTES, stream, a); }
#endif
}
```
